# Optimizing an MI355X kernel written in HIP

```python
import numpy as np
import jax
import jax.numpy as jnp
from jax import lax

D_MODEL = 1024
BATCH = 16
SEQ = 2048
DEPTH = 1

N_META = 16
LEAD = 128
N_PAD = LEAD - N_META
BLOCK = 128

HG_HEADS = 8
HG_DK = 128
HG_DV = 128
HG_WIDTH = HG_HEADS * HG_DK
HG_CHUNK = 16

MLA_HEADS = 16
MLA_NOPE = 128
MLA_ROPE = 64
MLA_V = 128
MLA_Q_RANK = 384
MLA_KV_RANK = 256
MLA_SCALE = (MLA_NOPE + MLA_ROPE) ** -0.5
ROPE_BASE = 10000.0

PEER_HEADS = 8
PEER_NKEYS = 128
PEER_N = PEER_NKEYS * PEER_NKEYS
PEER_HALF = 128
PEER_QDIM = 2 * PEER_HALF
PEER_TOPK = 16

ALPHA = (2 * DEPTH) ** 0.25
BETA = (8 * DEPTH) ** -0.25
EPS = 1e-5

IN_SIZES = (HG_WIDTH, HG_WIDTH, HG_WIDTH, HG_WIDTH, MLA_Q_RANK, MLA_KV_RANK, MLA_ROPE, D_MODEL, D_MODEL)
IN_WIDTH = 4 * HG_WIDTH + MLA_Q_RANK + MLA_KV_RANK + MLA_ROPE + 2 * D_MODEL

kernel_name = 'hybrid_hgrn2_mla_peer_block'


def layer_norm(t, gain, bias):
    tf = t.astype(jnp.float32)
    mu = jnp.mean(tf, axis=-1, keepdims=True)
    var = jnp.mean(jnp.square(tf - mu), axis=-1, keepdims=True)
    return ((tf - mu) * lax.rsqrt(var + EPS) * gain + bias).astype(t.dtype)


def rms_norm(t, gain):
    tf = t.astype(jnp.float32)
    ms = jnp.mean(jnp.square(tf), axis=-1, keepdims=True)
    return (tf * lax.rsqrt(ms + EPS) * gain).astype(t.dtype)


def rope_tables(pos):
    half = MLA_ROPE // 2
    inv_freq = ROPE_BASE ** (-jnp.arange(half, dtype=jnp.float32) / half)
    ang = pos.astype(jnp.float32)[:, None] * inv_freq[None, :]
    return jnp.cos(ang), jnp.sin(ang)


def apply_rope(t, cos, sin):
    half = MLA_ROPE // 2
    tf = t.astype(jnp.float32)
    t1, t2 = tf[..., :half], tf[..., half:]
    return jnp.concatenate([t1 * cos - t2 * sin, t2 * cos + t1 * sin], axis=-1).astype(t.dtype)


def hgrn2_branch(q, f_logit, inp, gate, lower_bound, valid, norm_gain):
    B, P, _ = q.shape
    n_chunks = P // HG_CHUNK
    f32 = jnp.float32
    f = lower_bound + (1.0 - lower_bound) * jax.nn.sigmoid(f_logit.astype(f32))
    vmask = valid[None, :, None]
    log_f = jnp.where(vmask, jnp.log(f), 0.0)
    k = jnp.where(vmask, 1.0 - f, 0.0)

    def chunks(t):
        return t.reshape(B, n_chunks, HG_CHUNK, HG_HEADS, -1).transpose(0, 3, 1, 2, 4)

    qc = chunks(q.astype(f32))
    kc = chunks(k)
    ic = chunks(inp.astype(f32))
    bc = jnp.cumsum(chunks(log_f), axis=3)
    b_last = bc[:, :, :, -1:, :]
    q_dec = qc * jnp.exp(bc)
    k_intra = kc * jnp.exp(-bc)
    k_state = kc * jnp.exp(b_last - bc)

    causal = jnp.tril(jnp.ones((HG_CHUNK, HG_CHUNK), dtype=bool))
    scores = jnp.where(causal, jnp.einsum('bhnck,bhnsk->bhncs', q_dec, k_intra), 0.0)
    o_intra = jnp.einsum('bhncs,bhnsv->bhncv', scores, ic)

    def step(state, xs):
        qd, ks, iv, dec = xs
        o = jnp.einsum('bhck,bhkv->bhcv', qd, state)
        state = dec[..., None] * state + jnp.einsum('bhck,bhcv->bhkv', ks, iv)
        return state, o

    s0 = jnp.zeros((B, HG_HEADS, HG_DK, HG_DV), f32)
    xs = (jnp.moveaxis(q_dec, 2, 0), jnp.moveaxis(k_state, 2, 0), jnp.moveaxis(ic, 2, 0),
          jnp.moveaxis(jnp.exp(b_last[:, :, :, 0, :]), 2, 0))
    _, o_inter = lax.scan(step, s0, xs)
    o = o_intra + jnp.moveaxis(o_inter, 0, 2)
    o = o.transpose(0, 2, 3, 1, 4).reshape(B, P, HG_HEADS, HG_DV)
    o = rms_norm(o, norm_gain.reshape(HG_HEADS, HG_DV)).reshape(B, P, HG_WIDTH)
    return (o * jax.nn.silu(gate.astype(f32))).astype(q.dtype)


def mla_branch(c_q, c_kv, k_rope, q_norm_gain, kv_norm_gain, w_uq, w_ukv, cos, sin):
    B, P, _ = c_q.shape
    q = (rms_norm(c_q, q_norm_gain) @ w_uq).reshape(B, P, MLA_HEADS, MLA_NOPE + MLA_ROPE)
    q_nope = q[..., :MLA_NOPE]
    q_rope = apply_rope(q[..., MLA_NOPE:], cos[:, None, :], sin[:, None, :])
    kv = (rms_norm(c_kv, kv_norm_gain) @ w_ukv).reshape(B, P, MLA_HEADS, MLA_NOPE + MLA_V)
    k_nope, v = kv[..., :MLA_NOPE], kv[..., MLA_NOPE:]
    k_r = apply_rope(k_rope, cos, sin)

    n_blocks = P // BLOCK
    qn_b = q_nope.reshape(B, n_blocks, BLOCK, MLA_HEADS, MLA_NOPE).transpose(1, 0, 3, 2, 4)
    qr_b = q_rope.reshape(B, n_blocks, BLOCK, MLA_HEADS, MLA_ROPE).transpose(1, 0, 3, 2, 4)
    qpos_b = jnp.arange(P).reshape(n_blocks, BLOCK)
    kpos = jnp.arange(P)
    key_real = kpos >= N_PAD

    def attend(args):
        qn, qr, qpos = args
        s = (jnp.einsum('bhqd,bkhd->bhqk', qn, k_nope, preferred_element_type=jnp.float32)
             + jnp.einsum('bhqr,bkr->bhqk', qr, k_r, preferred_element_type=jnp.float32)) * MLA_SCALE
        allowed = (kpos[None, :] <= qpos[:, None]) & (key_real[None, :] | (kpos[None, :] == qpos[:, None]))
        s = jnp.where(allowed, s, -jnp.inf)
        p = jax.nn.softmax(s, axis=-1).astype(v.dtype)
        return jnp.einsum('bhqk,bkhd->bqhd', p, v)

    out = lax.map(attend, (qn_b, qr_b, qpos_b))
    return out.transpose(1, 0, 2, 3, 4).reshape(B, P, MLA_HEADS * MLA_V)


def peer_ffn(h, w_query, sub_keys, u_table, v_table):
    B, P, D = h.shape
    T = B * P
    ht = h.reshape(T, D)
    q = (ht @ w_query).reshape(T, PEER_HEADS, 2, PEER_HALF)
    s = jnp.einsum('thpd,hpnd->thpn', q, sub_keys, preferred_element_type=jnp.float32)
    s_top, i_top = lax.top_k(s, PEER_TOPK)
    cand = s_top[:, :, 0, :, None] + s_top[:, :, 1, None, :]
    cand_idx = i_top[:, :, 0, :, None] * PEER_NKEYS + i_top[:, :, 1, None, :]
    best, sel = lax.top_k(cand.reshape(T, PEER_HEADS, PEER_TOPK * PEER_TOPK), PEER_TOPK)
    experts = jnp.take_along_axis(cand_idx.reshape(T, PEER_HEADS, PEER_TOPK * PEER_TOPK), sel, axis=-1)
    gates = jax.nn.softmax(best, axis=-1)
    n_blk = T // BLOCK
    n_sel = PEER_HEADS * PEER_TOPK

    def apply(args):
        xb, eb, gb = args
        u = jnp.take(u_table, eb, axis=0)
        a = jnp.einsum('tkd,td->tk', u, xb, preferred_element_type=jnp.float32)
        act = (jax.nn.gelu(a) * gb).astype(xb.dtype)
        vv = jnp.take(v_table, eb, axis=0)
        return jnp.einsum('tk,tkd->td', act, vv)

    out = lax.map(apply, (ht.reshape(n_blk, BLOCK, D), experts.reshape(n_blk, BLOCK, n_sel),
                          gates.reshape(n_blk, BLOCK, n_sel)))
    return out.reshape(B, P, D)


def setup_inputs(seed: int = 0) -> dict:
    key = jax.random.key(seed)
    ks = jax.random.split(key, 20)
    nrm = jax.random.normal
    f32 = jnp.float32
    L = DEPTH
    return {
        'x': nrm(ks[0], (BATCH, SEQ, D_MODEL), f32),
        'meta_tokens': nrm(ks[1], (N_META, D_MODEL), f32),
        'hgrn_lb_logits': 0.1 * nrm(ks[2], (DEPTH + 1, HG_WIDTH), f32),
        'w_in': nrm(ks[3], (L, D_MODEL, IN_WIDTH), f32) * D_MODEL ** -0.5,
        'q_norm_gain': 1.0 + 0.01 * nrm(ks[4], (L, MLA_Q_RANK), f32),
        'kv_norm_gain': 1.0 + 0.01 * nrm(ks[5], (L, MLA_KV_RANK), f32),
        'w_uq': nrm(ks[6], (L, MLA_Q_RANK, MLA_HEADS * (MLA_NOPE + MLA_ROPE)), f32) * MLA_Q_RANK ** -0.5,
        'w_ukv': nrm(ks[7], (L, MLA_KV_RANK, MLA_HEADS * (MLA_NOPE + MLA_V)), f32) * MLA_KV_RANK ** -0.5,
        'hgrn_norm_gain': 1.0 + 0.01 * nrm(ks[8], (L, HG_WIDTH), f32),
        'w_proj_hgrn': nrm(ks[9], (L, HG_WIDTH, D_MODEL), f32) * HG_WIDTH ** -0.5,
        'w_proj_mla': nrm(ks[10], (L, MLA_HEADS * MLA_V, D_MODEL), f32) * (MLA_HEADS * MLA_V) ** -0.5,
        'w_out': nrm(ks[11], (L, D_MODEL, D_MODEL), f32) * (BETA * D_MODEL ** -0.5),
        'ln1_gain': 1.0 + 0.01 * nrm(ks[12], (L, D_MODEL), f32),
        'ln1_bias': 0.01 * nrm(ks[13], (L, D_MODEL), f32),
        'peer_query': nrm(ks[14], (L, D_MODEL, PEER_HEADS * PEER_QDIM), f32) * D_MODEL ** -0.5,
        'peer_sub_keys': nrm(ks[15], (L, PEER_HEADS, 2, PEER_NKEYS, PEER_HALF), f32) * PEER_HALF ** -0.5,
        'peer_u': nrm(ks[16], (L, PEER_N, D_MODEL), f32) * D_MODEL ** -0.5,
        'peer_v': nrm(ks[17], (L, PEER_N, D_MODEL), f32) * BETA,
        'ln2_gain': 1.0 + 0.01 * nrm(ks[18], (L, D_MODEL), f32),
        'ln2_bias': 0.01 * nrm(ks[19], (L, D_MODEL), f32),
    }


def reference(x, meta_tokens, hgrn_lb_logits, w_in, q_norm_gain, kv_norm_gain, w_uq, w_ukv,
              hgrn_norm_gain, w_proj_hgrn, w_proj_mla, w_out, ln1_gain, ln1_bias,
              peer_query, peer_sub_keys, peer_u, peer_v, ln2_gain, ln2_bias):
    B, S, D = x.shape
    P = LEAD + S
    pad = jnp.zeros((B, N_PAD, D), x.dtype)
    meta = jnp.broadcast_to(meta_tokens.astype(x.dtype)[None], (B, N_META, D))
    h = jnp.concatenate([pad, meta, x], axis=1)
    rows = jnp.arange(P)
    valid = rows >= N_PAD
    cos, sin = rope_tables(rows - N_PAD)
    lower_bounds = jnp.cumsum(jax.nn.softmax(hgrn_lb_logits.astype(jnp.float32), axis=0), axis=0)
    offsets = [int(o) for o in np.cumsum(IN_SIZES)[:-1]]

    for l in range(DEPTH):
        proj = h @ w_in[l]
        hq, hf, hi, hg, cq, ckv, kr, ga, gb = jnp.split(proj, offsets, axis=-1)
        ya = hgrn2_branch(hq, hf, hi, hg, lower_bounds[l], valid, hgrn_norm_gain[l]) @ w_proj_hgrn[l]
        yb = mla_branch(cq, ckv, kr, q_norm_gain[l], kv_norm_gain[l], w_uq[l], w_ukv[l], cos, sin) @ w_proj_mla[l]
        mixed = (jax.nn.sigmoid(ga) * ya + jax.nn.sigmoid(gb) * yb) @ w_out[l]
        h = layer_norm(ALPHA * h + mixed, ln1_gain[l], ln1_bias[l])
        ffn = peer_ffn(h, peer_query[l], peer_sub_keys[l], peer_u[l], peer_v[l])
        h = layer_norm(ALPHA * h + ffn, ln2_gain[l], ln2_bias[l])

    return h[:, LEAD:]
```

```cpp
#include <hip/hip_runtime.h>
#include <hip/hip_cooperative_groups.h>
#include <cstdio>
#include <cstdint>
#include <cmath>
namespace cg = cooperative_groups;

#ifndef MK_LAUNCHES
#define MK_LAUNCHES 1
#endif
#ifndef PEER_SAMEORDER
#define PEER_SAMEORDER 0
#endif
#ifndef PEER_SPLIT
#define PEER_SPLIT 1
#endif

constexpr int NB = 16, SEQ = 2048, DM = 1024, LEAD = 128, NPADR = 112, PP = LEAD + SEQ;
constexpr int MALL = NB * PP;
constexpr int MR = NB * SEQ;
constexpr int INW = 6848, INWP = 6912;
constexpr int N1 = 4864, N1V = 4800;
constexpr int N1G = 5888;
constexpr int PV = PP - NPADR, MV = NB * PV;
constexpr int QR = 384, KVR = 256, ROPE = 64, NH = 16, QKD = 192, VD = 128;
constexpr int HGH = 8;
constexpr float ALPHA = 1.189207115002721f;
constexpr float EPS = 1e-5f;
constexpr int NHALF = 2, HB = NB / NHALF;
constexpr int MRH = HB * SEQ, MALLH = HB * PP;

constexpr size_t MiB = 1u << 20;
constexpr size_t al256(size_t x) { return (x + 255) / 256 * 256; }
constexpr size_t WS_CTL = 0;
constexpr size_t WS_WIN = 1 * MiB;
constexpr size_t WS_WUQ = WS_WIN + (size_t)INWP * DM * 2;
constexpr size_t WS_WUKV = WS_WUQ + (size_t)3072 * QR * 2;
constexpr size_t WS_WPH = WS_WUKV + (size_t)4096 * KVR * 2;
constexpr size_t WS_WPM = WS_WPH + (size_t)1024 * 1024 * 2;
constexpr size_t WS_WO = WS_WPM + (size_t)1024 * 2048 * 2;
constexpr size_t WS_WPQ = WS_WO + (size_t)1024 * 1024 * 2;
constexpr size_t WS_SK = WS_WPQ + (size_t)2048 * 1024 * 2;
constexpr size_t WS_ROPE = WS_SK + (size_t)16 * 128 * 128 * 2;
constexpr size_t WS_RQ = WS_ROPE + (size_t)PP * 32 * 2 * 4;
constexpr size_t WS_RKV = WS_RQ + (size_t)MR * 4;
constexpr size_t WS_WEND = WS_RKV + (size_t)MALL * 4;
static_assert(WS_WEND <= 34 * MiB, "weights region");
constexpr size_t WS_C = 34 * MiB;
constexpr size_t WS_CQ = WS_C, WS_CKV = WS_CQ + (size_t)MR * QR * 2, WS_KR = WS_CKV + (size_t)MALL * KVR * 2;
static_assert(WS_KR + (size_t)MALL * ROPE * 2 <= 81 * MiB, "C region");
constexpr size_t WS_A = 81 * MiB;
constexpr size_t WS_ON = 448 * MiB;
constexpr size_t WS_B = 149 * MiB;
constexpr size_t WS_HQ = WS_B, WS_K1 = WS_HQ + (size_t)MALL * DM * 2, WS_HI = WS_K1 + (size_t)MALL * DM * 2, WS_HG = WS_HI + (size_t)MALL * DM * 2;
static_assert(WS_HG + (size_t)MR * DM * 2 <= 421 * MiB, "B region");
constexpr size_t WS_QH = 81 * MiB;
constexpr size_t WS_KVH = 177 * MiB;
constexpr size_t WS_AO = 313 * MiB;
constexpr size_t WS_X = 81 * MiB;
constexpr size_t WS_H1B = 178 * MiB;
constexpr size_t WS_U8 = 145 * MiB, WS_V8 = 161 * MiB, WS_SU = 177 * MiB, WS_SV = WS_SU + 65536;
constexpr size_t WS_ACT = 242 * MiB, WS_SIDX = 258 * MiB;
constexpr size_t WS_PQ = 313 * MiB;
constexpr size_t WS_NEED = 512 * MiB;
static_assert(WS_AO + (size_t)MR * 2048 * 2 <= WS_ON && WS_ON + (size_t)MR * DM * 2 <= WS_NEED && WS_KVH + (size_t)MALLH * 4096 * 2 <= WS_AO && WS_QH + (size_t)MRH * 3072 * 2 <= WS_KVH && WS_HG + (size_t)MR * DM * 2 <= WS_ON && WS_A + (size_t)MV * DM * 2 <= WS_B, "attention buffers");
static_assert(WS_X + (size_t)MR * DM * 2 <= WS_U8 && WS_SV + 65536 <= WS_H1B && WS_H1B + (size_t)MR * DM * 2 <= WS_PQ && WS_PQ + (size_t)MR * 2048 * 2 <= WS_ON, "late buffers");

constexpr int LDS_BYTES = 147456;

#define LAS __attribute__((address_space(3)))
#define GAS __attribute__((address_space(1)))
typedef unsigned short bf16;
typedef unsigned v4u __attribute__((ext_vector_type(4)));
typedef unsigned v2u __attribute__((ext_vector_type(2)));
typedef float f32x2 __attribute__((ext_vector_type(2)));
typedef float f32x8 __attribute__((ext_vector_type(8)));
typedef float f32x16 __attribute__((ext_vector_type(16)));
typedef short s16x4 __attribute__((ext_vector_type(4)));

__device__ __forceinline__ unsigned f2bf(float f) { unsigned u = __builtin_bit_cast(unsigned, f); return (u + 0x7fffu + ((u >> 16) & 1u)) >> 16; }
__device__ __forceinline__ unsigned pk2(float lo, float hi) { return f2bf(lo) | (f2bf(hi) << 16); }
__device__ __forceinline__ float bflo(unsigned w) { return __builtin_bit_cast(float, w << 16); }
__device__ __forceinline__ float bfhi(unsigned w) { return __builtin_bit_cast(float, w & 0xffff0000u); }
__device__ __forceinline__ float bf2f(unsigned short h) { return __builtin_bit_cast(float, (unsigned)h << 16); }
__device__ __forceinline__ float fsigmoid(float x) { return 1.0f / (1.0f + __expf(-x)); }
__device__ __forceinline__ float wave_sum(float v) {
#pragma unroll
    for (int o = 1; o < 64; o <<= 1) v += __shfl_xor(v, o);
    return v;
}
namespace pg8 {
#define PG8_LAS __attribute__((address_space(3)))
typedef unsigned short bf16_t;
typedef short bf16x8 __attribute__((ext_vector_type(8)));
typedef float f32x4 __attribute__((ext_vector_type(4)));
typedef unsigned u32x4 __attribute__((ext_vector_type(4)));
constexpr int BM = 256, BK = 64, HALF = 128, HTB = HALF * BK * 2  , STAGE_BYTES = 8 * HTB, NXCD = 8, WGM = 8;

__host__ __device__ __forceinline__ int lds_byte(int r, int c) { const int st = (r >> 4) * 2 + (c >> 5), rr = r & 15, cc = c & 31, ob = rr * 64 + cc * 2; return st * 1024 + (ob ^ (((ob >> 9) & 1) << 5)); }
__host__ __device__ __forceinline__ void stage_rc(int b, int& R, int& C) { const int st = b / 1024, sb = b % 1024, swz = sb ^ (((sb >> 9) & 1) << 5); R = (st >> 1) * 16 + swz / 64; C = (st & 1) * 32 + (swz % 64) / 2; }
__host__ __device__ __forceinline__ int perm32(int rho) { const int n = rho >> 4, i = rho & 15; return 8 * (i >> 2) + 4 * n + (i & 3); }

struct Unit { int pm, pn; };
struct Gemm { const bf16_t* A; const bf16_t* Bt; int M, N, K; };

struct StaticOrder {
    int nM, nN, nwg, G, c;
    __host__ __device__ void init(int M, int N, int G_, int c_) { nM = M / BM; nN = N / BM; nwg = nM * nN; G = G_; c = c_; }
    __host__ __device__ bool next(int i, Unit& u) const {
        const long L = (long)i * G + c; if (L >= nwg) return false;
        int wgid = (int)L; { const int q = nwg / NXCD, r = nwg % NXCD, xcd = wgid % NXCD, off = wgid / NXCD; wgid = (xcd < r ? xcd * (q + 1) : r * (q + 1) + (xcd - r) * q) + off; }
        const int nig = WGM * nN, gid = wgid / nig, fm = gid * WGM, gsz = (nM - fm) < WGM ? (nM - fm) : WGM;
        u.pm = fm + ((wgid % nig) % gsz); u.pn = (wgid % nig) / gsz; return true;
    }
    __device__ __forceinline__ int arow(int pm) const { return pm * BM; }
    __device__ __forceinline__ void a_ready(const Unit&) const {}
    __device__ __forceinline__ void done(const Unit&) const {}
};
struct GateOrder : StaticOrder { __device__ __forceinline__ int arow(int pm) const { return (pm >> 3) * 2064 + 16 + (pm & 7) * BM; } };
struct DynGateOrder {
    unsigned* slots; unsigned* counter; int nN, nwg;
    __device__ __forceinline__ bool next(int i, Unit& u) const {
        if (i >= 16) return false;
        unsigned v = 0;
        if ((threadIdx.x & 63) == 0) {
            v = __hip_atomic_load(slots + i, __ATOMIC_RELAXED, __HIP_MEMORY_SCOPE_AGENT);
            if (v == 0u) { unsigned expect = 0u;
                if (__hip_atomic_compare_exchange_strong(slots + i, &expect, 1u, __ATOMIC_RELAXED, __ATOMIC_RELAXED, __HIP_MEMORY_SCOPE_AGENT)) {
                    const unsigned t = __hip_atomic_fetch_add(counter, 1u, __ATOMIC_RELAXED, __HIP_MEMORY_SCOPE_AGENT);
                    __hip_atomic_store(slots + i, t + 2u, __ATOMIC_RELAXED, __HIP_MEMORY_SCOPE_AGENT); } }
            unsigned sp = 0;
            while ((v = __hip_atomic_load(slots + i, __ATOMIC_RELAXED, __HIP_MEMORY_SCOPE_AGENT)) < 2u) { __builtin_amdgcn_s_sleep(1); if (++sp > (1u << 24)) { v = 0x7fffffffu; break; } }
        }
        const int t = (int)__builtin_amdgcn_readfirstlane(v) - 2;
        if (t >= nwg) return false;
        u.pm = t / nN; u.pn = t - u.pm * nN; return true;
    }
    __device__ __forceinline__ int arow(int pm) const { return (pm >> 3) * 2064 + 16 + (pm & 7) * BM; }
    __device__ __forceinline__ void a_ready(const Unit&) const {}
    __device__ __forceinline__ void done(const Unit&) const {}
};
__device__ __forceinline__ unsigned cvt_pk_bf16(float lo, float hi) { unsigned r; asm volatile("v_cvt_pk_bf16_f32 %0, %1, %2" : "=v"(r) : "v"(lo), "v"(hi)); return r; }
typedef float f32x2 __attribute__((ext_vector_type(2)));
template <class Epi, class Sched, bool ALIGN_EPI = false, bool SP2 = false>
__device__ __forceinline__ void gemm_phase(PG8_LAS unsigned char* lds, const Gemm g, const Sched& S, const Epi& E) {
    int tid_ = threadIdx.x; asm volatile("" : "+v"(tid_));
    const int tid = tid_, wid = __builtin_amdgcn_readfirstlane(tid >> 6), lane = tid & 63, wr = wid >> 2, wc = wid & 3, fr = lane & 15, fq = lane >> 4;
    int K_ = g.K; asm volatile("" : "+s"(K_));
    const int K = K_, nt = K / BK;
    unsigned voffA[2], voffB[2];
#pragma unroll
    for (int i = 0; i < 2; ++i) { int R, C; stage_rc(tid * 16 + i * 8192, R, C); const int Rb = Epi::PERM ? ((R & ~31) + perm32(R & 31)) : R;
        voffA[i] = (unsigned)(R * K + C) * 2u; voffB[i] = (unsigned)(Rb * K + C) * 2u; }
    const size_t kstep = (size_t)(BK * 2);
    const size_t hstep = (size_t)HALF * K * 2;
    const size_t tstep = 2 * hstep;
    const unsigned ldsw = (unsigned)wid * 1024u;
    const int aoff = lds_byte(wr * 64 + fr, fq * 8), boff = lds_byte(wc * 32 + fr, fq * 8);
#define PG8_SA(b, h) (((b) * 2 + (h)) * HTB)
#define PG8_SB(b, h) ((4 + (b) * 2 + (h)) * HTB)
#define PG8_STAGE(bufoff, gbase, voff) do { _Pragma("unroll") for (int _i = 0; _i < 2; ++_i) \
        __builtin_amdgcn_global_load_lds((const unsigned*)((const char*)(gbase) + (voff)[_i]), (PG8_LAS unsigned*)(lds + (bufoff) + ldsw + _i * 8192), 16, 0, 0); } while (0)
#define PG8_LDA(dst, b, h) do { _Pragma("unroll") for (int m = 0; m < 4; ++m) _Pragma("unroll") for (int k = 0; k < 2; ++k) dst[m][k] = *(const PG8_LAS bf16x8*)(lds + PG8_SA(b, h) + aoff + m * 2048 + k * 1024); } while (0)
#define PG8_LDB(dst, b, h) do { _Pragma("unroll") for (int n = 0; n < 2; ++n) _Pragma("unroll") for (int k = 0; k < 2; ++k) dst[n][k] = *(const PG8_LAS bf16x8*)(lds + PG8_SB(b, h) + boff + n * 2048 + k * 1024); } while (0)
#define PG8_MMA(ai, bj, At, Bt) do { __builtin_amdgcn_s_setprio(1); _Pragma("unroll") for (int m = 0; m < 4; ++m) _Pragma("unroll") for (int n = 0; n < 2; ++n) _Pragma("unroll") for (int k = 0; k < 2; ++k) \
        acc[ai][bj][m][n] = __builtin_amdgcn_mfma_f32_16x16x32_bf16(Bt[n][k], At[m][k], acc[ai][bj][m][n], 0, 0, 0); __builtin_amdgcn_s_setprio(0); } while (0)
#define PG8_WAIT_V(n) asm volatile("s_waitcnt vmcnt(" #n ")" ::: "memory")
#define PG8_WAIT_L(n) asm volatile("s_waitcnt lgkmcnt(" #n ")" ::: "memory")
#define PG8_BAR __builtin_amdgcn_s_barrier()
#define PG8_SCHED __builtin_amdgcn_sched_barrier(0)
    Unit cur, nxt; int ui = 0;
    if (!S.next(0, cur)) return;
    f32x4 acc[2][2][4][2];
#pragma unroll
    for (int a = 0; a < 2; ++a)
#pragma unroll
        for (int b = 0; b < 2; ++b)
#pragma unroll
            for (int m = 0; m < 4; ++m)
#pragma unroll
                for (int n = 0; n < 2; ++n) acc[a][b][m][n] = (f32x4){0.f, 0.f, 0.f, 0.f};
    bf16x8 At[4][2], B0[2][2], B1[2][2];
    const char* cA = (const char*)g.A + (size_t)S.arow(cur.pm) * (size_t)K * 2; const char* cB = (const char*)g.Bt + (size_t)cur.pn * tstep;
    S.a_ready(cur);
    if constexpr (SP2) {
        PG8_STAGE(PG8_SB(0, 0), cB, voffB); PG8_STAGE(PG8_SB(0, 1), cB + hstep, voffB); PG8_STAGE(PG8_SA(0, 0), cA, voffA); PG8_STAGE(PG8_SA(0, 1), cA + hstep, voffA);
        if (wr == 1) PG8_BAR;
        PG8_WAIT_V(2); PG8_BAR;
        PG8_STAGE(PG8_SB(1, 0), cB + kstep, voffB); PG8_STAGE(PG8_SA(1, 0), cA + kstep, voffA); PG8_STAGE(PG8_SB(1, 1), cB + hstep + kstep, voffB);
        PG8_WAIT_V(6); PG8_BAR;
    } else {
        PG8_STAGE(PG8_SB(0, 0), cB, voffB); PG8_STAGE(PG8_SA(0, 0), cA, voffA); PG8_STAGE(PG8_SB(0, 1), cB + hstep, voffB); PG8_STAGE(PG8_SA(0, 1), cA + hstep, voffA);
        if (wr == 1) PG8_BAR;
        PG8_WAIT_V(4); PG8_BAR;
        PG8_STAGE(PG8_SB(1, 0), cB + kstep, voffB); PG8_STAGE(PG8_SA(1, 0), cA + kstep, voffA); PG8_STAGE(PG8_SB(1, 1), cB + hstep + kstep, voffB);
        PG8_WAIT_V(6); PG8_BAR;
    }
    for (;;) {
        const bool has_next = S.next(ui + 1, nxt);
        const char* nA = has_next ? (const char*)g.A + (size_t)S.arow(nxt.pm) * (size_t)K * 2 : cA; const char* nB = has_next ? (const char*)g.Bt + (size_t)nxt.pn * tstep : cB;
        for (int t = 0; t < nt; t += 2) {
            const bool last = (t == nt - 2);
            const char* a1 = cA + (size_t)(t + 1) * kstep;
            const char* a2 = last ? nA : cA + (size_t)(t + 2) * kstep; const char* b2 = last ? nB : cB + (size_t)(t + 2) * kstep;
            const char* a3 = a2 + kstep; const char* b3 = b2 + kstep;
            if (last && has_next) S.a_ready(nxt);
            if constexpr (SP2) {
            PG8_LDB(B0, 0, 0); PG8_LDB(B1, 0, 1); PG8_SCHED; PG8_LDA(At, 0, 0); PG8_STAGE(PG8_SA(1, 1), a1 + hstep, voffA);
            PG8_WAIT_V(8); PG8_WAIT_L(0); PG8_BAR; PG8_MMA(0, 0, At, B0); PG8_MMA(0, 1, At, B1); PG8_BAR; PG8_SCHED;
            PG8_LDA(At, 0, 1); PG8_STAGE(PG8_SB(0, 0), b2, voffB); PG8_STAGE(PG8_SB(0, 1), b2 + hstep, voffB); PG8_STAGE(PG8_SA(0, 0), a2, voffA);
            PG8_WAIT_V(8); PG8_WAIT_L(0); PG8_BAR; PG8_MMA(1, 0, At, B0); PG8_MMA(1, 1, At, B1); PG8_BAR; PG8_SCHED;
            PG8_LDB(B0, 1, 0); PG8_LDB(B1, 1, 1); PG8_SCHED; PG8_LDA(At, 1, 0); PG8_STAGE(PG8_SA(0, 1), a2 + hstep, voffA);
            PG8_WAIT_V(8); PG8_WAIT_L(0); PG8_BAR; PG8_MMA(0, 0, At, B0); PG8_MMA(0, 1, At, B1); PG8_BAR; PG8_SCHED;
            PG8_LDA(At, 1, 1); PG8_STAGE(PG8_SB(1, 0), b3, voffB); PG8_STAGE(PG8_SB(1, 1), b3 + hstep, voffB); PG8_STAGE(PG8_SA(1, 0), a3, voffA);
            PG8_WAIT_V(8); PG8_WAIT_L(0); PG8_BAR; PG8_MMA(1, 0, At, B0); PG8_MMA(1, 1, At, B1); PG8_BAR; PG8_SCHED;
            } else {
            PG8_LDB(B0, 0, 0); PG8_SCHED; PG8_LDA(At, 0, 0); PG8_STAGE(PG8_SA(1, 1), a1 + hstep, voffA);
            PG8_WAIT_L(8); PG8_BAR; PG8_WAIT_L(0); PG8_MMA(0, 0, At, B0); PG8_BAR; PG8_SCHED;
            PG8_LDB(B1, 0, 1); PG8_STAGE(PG8_SB(0, 0), b2, voffB);
            PG8_BAR; PG8_WAIT_L(0); PG8_MMA(0, 1, At, B1); PG8_BAR;
            PG8_LDA(At, 0, 1); PG8_STAGE(PG8_SA(0, 0), a2, voffA);
            PG8_BAR; PG8_WAIT_L(0); PG8_MMA(1, 0, At, B0); PG8_BAR; PG8_SCHED;
            PG8_STAGE(PG8_SB(0, 1), b2 + hstep, voffB);
            PG8_WAIT_V(6); PG8_BAR; PG8_MMA(1, 1, At, B1); PG8_BAR;
            PG8_LDB(B0, 1, 0); PG8_SCHED; PG8_LDA(At, 1, 0); PG8_STAGE(PG8_SA(0, 1), a2 + hstep, voffA);
            PG8_WAIT_L(8); PG8_BAR; PG8_WAIT_L(0); PG8_MMA(0, 0, At, B0); PG8_BAR; PG8_SCHED;
            PG8_LDB(B1, 1, 1); PG8_STAGE(PG8_SB(1, 0), b3, voffB);
            PG8_BAR; PG8_WAIT_L(0); PG8_MMA(0, 1, At, B1); PG8_BAR;
            PG8_LDA(At, 1, 1); PG8_STAGE(PG8_SA(1, 0), a3, voffA);
            PG8_BAR; PG8_WAIT_L(0); PG8_MMA(1, 0, At, B0); PG8_BAR; PG8_SCHED;
            PG8_STAGE(PG8_SB(1, 1), b3 + hstep, voffB);
            PG8_WAIT_V(6); PG8_BAR; PG8_MMA(1, 1, At, B1); PG8_BAR;
            }
        }
        if constexpr (ALIGN_EPI) { if (wr == 0) PG8_BAR; }
        if constexpr (!Epi::AFTER_DRAIN) { E(acc, cur, wr, wc, fr, fq); S.done(cur); }
        if (!has_next) break;
#pragma unroll
        for (int a = 0; a < 2; ++a)
#pragma unroll
            for (int b = 0; b < 2; ++b)
#pragma unroll
                for (int m = 0; m < 4; ++m)
#pragma unroll
                    for (int n = 0; n < 2; ++n) acc[a][b][m][n] = (f32x4){0.f, 0.f, 0.f, 0.f};
        cur = nxt; cA = nA; cB = nB; ++ui;
        if constexpr (ALIGN_EPI) { if (wr == 1) PG8_BAR; }
    }
    PG8_WAIT_V(0);
    if constexpr (!ALIGN_EPI) { if (wr == 0) PG8_BAR; }
    PG8_BAR;
    if constexpr (Epi::AFTER_DRAIN) { E.fused(acc, cur, wr, wc, fr, fq, lds, wid, lane); S.done(cur); }
#undef PG8_SA
#undef PG8_SB
#undef PG8_STAGE
#undef PG8_LDA
#undef PG8_LDB
#undef PG8_MMA
#undef PG8_WAIT_V
#undef PG8_WAIT_L
#undef PG8_BAR
#undef PG8_SCHED
}
}

namespace pg8 {
__device__ __forceinline__ u32x4 pack8(const f32x4 a, const f32x4 b) { u32x4 w; w.x = cvt_pk_bf16(a[0], a[1]); w.y = cvt_pk_bf16(a[2], a[3]); w.z = cvt_pk_bf16(b[0], b[1]); w.w = cvt_pk_bf16(b[2], b[3]); return w; }

template <bool RAW> struct EpiInProjT {
    static constexpr bool PERM = true, AFTER_DRAIN = false;
    bf16_t *HQ, *K1, *HI, *HG, *CQ, *CKV, *KR, *GA, *GB; const float* lbl; const float* rope;
    __device__ __forceinline__ void operator()(const f32x4 (&acc)[2][2][4][2], const Unit& u, int wr, int wc, int fr_, int fq_) const {
        int fr = fr_, fq = fq_; asm volatile("" : "+v"(fr), "+v"(fq));
#pragma unroll
        for (int bj = 0; bj < 2; ++bj) {
            const int c = u.pn * BM + bj * HALF + wc * 32 + 8 * fq;
            if (c >= N1V) continue;
            int seg, cc;
            if (c < 4096) { seg = c >> 10; cc = c & 1023; }
            else if (c < 4480) { seg = 4; cc = c - 4096; }
            else if (c < 4736) { seg = 5; cc = c - 4480; }
            else { seg = 6; cc = c - 4736; }
            float oml[8];
            if (seg == 1 && !RAW) {
#pragma unroll
                for (int j = 0; j < 8; ++j) { const float l0 = lbl[cc + j], l1 = lbl[1024 + cc + j]; oml[j] = 1.0f - __builtin_amdgcn_rcpf(1.0f + __expf(l1 - l0)); }
            }
#pragma unroll
            for (int ai = 0; ai < 2; ++ai)
#pragma unroll
                for (int m = 0; m < 4; ++m) {
                    const int Rc = u.pm * BM + ai * HALF + wr * 64 + m * 16 + fr;
                    const int b = Rc / PV, p = NPADR + (Rc - b * PV); const int R = b * PP + p; const bool real = p >= LEAD; const size_t rr = (size_t)b * SEQ + (p - LEAD);
                    f32x4 v0 = acc[ai][bj][m][0], v1 = acc[ai][bj][m][1];
                    if (RAW && seg != 0 && seg != 2 && seg != 5) { if (seg == 1) *(u32x4*)(K1 + (size_t)R * DM + cc) = pack8(v0, v1); else if (seg == 6) *(u32x4*)(KR + (size_t)R * ROPE + cc) = pack8(v0, v1); else if (real) { if (seg == 3) *(u32x4*)(HG + rr * DM + cc) = pack8(v0, v1); else if (seg == 4) *(u32x4*)(CQ + rr * QR + cc) = pack8(v0, v1); else *(u32x4*)((seg == 7 ? GA : GB) + rr * DM + cc) = pack8(v0, v1); } }
                    else if (seg == 0) { *(u32x4*)(HQ + (size_t)R * DM + cc) = pack8(v0, v1); }
                    else if (seg == 1) {
#pragma unroll
                        for (int j = 0; j < 4; ++j) { v0[j] = oml[j] * __builtin_amdgcn_rcpf(1.0f + __expf(v0[j])); v1[j] = oml[4 + j] * __builtin_amdgcn_rcpf(1.0f + __expf(v1[j])); }
                        *(u32x4*)(K1 + (size_t)R * DM + cc) = pack8(v0, v1); }
                    else if (seg == 2) { *(u32x4*)(HI + (size_t)R * DM + cc) = pack8(v0, v1); }
                    else if (seg == 3) { if (real) {
#pragma unroll
                        for (int j = 0; j < 4; ++j) { v0[j] = v0[j] * __builtin_amdgcn_rcpf(1.0f + __expf(-v0[j])); v1[j] = v1[j] * __builtin_amdgcn_rcpf(1.0f + __expf(-v1[j])); }
                        *(u32x4*)(HG + rr * DM + cc) = pack8(v0, v1); } }
                    else if (seg == 4) { if (real) *(u32x4*)(CQ + rr * QR + cc) = pack8(v0, v1); }
                    else if (seg == 5) { *(u32x4*)(CKV + (size_t)R * KVR + cc) = pack8(v0, v1); }
                    else if (seg == 6) {
                        const f32x4* tp = (const f32x4*)(rope + ((size_t)p * 32 + (cc >> 1)) * 2);
                        const f32x4 t0 = tp[0], t1 = tp[1];
                        f32x4 o0, o1;
                        o0[0] = v0[0] * t0[0] - v0[1] * t0[1]; o0[1] = v0[1] * t0[0] + v0[0] * t0[1];
                        o0[2] = v0[2] * t0[2] - v0[3] * t0[3]; o0[3] = v0[3] * t0[2] + v0[2] * t0[3];
                        o1[0] = v1[0] * t1[0] - v1[1] * t1[1]; o1[1] = v1[1] * t1[0] + v1[0] * t1[1];
                        o1[2] = v1[2] * t1[2] - v1[3] * t1[3]; o1[3] = v1[3] * t1[2] + v1[2] * t1[3];
                        *(u32x4*)(KR + (size_t)R * ROPE + cc) = pack8(o0, o1); }
                    else { if (real) {
#pragma unroll
                        for (int j = 0; j < 4; ++j) { v0[j] = __builtin_amdgcn_rcpf(1.0f + __expf(-v0[j])); v1[j] = __builtin_amdgcn_rcpf(1.0f + __expf(-v1[j])); }
                        *(u32x4*)((seg == 7 ? GA : GB) + rr * DM + cc) = pack8(v0, v1); } }
                }
        }
    }
};

typedef EpiInProjT<false> EpiInProj;


struct EpiGates {
    static constexpr bool PERM = true, AFTER_DRAIN = false;
    bf16_t *GA, *GB;
    __device__ __forceinline__ void operator()(const f32x4 (&acc)[2][2][4][2], const Unit& u, int wr, int wc, int fr_, int fq_) const {
        int fr = fr_, fq = fq_; asm volatile("" : "+v"(fr), "+v"(fq));
#pragma unroll
        for (int bj = 0; bj < 2; ++bj) { const int c = u.pn * BM + bj * HALF + wc * 32 + 8 * fq; bf16_t* dst = (c < 1024 ? GA : GB) + (c & 1023);
#pragma unroll
            for (int ai = 0; ai < 2; ++ai)
#pragma unroll
                for (int m = 0; m < 4; ++m) { const size_t rr = (size_t)(u.pm * BM + ai * HALF + wr * 64 + m * 16 + fr);
                    f32x4 v0 = acc[ai][bj][m][0], v1 = acc[ai][bj][m][1];
#pragma unroll
                    for (int j = 0; j < 4; ++j) { v0[j] = __builtin_amdgcn_rcpf(1.0f + __expf(-v0[j])); v1[j] = __builtin_amdgcn_rcpf(1.0f + __expf(-v1[j])); }
                    *(u32x4*)(dst + rr * DM) = pack8(v0, v1); } }
    }
};

struct EpiQ {
    static constexpr bool PERM = true, AFTER_DRAIN = false;
    bf16_t* Q; const float* rq; const float* rope; int row_base;
    __device__ __forceinline__ void operator()(const f32x4 (&acc)[2][2][4][2], const Unit& u, int wr, int wc, int fr_, int fq_) const {
        int fr = fr_, fq = fq_; asm volatile("" : "+v"(fr), "+v"(fq));
        float sc[8];
#pragma unroll
        for (int i = 0; i < 8; ++i) sc[i] = rq[row_base + u.pm * BM + (i >> 2) * HALF + wr * 64 + (i & 3) * 16 + fr];
#pragma unroll
        for (int bj = 0; bj < 2; ++bj) {
            const int c = u.pn * BM + bj * HALF + wc * 32 + 8 * fq; const int hc = c % QKD; const bool isr = hc >= 128; const int pi = (hc - 128) >> 1;
#pragma unroll
            for (int ai = 0; ai < 2; ++ai) {
                f32x4 t0[4], t1[4];
                if (isr) {
#pragma unroll
                    for (int m = 0; m < 4; ++m) { const int rr = row_base + u.pm * BM + ai * HALF + wr * 64 + m * 16 + fr; const int p = LEAD + (rr & (SEQ - 1));
                        const f32x4* tp = (const f32x4*)(rope + ((size_t)p * 32 + pi) * 2); t0[m] = tp[0]; t1[m] = tp[1]; }
                }
#pragma unroll
                for (int m = 0; m < 4; ++m) {
                    const int rl = u.pm * BM + ai * HALF + wr * 64 + m * 16 + fr; const float s = sc[ai * 4 + m];
                    f32x4 v0 = acc[ai][bj][m][0] * s, v1 = acc[ai][bj][m][1] * s;
                    if (isr) {
                        f32x4 o0, o1;
                        o0[0] = v0[0] * t0[m][0] - v0[1] * t0[m][1]; o0[1] = v0[1] * t0[m][0] + v0[0] * t0[m][1];
                        o0[2] = v0[2] * t0[m][2] - v0[3] * t0[m][3]; o0[3] = v0[3] * t0[m][2] + v0[2] * t0[m][3];
                        o1[0] = v1[0] * t1[m][0] - v1[1] * t1[m][1]; o1[1] = v1[1] * t1[m][0] + v1[0] * t1[m][1];
                        o1[2] = v1[2] * t1[m][2] - v1[3] * t1[m][3]; o1[3] = v1[3] * t1[m][2] + v1[2] * t1[m][3];
                        v0 = o0; v1 = o1;
                    }
                    *(u32x4*)(Q + (size_t)rl * 3072 + c) = pack8(v0, v1);
                }
            }
        }
    }
};
struct EpiScaleBf16 {
    static constexpr bool PERM = true, AFTER_DRAIN = false;
    bf16_t* O; int ldc; const float* rs; int row_base;
    __device__ __forceinline__ void operator()(const f32x4 (&acc)[2][2][4][2], const Unit& u, int wr, int wc, int fr_, int fq_) const {
        int fr = fr_, fq = fq_; asm volatile("" : "+v"(fr), "+v"(fq));
        float sc[8];
#pragma unroll
        for (int i = 0; i < 8; ++i) sc[i] = rs ? rs[row_base + u.pm * BM + (i >> 2) * HALF + wr * 64 + (i & 3) * 16 + fr] : 1.0f;
#pragma unroll
        for (int ai = 0; ai < 2; ++ai)
#pragma unroll
            for (int m = 0; m < 4; ++m) {
                const int rl = u.pm * BM + ai * HALF + wr * 64 + m * 16 + fr; const float s = sc[ai * 4 + m];
#pragma unroll
                for (int bj = 0; bj < 2; ++bj) { const int c = u.pn * BM + bj * HALF + wc * 32 + 8 * fq;
                    *(u32x4*)(O + (size_t)rl * ldc + c) = pack8(acc[ai][bj][m][0] * s, acc[ai][bj][m][1] * s); }
            }
    }
};
template <bool ACCUM> struct EpiGate {
    static constexpr bool PERM = true, AFTER_DRAIN = false;
    bf16_t* X; const bf16_t* G;
    __device__ __forceinline__ void operator()(const f32x4 (&acc)[2][2][4][2], const Unit& u, int wr, int wc, int fr_, int fq_) const {
        int fr = fr_, fq = fq_; asm volatile("" : "+v"(fr), "+v"(fq));
#pragma unroll
        for (int ai = 0; ai < 2; ++ai)
#pragma unroll
            for (int mh = 0; mh < 2; ++mh) {
                u32x4 g[2][2], x[2][2];
#pragma unroll
                for (int mm = 0; mm < 2; ++mm) { const size_t rl = (size_t)(u.pm * BM + ai * HALF + wr * 64 + (mh * 2 + mm) * 16 + fr);
#pragma unroll
                    for (int bj = 0; bj < 2; ++bj) { const int c = u.pn * BM + bj * HALF + wc * 32 + 8 * fq; g[mm][bj] = *(const u32x4*)(G + rl * DM + c); if (ACCUM) x[mm][bj] = *(const u32x4*)(X + rl * DM + c); } }
#pragma unroll
                for (int mm = 0; mm < 2; ++mm) { const int m = mh * 2 + mm; const size_t rl = (size_t)(u.pm * BM + ai * HALF + wr * 64 + m * 16 + fr);
#pragma unroll
                    for (int bj = 0; bj < 2; ++bj) { const int c = u.pn * BM + bj * HALF + wc * 32 + 8 * fq; const u32x4 gg = g[mm][bj];
                        f32x4 v0 = acc[ai][bj][m][0], v1 = acc[ai][bj][m][1];
                        v0[0] *= bflo(gg.x); v0[1] *= bfhi(gg.x); v0[2] *= bflo(gg.y); v0[3] *= bfhi(gg.y);
                        v1[0] *= bflo(gg.z); v1[1] *= bfhi(gg.z); v1[2] *= bflo(gg.w); v1[3] *= bfhi(gg.w);
                        if (ACCUM) { const u32x4 xx = x[mm][bj];
                            v0[0] += bflo(xx.x); v0[1] += bfhi(xx.x); v0[2] += bflo(xx.y); v0[3] += bfhi(xx.y);
                            v1[0] += bflo(xx.z); v1[1] += bfhi(xx.z); v1[2] += bflo(xx.w); v1[3] += bfhi(xx.w); }
                        *(u32x4*)(X + rl * DM + c) = pack8(v0, v1); } }
            }
    }
};
struct EpiResF32 {
    static constexpr bool PERM = false, AFTER_DRAIN = false;
    float* Y; const float* base; float alpha;
    __device__ __forceinline__ void operator()(const f32x4 (&acc)[2][2][4][2], const Unit& u, int wr, int wc, int fr_, int fq_) const {
        int fr = fr_, fq = fq_; asm volatile("" : "+v"(fr), "+v"(fq));
        const int col0 = u.pn * BM + wc * 32 + 4 * fq;
#pragma unroll
        for (int ai = 0; ai < 2; ++ai)
#pragma unroll
            for (int mh = 0; mh < 2; ++mh) {
                f32x4 bs[2][2][2];
#pragma unroll
                for (int mm = 0; mm < 2; ++mm) { const size_t off = (size_t)(u.pm * BM + ai * HALF + wr * 64 + (mh * 2 + mm) * 16 + fr) * DM + col0;
#pragma unroll
                    for (int bj = 0; bj < 2; ++bj)
#pragma unroll
                        for (int n = 0; n < 2; ++n) bs[mm][bj][n] = *(const f32x4*)(base + off + bj * HALF + n * 16); }
#pragma unroll
                for (int mm = 0; mm < 2; ++mm) { const int m = mh * 2 + mm; const size_t off = (size_t)(u.pm * BM + ai * HALF + wr * 64 + m * 16 + fr) * DM + col0;
#pragma unroll
                    for (int bj = 0; bj < 2; ++bj)
#pragma unroll
                        for (int n = 0; n < 2; ++n) *(f32x4*)(Y + off + bj * HALF + n * 16) = bs[mm][bj][n] * alpha + acc[ai][bj][m][n]; }
            }
    }
};

struct EpiNoStore {
    static constexpr bool PERM = true, AFTER_DRAIN = false;
    bf16_t* O; int flag;
    __device__ __forceinline__ void operator()(const f32x4 (&acc)[2][2][4][2], const Unit& u, int wr, int wc, int fr, int fq) const {
        f32x4 s = {0.f, 0.f, 0.f, 0.f};
#pragma unroll
        for (int ai = 0; ai < 2; ++ai)
#pragma unroll
            for (int bj = 0; bj < 2; ++bj)
#pragma unroll
                for (int m = 0; m < 4; ++m) { s += acc[ai][bj][m][0]; s += acc[ai][bj][m][1]; }
        if (flag) *(f32x4*)(O + (size_t)(u.pm * 256 + fr) * 64 + fq * 8) = s;
    }
};
}

namespace attn {
using bf16x8 = __attribute__((ext_vector_type(8))) short;
using u32x4 = __attribute__((ext_vector_type(4))) unsigned;
constexpr float SCALE = 0.07216878364870322f;
constexpr float THR = 8.f;
constexpr int SHM_V = 16384, SHM_K = 16384, SHM_R = 8192;
constexpr int OFF_V = 0, OFF_K = 2 * SHM_V, OFF_R = OFF_K + 2 * SHM_K, OFF_WS = OFF_R + 2 * SHM_R, LDS_USED = OFF_WS + 8 * 64 * 4;
#define KSWZ(row, colB) ((row) * 256 + ((colB) ^ (((row) & 7) << 4)))
#define RSWZ(row, colB) ((row) * 128 + ((colB) ^ (((row) & 7) << 4)))
#define SBAR() __builtin_amdgcn_sched_barrier(0)
__device__ __forceinline__ int crow(int r, int hi) { return (r & 3) + 8 * (r >> 2) + 4 * hi; }
__device__ __forceinline__ unsigned cvtpk(float lo, float hi) { unsigned r; asm volatile("v_cvt_pk_bf16_f32 %0, %1, %2" : "=v"(r) : "v"(lo), "v"(hi)); return r; }
__device__ __forceinline__ bf16x8 ld8(const bf16* p) { return *reinterpret_cast<const bf16x8*>(p); }

__device__ __forceinline__ void partialSM(f32x16& p0, f32x16& p1, float& m_reg, float& mn, float& alpha) {
  constexpr float C = SCALE * 1.4426950408889634f;
  float pmax = p0[0];
#pragma unroll
  for (int r = 1; r < 16; ++r) pmax = fmaxf(pmax, p0[r]);
#pragma unroll
  for (int r = 0; r < 16; ++r) pmax = fmaxf(pmax, p1[r]);
  { auto rr = __builtin_amdgcn_permlane32_swap(__float_as_uint(pmax), __float_as_uint(pmax), false, false);
    pmax = fmaxf(__uint_as_float(rr[0]), __uint_as_float(rr[1])); }
  if (__builtin_expect(__all(pmax - m_reg <= THR / SCALE), 1)) { mn = m_reg; alpha = 1.f; }
  else { mn = fmaxf(m_reg, pmax); alpha = __builtin_amdgcn_exp2f((m_reg - mn) * C); m_reg = mn; }
  float mnC = -mn * C;
#pragma unroll
  for (int r = 0; r < 16; ++r) p0[r] = fmaf(p0[r], C, mnC);
#pragma unroll
  for (int r = 0; r < 16; ++r) p1[r] = fmaf(p1[r], C, mnC);
#pragma unroll
  for (int r = 0; r < 16; ++r) p0[r] = __builtin_amdgcn_exp2f(p0[r]);
}
__device__ __forceinline__ void finishSM(f32x16& p0, f32x16& p1, float alpha, float& l_reg, bf16x8& pa0, bf16x8& pa1, bf16x8& pa2, bf16x8& pa3) {
#pragma unroll
  for (int r = 0; r < 16; ++r) p1[r] = __builtin_amdgcn_exp2f(p1[r]);
  float ps = 0;
#pragma unroll
  for (int r = 0; r < 16; ++r) ps += p0[r];
#pragma unroll
  for (int r = 0; r < 16; ++r) ps += p1[r];
  { auto rr = __builtin_amdgcn_permlane32_swap(__float_as_uint(ps), __float_as_uint(ps), false, false);
    ps = __uint_as_float(rr[0]) + __uint_as_float(rr[1]); }
  l_reg = l_reg * alpha + ps;
#define PK4(P, BASE, OUT) do { unsigned a0 = cvtpk(P[BASE + 0], P[BASE + 1]), a1 = cvtpk(P[BASE + 2], P[BASE + 3]);   \
    unsigned b0 = cvtpk(P[BASE + 4], P[BASE + 5]), b1 = cvtpk(P[BASE + 6], P[BASE + 7]);                              \
    auto r0 = __builtin_amdgcn_permlane32_swap(a0, b0, false, false); auto r1 = __builtin_amdgcn_permlane32_swap(a1, b1, false, false); \
    u32x4 w = {r0[0], r1[0], r0[1], r1[1]}; OUT = *reinterpret_cast<bf16x8*>(&w); } while (0)
  PK4(p0, 0, pa0); PK4(p0, 8, pa1); PK4(p1, 0, pa2); PK4(p1, 8, pa3);
#undef PK4
}
__device__ __forceinline__ void qkt(f32x16& p0, f32x16& p1, const char* Ks, const char* Rs, const bf16x8* qr, int r32, int hi) {
  p0 = f32x16{}; p1 = f32x16{};
#pragma unroll
  for (int d0 = 0; d0 < 8; ++d0) { int cb = (d0 * 16 + hi * 8) * 2;
    bf16x8 b0 = *reinterpret_cast<const bf16x8*>(Ks + KSWZ(r32, cb));
    bf16x8 b1 = *reinterpret_cast<const bf16x8*>(Ks + KSWZ(32 + r32, cb));
    p0 = __builtin_amdgcn_mfma_f32_32x32x16_bf16(b0, qr[d0], p0, 0, 0, 0);
    p1 = __builtin_amdgcn_mfma_f32_32x32x16_bf16(b1, qr[d0], p1, 0, 0, 0); }
#pragma unroll
  for (int d0 = 0; d0 < 4; ++d0) { int cb = (d0 * 16 + hi * 8) * 2;
    bf16x8 b0 = *reinterpret_cast<const bf16x8*>(Rs + RSWZ(r32, cb));
    bf16x8 b1 = *reinterpret_cast<const bf16x8*>(Rs + RSWZ(32 + r32, cb));
    p0 = __builtin_amdgcn_mfma_f32_32x32x16_bf16(b0, qr[8 + d0], p0, 0, 0, 0);
    p1 = __builtin_amdgcn_mfma_f32_32x32x16_bf16(b1, qr[8 + d0], p1, 0, 0, 0); }
}
__device__ __forceinline__ void amask(f32x16& p0, f32x16& p1, int t, int NT, int qrel, int hi) {
  const float NEG = -INFINITY;
  if (t == 0) {
#pragma unroll
    for (int r = 0; r < 16; ++r) p0[r] = NEG;
#pragma unroll
    for (int r = 0; r < 8; ++r) p1[r] = NEG;
  } else if (t >= NT - 4) {
    const int d = qrel - 64 * (t - (NT - 4)) - 4 * hi;
#pragma unroll
    for (int r = 0; r < 16; ++r) { if ((r & 3) + 8 * (r >> 2) > d) p0[r] = NEG; if ((r & 3) + 8 * (r >> 2) + 32 > d) p1[r] = NEG; }
  }
}
__device__ __forceinline__ int v_st(int k, int c) { const int kk = (k & ~0xC) | ((k & 4) << 1) | ((k & 8) >> 1); return ((kk >> 3) * 4 + (c >> 5)) * 512 + ((kk & 7) * 32 + (c & 31)) * 2; }
__device__ __forceinline__ int v_rd_base(int lane) { return ((lane & 3) << 3) | (((lane >> 2) & 3) << 6) | (((lane >> 4) & 1) << 5) | (((lane >> 5) & 1) << 8); }
constexpr int v_rd_off(int d0, int ks, int half) { return d0 * 512 + ks * 4096 + half * 2048; }
template <int OFF> __device__ __forceinline__ s16x4 tr_read(int vb) {
  s16x4 r; asm volatile("ds_read_b64_tr_b16 %0, %1 offset:%2" : "=&v"(r) : "v"(vb), "i"(OFF) : "memory"); return r;
}
template <int D0> __device__ __forceinline__ void pv_one(f32x16& od, int vb, bf16x8 pa0, bf16x8 pa1, bf16x8 pa2, bf16x8 pa3) {
  const s16x4 l0 = tr_read<v_rd_off(D0, 0, 0)>(vb), h0 = tr_read<v_rd_off(D0, 0, 1)>(vb), l1 = tr_read<v_rd_off(D0, 1, 0)>(vb), h1 = tr_read<v_rd_off(D0, 1, 1)>(vb);
  const s16x4 l2 = tr_read<v_rd_off(D0, 2, 0)>(vb), h2 = tr_read<v_rd_off(D0, 2, 1)>(vb), l3 = tr_read<v_rd_off(D0, 3, 0)>(vb), h3 = tr_read<v_rd_off(D0, 3, 1)>(vb);
  asm volatile("s_waitcnt lgkmcnt(0)" ::: "memory"); SBAR();
#define PK(L, H) (bf16x8){L[0], L[1], L[2], L[3], H[0], H[1], H[2], H[3]}
  od = __builtin_amdgcn_mfma_f32_32x32x16_bf16(pa0, PK(l0, h0), od, 0, 0, 0);
  od = __builtin_amdgcn_mfma_f32_32x32x16_bf16(pa1, PK(l1, h1), od, 0, 0, 0);
  od = __builtin_amdgcn_mfma_f32_32x32x16_bf16(pa2, PK(l2, h2), od, 0, 0, 0);
  od = __builtin_amdgcn_mfma_f32_32x32x16_bf16(pa3, PK(l3, h3), od, 0, 0, 0);
#undef PK
}
__device__ __forceinline__ void pv_d0(f32x16* o, int vb, bf16x8 pa0, bf16x8 pa1, bf16x8 pa2, bf16x8 pa3) {
  pv_one<0>(o[0], vb, pa0, pa1, pa2, pa3); pv_one<1>(o[1], vb, pa0, pa1, pa2, pa3); pv_one<2>(o[2], vb, pa0, pa1, pa2, pa3); pv_one<3>(o[3], vb, pa0, pa1, pa2, pa3);
}

__device__ __forceinline__ void attn_unit(const bf16* __restrict__ Qb, const bf16* __restrict__ Kh, const bf16* __restrict__ Rh, bf16* __restrict__ Ob, int NT, char* lds) {
  int tid_ = threadIdx.x; asm volatile("" : "+v"(tid_));
  const int tid = tid_, wid = tid >> 6, lane = tid & 63, r32 = lane & 31, hi = lane >> 5;
  const bf16* Vh = Kh + 128;
  char* V_lds = lds + OFF_V; char* K_lds = lds + OFF_K; char* R_lds = lds + OFF_R;
  float* ws = (float*)(lds + OFF_WS) + wid * 64; float* li_l = ws; float* al_l = ws + 32;
  float m_reg = -1e30f, l_reg = 0; f32x16 o[4] = {}; bf16x8 qr[12];
  const bf16* Qw = Qb + (long)(wid * 32 + r32) * 3072 + hi * 8;
#pragma unroll
  for (int d0 = 0; d0 < 12; ++d0) qr[d0] = ld8(Qw + d0 * 16);
  const int sr = tid >> 4, sc = (tid & 15) * 8, vst0 = v_st(sr, sc), vst1 = v_st(32 + sr, sc);
  const int rrow = tid >> 3, rcol = (tid & 7) * 8;
  const int vb0 = (int)(uintptr_t)V_lds + v_rd_base(lane);
  const int qrel = wid * 32 + r32;
  bf16x8 vs0, vs1, ks0, ks1, rs0;
#define SLOAD(k0) do { vs0 = ld8(&Vh[(long)((k0) + sr) * 4096 + sc]); vs1 = ld8(&Vh[(long)((k0) + 32 + sr) * 4096 + sc]); \
    ks0 = ld8(&Kh[(long)((k0) + sr) * 4096 + sc]); ks1 = ld8(&Kh[(long)((k0) + 32 + sr) * 4096 + sc]); rs0 = ld8(&Rh[(long)((k0) + rrow) * 64 + rcol]); } while (0)
#define SWRITE(b) do { *(bf16x8*)(V_lds + (b) * SHM_V + vst0) = vs0; *(bf16x8*)(V_lds + (b) * SHM_V + vst1) = vs1; const int kc = sc * 2; \
    *(bf16x8*)(K_lds + (b) * SHM_K + KSWZ(sr, kc)) = ks0; *(bf16x8*)(K_lds + (b) * SHM_K + KSWZ(32 + sr, kc)) = ks1; \
    *(bf16x8*)(R_lds + (b) * SHM_R + RSWZ(rrow, rcol * 2)) = rs0; } while (0)
#define SWAIT() asm volatile("s_waitcnt vmcnt(0)" ::: "memory")
#define RESC(a) do { if (__any((a) < 1.f)) { if (hi == 0) al_l[r32] = (a); asm volatile("s_waitcnt lgkmcnt(0)" ::: "memory"); \
    _Pragma("unroll") for (int d = 0; d < 4; ++d) _Pragma("unroll") for (int r = 0; r < 16; ++r) o[d][r] *= al_l[crow(r, hi)]; } } while (0)
  f32x16 pA0, pA1, pB0, pB1; float mnA, mnB, alA, alB; bf16x8 pa0, pa1, pa2, pa3;
  SLOAD(0); SWAIT(); SWRITE(0); __syncthreads();
  qkt(pA0, pA1, K_lds, R_lds, qr, r32, hi); amask(pA0, pA1, 0, NT, qrel, hi); partialSM(pA0, pA1, m_reg, mnA, alA);
  SLOAD(64); SWAIT(); SWRITE(1); __syncthreads();
  for (int j = 1; j + 1 < NT; j += 2) {
    SBAR(); qkt(pB0, pB1, K_lds + SHM_K, R_lds + SHM_R, qr, r32, hi); amask(pB0, pB1, j, NT, qrel, hi);
    finishSM(pA0, pA1, alA, l_reg, pa0, pa1, pa2, pa3); SBAR();
    SLOAD((j + 1) * 64); SBAR();
    pv_d0(o, vb0, pa0, pa1, pa2, pa3); partialSM(pB0, pB1, m_reg, mnB, alB);
    __syncthreads(); SWAIT(); SWRITE(0);
    RESC(alB); __syncthreads();
    SBAR(); qkt(pA0, pA1, K_lds, R_lds, qr, r32, hi); amask(pA0, pA1, j + 1, NT, qrel, hi);
    finishSM(pB0, pB1, alB, l_reg, pa0, pa1, pa2, pa3); SBAR();
    const bool more = (j + 2 < NT);
    if (more) SLOAD((j + 2) * 64);
    SBAR();
    pv_d0(o, vb0 + SHM_V, pa0, pa1, pa2, pa3); partialSM(pA0, pA1, m_reg, mnA, alA);
    __syncthreads(); SWAIT(); if (more) SWRITE(1);
    RESC(alA); __syncthreads();
  }
  finishSM(pA0, pA1, alA, l_reg, pa0, pa1, pa2, pa3); SBAR();
  pv_d0(o, vb0, pa0, pa1, pa2, pa3);
  if (hi == 0) li_l[r32] = l_reg; asm volatile("s_waitcnt lgkmcnt(0)" ::: "memory");
  float rli[16];
#pragma unroll
  for (int r = 0; r < 16; ++r) rli[r] = __builtin_amdgcn_rcpf(li_l[crow(r, hi)]);
  __syncthreads();
  { unsigned short* stg = (unsigned short*)(lds + wid * 8192);
#pragma unroll
    for (int r = 0; r < 16; ++r) { const int orow = crow(r, hi);
#pragma unroll
      for (int d0 = 0; d0 < 4; ++d0) stg[orow * 128 + d0 * 32 + r32] = (unsigned short)f2bf(o[d0][r] * rli[r]); }
    asm volatile("s_waitcnt lgkmcnt(0)" ::: "memory");
#pragma unroll
    for (int i = 0; i < 8; ++i) { const int row = i * 4 + (lane >> 4), ch = lane & 15;
      const u32x4 v = *(const u32x4*)(stg + row * 128 + ch * 8); *(u32x4*)(Ob + (long)(wid * 32 + row) * 2048 + ch * 8) = v; } }
  __syncthreads();
#undef SLOAD
#undef SWRITE
#undef SWAIT
#undef RESC
}
#undef KSWZ
#undef RSWZ
#undef SBAR
}


struct Params {
    const float* in[20];
    float* out; unsigned char* ws;
    int ph_lo, ph_hi;
};
enum { I_X = 0, I_META, I_LBL, I_WIN, I_QG, I_KVG, I_WUQ, I_WUKV, I_HGG, I_WPH, I_WPM, I_WO, I_LN1G, I_LN1B, I_PQ, I_SK, I_PU, I_PV, I_LN2G, I_LN2B };

struct Ctx { LAS unsigned char* lds; int tid, lane, wave, G, bid, vcu; };

template <class CM> __device__ __forceinline__ void transpose_w(const float* __restrict__ W, int K, int N, int NP, bf16* __restrict__ WT, const float* __restrict__ ks, LAS float* scr, int gw, int NGW, int lane, CM cm) {
    const int nblk = NP / 32, items = (K / 64) * nblk;
    for (int it = gw; it < items; it += NGW) {
        const int kb = it / nblk, nb = it % nblk, k0 = 64 * kb, n0 = 32 * nb;
        const int scol = cm(n0 + (lane & 31));
#pragma unroll 16
        for (int i = 0; i < 32; ++i) { const int kk = 2 * i + (lane >> 5); float v = scol >= 0 ? W[(size_t)(k0 + kk) * N + scol] : 0.f; if (ks) v *= ks[k0 + kk]; scr[kk * 33 + (lane & 31)] = v; }
        asm volatile("s_waitcnt lgkmcnt(0)" ::: "memory");
        const int c = lane & 7;
#pragma unroll
        for (int j = 0; j < 4; ++j) { const int n = (lane >> 3) + 8 * j; const LAS float* s = scr + (8 * c) * 33 + n;
            v4u o; o.x = pk2(s[0 * 33], s[1 * 33]); o.y = pk2(s[2 * 33], s[3 * 33]); o.z = pk2(s[4 * 33], s[5 * 33]); o.w = pk2(s[6 * 33], s[7 * 33]);
            *(v4u*)(WT + (size_t)(n0 + n) * K + k0 + 8 * c) = o; }
        asm volatile("s_waitcnt lgkmcnt(0)" ::: "memory");
    }
}
__device__ __forceinline__ int rope_src(int j) { return (j & 1) ? 32 + (j >> 1) : (j >> 1); }

__device__ __forceinline__ void cvt_rows(const float* __restrict__ src, bf16* __restrict__ dst, size_t n8, size_t gt, size_t NGT) {
    for (size_t i = gt; i < n8; i += NGT) { const pg8::f32x4 a = *(const pg8::f32x4*)(src + i * 8), b = *(const pg8::f32x4*)(src + i * 8 + 4);
        v4u o; o.x = pk2(a[0], a[1]); o.y = pk2(a[2], a[3]); o.z = pk2(b[0], b[1]); o.w = pk2(b[2], b[3]); *(v4u*)(dst + i * 8) = o; }
}


__device__ __forceinline__ void late_weights(const Params& P, const Ctx& C, int gw, int NGW, size_t gt, size_t NGT, int part  ) {
    LAS float* scr = (LAS float*)(C.lds + C.wave * 16384);
    unsigned char* ws = P.ws;
#define ROT(k) ((gw + (k) * (NGW / 6)) % NGW)
    if (part & 1) {
    transpose_w(P.in[I_WUQ], QR, 3072, 3072, (bf16*)(ws + WS_WUQ), P.in[I_QG], scr, ROT(0), NGW, C.lane,
        [](int n) { const int h = n / QKD, c = n - h * QKD; return c < 128 ? n : h * QKD + 128 + rope_src(c - 128); });
    transpose_w(P.in[I_WUKV], KVR, 4096, 4096, (bf16*)(ws + WS_WUKV), P.in[I_KVG], scr, ROT(1), NGW, C.lane, [](int n) { return n; });
    }
    if (part & 2) {
    transpose_w(P.in[I_WPH], 1024, 1024, 1024, (bf16*)(ws + WS_WPH), nullptr, scr, ROT(2), NGW, C.lane, [](int n) { return n; });
    transpose_w(P.in[I_WPM], 2048, 1024, 1024, (bf16*)(ws + WS_WPM), nullptr, scr, ROT(3), NGW, C.lane, [](int n) { return n; });
    transpose_w(P.in[I_WO], 1024, 1024, 1024, (bf16*)(ws + WS_WO), nullptr, scr, ROT(4), NGW, C.lane, [](int n) { return n; });
    transpose_w(P.in[I_PQ], 1024, 2048, 2048, (bf16*)(ws + WS_WPQ), nullptr, scr, ROT(5), NGW, C.lane, [](int n) { return n; });
    cvt_rows(P.in[I_SK], (bf16*)(ws + WS_SK), (size_t)16 * 128 * 128 / 8, gt, NGT);
    }
#undef ROT
}

__device__ __forceinline__ void p0_prologue(const Params& P, const Ctx& C) {
    LAS float* scr = (LAS float*)(C.lds + C.wave * 16384);
    const int gw = C.vcu * 8 + C.wave, NGW = C.G * 8;
    unsigned char* ws = P.ws;
    transpose_w(P.in[I_WIN], DM, INW, INWP, (bf16*)(ws + WS_WIN), nullptr, scr, gw, NGW, C.lane,
        [](int n) { return n < 4736 ? n : n < N1V ? 4736 + rope_src(n - 4736) : n < N1 ? -1 : N1V + (n - N1); });
    const size_t gt = (size_t)C.vcu * 512 + C.tid, NGT = (size_t)C.G * 512;
    { bf16* H = (bf16*)(ws + WS_A); const float* x = P.in[I_X]; const float* meta = P.in[I_META];
      constexpr size_t NI = (size_t)MV * (DM / 8);
      for (size_t i0 = gt; i0 < NI; i0 += 4 * NGT) {
          pg8::f32x4 a[4], bb[4]; bool act[4];
#pragma unroll
          for (int u = 0; u < 4; ++u) { const size_t i = i0 + (size_t)u * NGT; act[u] = i < NI; a[u] = (pg8::f32x4){0.f, 0.f, 0.f, 0.f}; bb[u] = a[u];
              if (act[u]) { const int Rc = (int)(i >> 7), c8 = (int)(i & 127) * 8; const int b = Rc / PV, q = Rc - b * PV;
                  const float* s = q >= 16 ? x + ((size_t)b * SEQ + (q - 16)) * DM + c8 : meta + (size_t)q * DM + c8; a[u] = *(const pg8::f32x4*)s; bb[u] = *(const pg8::f32x4*)(s + 4); } }
#pragma unroll
          for (int u = 0; u < 4; ++u) if (act[u]) { const size_t i = i0 + (size_t)u * NGT; v4u o; o.x = pk2(a[u][0], a[u][1]); o.y = pk2(a[u][2], a[u][3]); o.z = pk2(bb[u][0], bb[u][1]); o.w = pk2(bb[u][2], bb[u][3]); *(v4u*)(H + i * 8) = o; }
      } }
    { bf16* HQ = (bf16*)(ws + WS_HQ); bf16* K1 = (bf16*)(ws + WS_K1); bf16* HI = (bf16*)(ws + WS_HI); bf16* CKV = (bf16*)(ws + WS_CKV);
      const v4u z = {0u, 0u, 0u, 0u};
      for (size_t i = gt; i < (size_t)NB * 48 * 128; i += NGT) { const int b = (int)(i / (48 * 128)), r = (int)(i % (48 * 128)); const size_t off = ((size_t)b * PP + 64) * DM + (size_t)r * 8;
          *(v4u*)(HQ + off) = z; *(v4u*)(K1 + off) = z; *(v4u*)(HI + off) = z; }
      for (size_t i = gt; i < (size_t)NB * 48 * 32; i += NGT) { const int b = (int)(i / (48 * 32)), r = (int)(i % (48 * 32)); *(v4u*)(CKV + ((size_t)b * PP + 64) * KVR + (size_t)r * 8) = z; } }
    { float* T = (float*)(ws + WS_ROPE);
      for (size_t i = gt; i < (size_t)PP * 32; i += NGT) { const int p = (int)(i >> 5), k = (int)(i & 31);
          const float ang = (float)(p - NPADR) * exp2f(-(float)k * 0.4152410118609203f);
          const double rev = (double)ang * 0.15915494309189535; const float fr = (float)(rev - floor(rev));
          T[i * 2] = __builtin_amdgcn_cosf(fr); T[i * 2 + 1] = __builtin_amdgcn_sinf(fr); } }
}

__device__ __forceinline__ float sq8(const v4u w) {
    return bflo(w.x) * bflo(w.x) + bfhi(w.x) * bfhi(w.x) + bflo(w.y) * bflo(w.y) + bfhi(w.y) * bfhi(w.y) + bflo(w.z) * bflo(w.z) + bfhi(w.z) * bfhi(w.z) + bflo(w.w) * bflo(w.w) + bfhi(w.w) * bfhi(w.w);
}
template <int W> __device__ __forceinline__ void rowstat_rows(const bf16* __restrict__ X, float* __restrict__ out, int nrows, int gw, int NGW, int lane) {
    const int g = lane >> 4, l16 = lane & 15;
    for (int r0 = gw * 8; r0 < nrows; r0 += NGW * 8) {
        v4u a[2][W / 128];
#pragma unroll
        for (int u = 0; u < 2; ++u) { const int r = r0 + u * 4 + g;
#pragma unroll
            for (int j = 0; j < W / 128; ++j) a[u][j] = r < nrows ? *(const v4u*)(X + (size_t)r * W + (l16 + 16 * j) * 8) : (v4u){0u, 0u, 0u, 0u}; }
#pragma unroll
        for (int u = 0; u < 2; ++u) { const int r = r0 + u * 4 + g; float s = 0.f;
#pragma unroll
            for (int j = 0; j < W / 128; ++j) s += sq8(a[u][j]);
            s += __shfl_xor(s, 1); s += __shfl_xor(s, 2); s += __shfl_xor(s, 4); s += __shfl_xor(s, 8);
            if (l16 == 0 && r < nrows) out[r] = 1.0f / sqrtf(s * (1.0f / W) + EPS); }
    }
}
__device__ __forceinline__ void rowstats(const Params& P, const Ctx& C, int gw, int NGW) {
    rowstat_rows<QR>((const bf16*)(P.ws + WS_CQ), (float*)(P.ws + WS_RQ), MR, gw, NGW, C.lane);
    rowstat_rows<KVR>((const bf16*)(P.ws + WS_CKV), (float*)(P.ws + WS_RKV), MALL, gw, NGW, C.lane);
}

__device__ __forceinline__ void hgrn_item(const Params& P, const Ctx& C, int item) {
    const int b = item >> 3, h = item & 7, tid = C.tid, v = tid & 127, kq = tid >> 7;
    LAS float* fq = (LAS float*)C.lds; LAS float* ff = fq + 2048; LAS float* fk = ff + 2048; LAS float* fi = fk + 2048; LAS float* opart = fi + 2048;
    const bf16* HQ = (const bf16*)(P.ws + WS_HQ); const bf16* K1 = (const bf16*)(P.ws + WS_K1); const bf16* HI = (const bf16*)(P.ws + WS_HI); const bf16* HG = (const bf16*)(P.ws + WS_HG);
    bf16* ON = (bf16*)(P.ws + WS_ON); const float* gain = P.in[I_HGG];
    float S[32];
#pragma unroll
    for (int j = 0; j < 32; ++j) S[j] = 0.f;
    const int lt = tid >> 5, c4 = (tid & 31) * 4;
    for (int ch = NPADR / 16; ch < PP / 16; ++ch) {
        const int p0 = ch * 16;
        { const size_t off = ((size_t)b * PP + p0 + lt) * DM + h * 128 + c4;
          const v2u q = *(const v2u*)(HQ + off), k = *(const v2u*)(K1 + off), iv = *(const v2u*)(HI + off);
          const int o = lt * 128 + c4;
          fq[o] = bflo(q.x); fq[o + 1] = bfhi(q.x); fq[o + 2] = bflo(q.y); fq[o + 3] = bfhi(q.y);
          const float k0 = bflo(k.x), k1 = bfhi(k.x), k2 = bflo(k.y), k3 = bfhi(k.y);
          fk[o] = k0; fk[o + 1] = k1; fk[o + 2] = k2; fk[o + 3] = k3;
          ff[o] = 1.f - k0; ff[o + 1] = 1.f - k1; ff[o + 2] = 1.f - k2; ff[o + 3] = 1.f - k3;
          fi[o] = bflo(iv.x); fi[o + 1] = bfhi(iv.x); fi[o + 2] = bflo(iv.y); fi[o + 3] = bfhi(iv.y); }
        __syncthreads();
#pragma unroll 2
        for (int t = 0; t < 16; ++t) {
            const float ivv = fi[t * 128 + v]; float op = 0.f;
            const LAS pg8::f32x4* f4 = (const LAS pg8::f32x4*)(ff + t * 128 + kq * 32);
            const LAS pg8::f32x4* k4 = (const LAS pg8::f32x4*)(fk + t * 128 + kq * 32);
            const LAS pg8::f32x4* q4 = (const LAS pg8::f32x4*)(fq + t * 128 + kq * 32);
#pragma unroll
            for (int j4 = 0; j4 < 8; ++j4) { const pg8::f32x4 fv = f4[j4], kv = k4[j4], qv = q4[j4];
#pragma unroll
                for (int e = 0; e < 4; ++e) { const float s = fmaf(fv[e], S[j4 * 4 + e], kv[e] * ivv); S[j4 * 4 + e] = s; op = fmaf(qv[e], s, op); } }
            opart[(t * 4 + kq) * 128 + v] = op;
        }
        __syncthreads();
        { pg8::f32x4 o = *(const LAS pg8::f32x4*)(opart + (lt * 4 + 0) * 128 + c4);
          o += *(const LAS pg8::f32x4*)(opart + (lt * 4 + 1) * 128 + c4); o += *(const LAS pg8::f32x4*)(opart + (lt * 4 + 2) * 128 + c4); o += *(const LAS pg8::f32x4*)(opart + (lt * 4 + 3) * 128 + c4);
          float ss = o[0] * o[0] + o[1] * o[1] + o[2] * o[2] + o[3] * o[3];
#pragma unroll
          for (int m = 1; m < 32; m <<= 1) ss += __shfl_xor(ss, m);
          const int p = p0 + lt;
          if (p >= LEAD) { const float rstd = 1.0f / sqrtf(ss * (1.0f / 128.f) + EPS); const size_t rr = (size_t)b * SEQ + (p - LEAD);
              const v2u g = *(const v2u*)(HG + rr * DM + h * 128 + c4); const pg8::f32x4 gn = *(const pg8::f32x4*)(gain + h * 128 + c4);
              v2u w; w.x = pk2(o[0] * rstd * gn[0] * bflo(g.x), o[1] * rstd * gn[1] * bfhi(g.x)); w.y = pk2(o[2] * rstd * gn[2] * bflo(g.y), o[3] * rstd * gn[3] * bfhi(g.y));
              *(v2u*)(ON + rr * DM + h * 128 + c4) = w; } }
    }
    __syncthreads();
}


__device__ __forceinline__ void hgrn_item2(const Params& P, const Ctx& C, int item) {
    typedef short bf16x8v __attribute__((ext_vector_type(8)));
    int tid_ = threadIdx.x; asm volatile("" : "+v"(tid_));
    const int tid = tid_, lane = tid & 63, w = C.wave, fr = lane & 15, g = lane >> 4;
    const int b = item >> 3, h = item & 7;
    constexpr int SQ = 272, SP = 144;
    constexpr int O_QD = 0, O_KI = 17408, O_KST = 34816, O_IT = 53248, O_P = 71680, O_ST = 80896, O_SEG = 115712, O_DEC = 119808;
    LAS unsigned char* L = C.lds;
    const bf16* HQ = (const bf16*)(P.ws + WS_HQ); const bf16* K1 = (const bf16*)(P.ws + WS_K1); const bf16* HI = (const bf16*)(P.ws + WS_HI); const bf16* HG = (const bf16*)(P.ws + WS_HG);
    bf16* ON = (bf16*)(P.ws + WS_ON); const float* gain = P.in[I_HGG];
    const int kp = tid & 63;
    for (int i = tid; i < 34816 / 16; i += 512) *(LAS v4u*)(L + O_ST + i * 16) = (v4u){0u, 0u, 0u, 0u};
    pg8::f32x4 S[8];
#pragma unroll
    for (int j = 0; j < 8; ++j) S[j] = (pg8::f32x4){0.f, 0.f, 0.f, 0.f};
    unsigned rq[8], rk[8], ri[8];
    const size_t colbase = (size_t)h * 128 + 2 * kp;
#define LOADRAW(c) do { const size_t r0_ = ((size_t)b * PP + 64 + 64 * (c) + 8 * w) * DM + colbase; \
        _Pragma("unroll") for (int i = 0; i < 8; ++i) { rq[i] = *(const unsigned*)(HQ + r0_ + (size_t)i * DM); rk[i] = *(const unsigned*)(K1 + r0_ + (size_t)i * DM); ri[i] = *(const unsigned*)(HI + r0_ + (size_t)i * DM); } } while (0)
    LOADRAW(0);
    __syncthreads();
#pragma unroll 1
    for (int c = 0; c < 33; ++c) {
        float cum0[8], cum1[8], ka[8], kb[8]; float cs0 = 0.f, cs1 = 0.f;
#pragma unroll
        for (int i = 0; i < 8; ++i) { const bool valid = (64 + 64 * c + 8 * w + i) >= NPADR; const float k0 = valid ? bflo(rk[i]) : 0.f, k1 = valid ? bfhi(rk[i]) : 0.f; ka[i] = k0; kb[i] = k1;
            cs0 += __builtin_amdgcn_logf(1.0f - k0); cs1 += __builtin_amdgcn_logf(1.0f - k1); cum0[i] = cs0; cum1[i] = cs1; }
        *(LAS f32x2*)(L + O_SEG + (w * 128 + 2 * kp) * 4) = (f32x2){cs0, cs1};
        { v4u w0, w1;
          w0.x = (ri[0] & 0xffffu) | (ri[1] << 16); w0.y = (ri[2] & 0xffffu) | (ri[3] << 16); w0.z = (ri[4] & 0xffffu) | (ri[5] << 16); w0.w = (ri[6] & 0xffffu) | (ri[7] << 16);
          w1.x = (ri[0] >> 16) | (ri[1] & 0xffff0000u); w1.y = (ri[2] >> 16) | (ri[3] & 0xffff0000u); w1.z = (ri[4] >> 16) | (ri[5] & 0xffff0000u); w1.w = (ri[6] >> 16) | (ri[7] & 0xffff0000u);
          *(LAS v4u*)(L + O_IT + (2 * kp) * SP + w * 16) = w0; *(LAS v4u*)(L + O_IT + (2 * kp + 1) * SP + w * 16) = w1; }
        __syncthreads();
        { float p0 = 0.f, p1 = 0.f, t0 = 0.f, t1 = 0.f;
#pragma unroll
          for (int j = 0; j < 8; ++j) { const f32x2 sj = *(const LAS f32x2*)(L + O_SEG + (j * 128 + 2 * kp) * 4); t0 += sj[0]; t1 += sj[1]; if (j < w) { p0 += sj[0]; p1 += sj[1]; } }
          const float d0 = __builtin_amdgcn_exp2f(t0), d1 = __builtin_amdgcn_exp2f(t1);
          float ks0[8], ks1[8];
#pragma unroll
          for (int i = 0; i < 8; ++i) { const float e0 = __builtin_amdgcn_exp2f(p0 + cum0[i]), e1 = __builtin_amdgcn_exp2f(p1 + cum1[i]);
              const float ki0 = ka[i] * __builtin_amdgcn_rcpf(e0), ki1 = kb[i] * __builtin_amdgcn_rcpf(e1);
              const int t = 8 * w + i;
              *(LAS unsigned*)(L + O_QD + t * SQ + kp * 4) = pg8::cvt_pk_bf16(bflo(rq[i]) * e0, bfhi(rq[i]) * e1);
              *(LAS unsigned*)(L + O_KI + t * SQ + kp * 4) = pg8::cvt_pk_bf16(ki0, ki1);
              ks0[i] = ki0 * d0; ks1[i] = ki1 * d1; }
          *(LAS v4u*)(L + O_KST + (2 * kp) * SP + w * 16) = (v4u){pg8::cvt_pk_bf16(ks0[0], ks0[1]), pg8::cvt_pk_bf16(ks0[2], ks0[3]), pg8::cvt_pk_bf16(ks0[4], ks0[5]), pg8::cvt_pk_bf16(ks0[6], ks0[7])};
          *(LAS v4u*)(L + O_KST + (2 * kp + 1) * SP + w * 16) = (v4u){pg8::cvt_pk_bf16(ks1[0], ks1[1]), pg8::cvt_pk_bf16(ks1[2], ks1[3]), pg8::cvt_pk_bf16(ks1[4], ks1[5]), pg8::cvt_pk_bf16(ks1[6], ks1[7])};
          if (w == 0) *(LAS f32x2*)(L + O_DEC + (2 * kp) * 4) = (f32x2){d0, d1}; }
        if (c + 1 < 33) LOADRAW(c + 1);
        __syncthreads();
#pragma unroll
        for (int q = 0; q < 2; ++q) { const int ti = 2 * w + q, tr = ti >> 2, sc = ti & 3;
            pg8::f32x4 acc = (pg8::f32x4){0.f, 0.f, 0.f, 0.f};
            if (sc <= tr) {
#pragma unroll
                for (int kk = 0; kk < 4; ++kk) { const bf16x8v a = *(const LAS bf16x8v*)(L + O_QD + (tr * 16 + fr) * SQ + kk * 64 + g * 16), bb = *(const LAS bf16x8v*)(L + O_KI + (sc * 16 + fr) * SQ + kk * 64 + g * 16);
                    acc = __builtin_amdgcn_mfma_f32_16x16x32_bf16(a, bb, acc, 0, 0, 0); }
            }
#pragma unroll
            for (int r = 0; r < 4; ++r) { const float v = (sc < tr || (sc == tr && fr <= 4 * g + r)) ? acc[r] : 0.f;
                *(LAS unsigned short*)(L + O_P + (tr * 16 + 4 * g + r) * SP + (sc * 16 + fr) * 2) = (unsigned short)f2bf(v); } }
        __syncthreads();
        pg8::f32x4 oacc[4];
        { const int tr = w >> 1, vb0 = (w & 1) * 4;
#pragma unroll
          for (int j = 0; j < 4; ++j) oacc[j] = (pg8::f32x4){0.f, 0.f, 0.f, 0.f};
#pragma unroll
          for (int kk = 0; kk < 2; ++kk) if (32 * kk <= 16 * tr + 15) { const bf16x8v a = *(const LAS bf16x8v*)(L + O_P + (tr * 16 + fr) * SP + kk * 64 + g * 16);
#pragma unroll
              for (int j = 0; j < 4; ++j) { const bf16x8v bb = *(const LAS bf16x8v*)(L + O_IT + ((vb0 + j) * 16 + fr) * SP + kk * 64 + g * 16); oacc[j] = __builtin_amdgcn_mfma_f32_16x16x32_bf16(a, bb, oacc[j], 0, 0, 0); } }
#pragma unroll
          for (int kk = 0; kk < 4; ++kk) { const bf16x8v a = *(const LAS bf16x8v*)(L + O_QD + (tr * 16 + fr) * SQ + kk * 64 + g * 16);
#pragma unroll
              for (int j = 0; j < 4; ++j) { const bf16x8v bb = *(const LAS bf16x8v*)(L + O_ST + ((vb0 + j) * 16 + fr) * SQ + kk * 64 + g * 16); oacc[j] = __builtin_amdgcn_mfma_f32_16x16x32_bf16(a, bb, oacc[j], 0, 0, 0); } } }
        { const pg8::f32x4 dv = *(const LAS pg8::f32x4*)(L + O_DEC + (16 * w + 4 * g) * 4);
#pragma unroll
          for (int j = 0; j < 8; ++j) S[j] = S[j] * dv;
#pragma unroll
          for (int kk = 0; kk < 2; ++kk) { const bf16x8v a = *(const LAS bf16x8v*)(L + O_KST + (16 * w + fr) * SP + kk * 64 + g * 16);
#pragma unroll
              for (int j = 0; j < 8; ++j) { const bf16x8v bb = *(const LAS bf16x8v*)(L + O_IT + (j * 16 + fr) * SP + kk * 64 + g * 16); S[j] = __builtin_amdgcn_mfma_f32_16x16x32_bf16(a, bb, S[j], 0, 0, 0); } } }
        __syncthreads();
        { const int tr = w >> 1, vb0 = (w & 1) * 4;
#pragma unroll
          for (int j = 0; j < 4; ++j)
#pragma unroll
              for (int r = 0; r < 4; ++r) ((LAS float*)L)[(tr * 16 + 4 * g + r) * 132 + (vb0 + j) * 16 + fr] = oacc[j][r];
#pragma unroll
          for (int j = 0; j < 8; ++j) { v2u pkd; pkd.x = pk2(S[j][0], S[j][1]); pkd.y = pk2(S[j][2], S[j][3]); *(LAS v2u*)(L + O_ST + (j * 16 + fr) * SQ + (16 * w + 4 * g) * 2) = pkd; } }
        __syncthreads();
        if (c >= 1) { const int t = tid >> 3, c16 = (tid & 7) * 16; const LAS pg8::f32x4* op = (const LAS pg8::f32x4*)((LAS float*)L + t * 132 + c16);
            pg8::f32x4 o[4]; float ss = 0.f;
#pragma unroll
            for (int q = 0; q < 4; ++q) { o[q] = op[q]; ss += (o[q][0] * o[q][0] + o[q][1] * o[q][1]) + (o[q][2] * o[q][2] + o[q][3] * o[q][3]); }
            ss += __shfl_xor(ss, 1); ss += __shfl_xor(ss, 2); ss += __shfl_xor(ss, 4);
            const float rstd = 1.0f / sqrtf(ss * (1.0f / 128.f) + EPS);
            const size_t rr = (size_t)b * SEQ + (64 * c - 64 + t); const size_t off = rr * DM + h * 128 + c16;
            const v4u g0 = *(const v4u*)(HG + off), g1 = *(const v4u*)(HG + off + 8);
            const pg8::f32x4* gp = (const pg8::f32x4*)(gain + h * 128 + c16); const pg8::f32x4 n0 = gp[0], n1 = gp[1], n2 = gp[2], n3 = gp[3];
            v4u w0, w1;
            w0.x = pk2(o[0][0] * rstd * n0[0] * bflo(g0.x), o[0][1] * rstd * n0[1] * bfhi(g0.x)); w0.y = pk2(o[0][2] * rstd * n0[2] * bflo(g0.y), o[0][3] * rstd * n0[3] * bfhi(g0.y));
            w0.z = pk2(o[1][0] * rstd * n1[0] * bflo(g0.z), o[1][1] * rstd * n1[1] * bfhi(g0.z)); w0.w = pk2(o[1][2] * rstd * n1[2] * bflo(g0.w), o[1][3] * rstd * n1[3] * bfhi(g0.w));
            w1.x = pk2(o[2][0] * rstd * n2[0] * bflo(g1.x), o[2][1] * rstd * n2[1] * bfhi(g1.x)); w1.y = pk2(o[2][2] * rstd * n2[2] * bflo(g1.y), o[2][3] * rstd * n2[3] * bfhi(g1.y));
            w1.z = pk2(o[3][0] * rstd * n3[0] * bflo(g1.z), o[3][1] * rstd * n3[1] * bfhi(g1.z)); w1.w = pk2(o[3][2] * rstd * n3[2] * bflo(g1.w), o[3][3] * rstd * n3[3] * bfhi(g1.w));
            *(v4u*)(ON + off) = w0; *(v4u*)(ON + off + 8) = w1; }
    }
#undef LOADRAW
    __syncthreads();
}

__device__ __forceinline__ void ln1_phase(const Params& P, const Ctx& C, bool dostore) {
    const int gw = C.vcu * 8 + C.wave, NGW = C.G * 8; bf16* H1B = (bf16*)(P.ws + WS_H1B);
    const float* g = P.in[I_LN1G]; const float* bb = P.in[I_LN1B];
    for (int r = gw; r < MR; r += NGW) {
        pg8::f32x4* row = (pg8::f32x4*)(P.out + (size_t)r * DM) + C.lane;
        pg8::f32x4 v[4]; float s = 0.f;
#pragma unroll
        for (int j = 0; j < 4; ++j) { v[j] = row[64 * j]; s += (v[j][0] + v[j][1]) + (v[j][2] + v[j][3]); }
        const float mean = wave_sum(s) * (1.f / DM); float s2 = 0.f;
#pragma unroll
        for (int j = 0; j < 4; ++j) { v[j] = v[j] - mean; s2 += (v[j][0] * v[j][0] + v[j][1] * v[j][1]) + (v[j][2] * v[j][2] + v[j][3] * v[j][3]); }
        const float rstd = 1.f / sqrtf(wave_sum(s2) * (1.f / DM) + EPS);
#pragma unroll
        for (int j = 0; j < 4; ++j) { const int c = (C.lane + 64 * j) * 4; const pg8::f32x4 gg = *(const pg8::f32x4*)(g + c), b4 = *(const pg8::f32x4*)(bb + c);
            const pg8::f32x4 o = v[j] * rstd * gg + b4; if (dostore) row[64 * j] = o;
            v2u w; w.x = pk2(o[0], o[1]); w.y = pk2(o[2], o[3]); if (dostore) *(v2u*)(H1B + (size_t)r * DM + c) = w; }
    }
}


typedef float f32x2v __attribute__((ext_vector_type(2)));
__device__ __forceinline__ void cvt_table_fp8(const float* __restrict__ src, unsigned char* __restrict__ dst, float* __restrict__ inv  , int gw, int NGW, int lane) {
    for (int r = gw; r < 16384; r += NGW) {
        const pg8::f32x4* p = (const pg8::f32x4*)(src + (size_t)r * 1024 + lane * 16);
        pg8::f32x4 v[4]; float mx = 0.f;
#pragma unroll
        for (int j = 0; j < 4; ++j) { v[j] = p[j]; mx = fmaxf(mx, fmaxf(fmaxf(fabsf(v[j][0]), fabsf(v[j][1])), fmaxf(fabsf(v[j][2]), fabsf(v[j][3])))); }
#pragma unroll
        for (int o = 1; o < 64; o <<= 1) mx = fmaxf(mx, __shfl_xor(mx, o));
        const float sc = mx > 0.f ? exp2f(floorf(log2f(256.0f / mx))) : 1.0f;
        v4u w;
        { int t = 0; t = __builtin_amdgcn_cvt_pk_fp8_f32(v[0][0] * sc, v[0][1] * sc, t, false); t = __builtin_amdgcn_cvt_pk_fp8_f32(v[0][2] * sc, v[0][3] * sc, t, true); w.x = (unsigned)t; }
        { int t = 0; t = __builtin_amdgcn_cvt_pk_fp8_f32(v[1][0] * sc, v[1][1] * sc, t, false); t = __builtin_amdgcn_cvt_pk_fp8_f32(v[1][2] * sc, v[1][3] * sc, t, true); w.y = (unsigned)t; }
        { int t = 0; t = __builtin_amdgcn_cvt_pk_fp8_f32(v[2][0] * sc, v[2][1] * sc, t, false); t = __builtin_amdgcn_cvt_pk_fp8_f32(v[2][2] * sc, v[2][3] * sc, t, true); w.z = (unsigned)t; }
        { int t = 0; t = __builtin_amdgcn_cvt_pk_fp8_f32(v[3][0] * sc, v[3][1] * sc, t, false); t = __builtin_amdgcn_cvt_pk_fp8_f32(v[3][2] * sc, v[3][3] * sc, t, true); w.w = (unsigned)t; }
        *(v4u*)(dst + (size_t)r * 1024 + lane * 16) = w;
        if (lane == 0) inv[2 * r] = 1.0f / sc;
    }
}
__device__ __forceinline__ void fp8x4_to_bf16x4(unsigned w, unsigned& lo, unsigned& hi) {
    const f32x2v a = __builtin_amdgcn_cvt_pk_f32_fp8((int)w, false), b = __builtin_amdgcn_cvt_pk_f32_fp8((int)w, true);
    lo = pg8::cvt_pk_bf16(a[0], a[1]); hi = pg8::cvt_pk_bf16(b[0], b[1]);
}

__device__ __forceinline__ float gelu_tanh(float a) { const float u = 0.7978845608028654f * (a + 0.044715f * a * a * a); return a / (1.0f + __expf(-2.0f * u)); }
typedef short bf16x8v __attribute__((ext_vector_type(8)));

__device__ __forceinline__ float vmaxf(float a, float b) { float r; asm("v_max_f32 %0, %1, %2" : "=v"(r) : "v"(a), "v"(b)); return r; }
__device__ __forceinline__ float vminf(float a, float b) { float r; asm("v_min_f32 %0, %1, %2" : "=v"(r) : "v"(a), "v"(b)); return r; }
#define CE_DESC(a, b) do { const float hi_ = vmaxf(a, b), lo_ = vminf(a, b); a = hi_; b = lo_; } while (0)
template <int N> __device__ __forceinline__ void bitonic_merge_desc(float (&v)[N]) {
#pragma unroll
    for (int j = N / 2; j > 0; j >>= 1)
#pragma unroll
        for (int i = 0; i < N; ++i) { const int l = i ^ j; if (l > i) CE_DESC(v[i], v[l]); }
}
template <int N> __device__ __forceinline__ void bitonic_sort_desc(float (&v)[N]) {
#pragma unroll
    for (int k = 2; k <= N; k <<= 1)
#pragma unroll
        for (int j = k >> 1; j > 0; j >>= 1)
#pragma unroll
            for (int i = 0; i < N; ++i) { const int l = i ^ j; if (l > i) { if ((i & k) == 0 || k == N) CE_DESC(v[i], v[l]); else CE_DESC(v[l], v[i]); } }
}
__device__ __forceinline__ void top16_merge(float (&a)[16], const float (&b)[16]) {
#pragma unroll
    for (int i = 0; i < 16; ++i) a[i] = vmaxf(a[i], b[15 - i]);
    bitonic_merge_desc<16>(a);
}
__device__ __forceinline__ void peer_route(const Params& P, const Ctx& C, int grp, LAS unsigned short* sidx, LAS float* sgate, LAS float* topv) {
    int lane_ = C.lane; asm volatile("" : "+v"(lane_));
    const int lane = lane_, w = C.wave, tokl = lane & 31, hi = lane >> 5;
    const bf16* PQ = (const bf16*)(P.ws + WS_PQ); const bf16* SK = (const bf16*)(P.ws + WS_SK);
    const int tok0 = grp * 32;
#pragma unroll 1
    for (int pp = 0; pp < 2; ++pp) {
        const int hp = 2 * w + pp;
        f32x16 acc[4] = {};
#pragma unroll
        for (int s = 0; s < 8; ++s) {
            const bf16x8v bfrag = *(const bf16x8v*)(PQ + (size_t)(tok0 + tokl) * 2048 + hp * 128 + s * 16 + hi * 8);
#pragma unroll
            for (int mb = 0; mb < 4; ++mb) { const bf16x8v afrag = *(const bf16x8v*)(SK + (size_t)(hp * 128 + mb * 32 + tokl) * 128 + s * 16 + hi * 8);
                acc[mb] = __builtin_amdgcn_mfma_f32_32x32x16_bf16(afrag, bfrag, acc[mb], 0, 0, 0); }
        }
        float g0[16], g1[16], g2[16], g3[16];
#pragma unroll
        for (int r = 0; r < 16; ++r) { const unsigned kb = (unsigned)((r & 3) + 8 * (r >> 2) + 4 * hi);
            g0[r] = __uint_as_float((__float_as_uint(acc[0][r]) & ~127u) | kb); g1[r] = __uint_as_float((__float_as_uint(acc[1][r]) & ~127u) | (kb + 32u));
            g2[r] = __uint_as_float((__float_as_uint(acc[2][r]) & ~127u) | (kb + 64u)); g3[r] = __uint_as_float((__float_as_uint(acc[3][r]) & ~127u) | (kb + 96u)); }
        bitonic_sort_desc<16>(g0); bitonic_sort_desc<16>(g1); bitonic_sort_desc<16>(g2); bitonic_sort_desc<16>(g3);
        top16_merge(g0, g1); top16_merge(g2, g3); top16_merge(g0, g2);
        { float o[16];
#pragma unroll
          for (int i = 0; i < 16; ++i) o[i] = __shfl_xor(g0[i], 32);
          top16_merge(g0, o); }
        if (hi == 0) { LAS pg8::f32x4* tp = (LAS pg8::f32x4*)(topv + tokl * 260 + hp * 16);
            tp[0] = (pg8::f32x4){g0[0], g0[1], g0[2], g0[3]}; tp[1] = (pg8::f32x4){g0[4], g0[5], g0[6], g0[7]}; tp[2] = (pg8::f32x4){g0[8], g0[9], g0[10], g0[11]}; tp[3] = (pg8::f32x4){g0[12], g0[13], g0[14], g0[15]}; }
    }
    asm volatile("s_waitcnt lgkmcnt(0)" ::: "memory");
    const LAS float* ta_l = topv + tokl * 260 + (2 * w) * 16; const LAS float* tb_l = ta_l + 16;
    float ta[16], tb[16];
#pragma unroll
    for (int q = 0; q < 4; ++q) { const pg8::f32x4 x = ((const LAS pg8::f32x4*)ta_l)[q], y = ((const LAS pg8::f32x4*)tb_l)[q];
        ta[4 * q] = x[0]; ta[4 * q + 1] = x[1]; ta[4 * q + 2] = x[2]; ta[4 * q + 3] = x[3]; tb[4 * q] = y[0]; tb[4 * q + 1] = y[1]; tb[4 * q + 2] = y[2]; tb[4 * q + 3] = y[3]; }
    float cand[25];
    { int n = 0;
#pragma unroll
      for (int i = 0; i < 16; ++i)
#pragma unroll
          for (int j = 0; j < 16; ++j) if ((i + 1) * (j + 1) <= 16) {
              const float sv = ta[i] + tb[j]; const float tagged = __uint_as_float((__float_as_uint(sv) & ~255u) | (unsigned)((i << 4) | j));
              if ((n & 1) == 0) cand[n >> 1] = tagged; else cand[n >> 1] = hi ? tagged : cand[n >> 1];
              ++n; } }
    float best[16];
    { float ca[16], cb[16];
#pragma unroll
      for (int i = 0; i < 16; ++i) { ca[i] = cand[i]; cb[i] = i < 9 ? cand[16 + i] : -INFINITY; }
      bitonic_sort_desc<16>(ca); bitonic_sort_desc<16>(cb); top16_merge(ca, cb);
#pragma unroll
      for (int i = 0; i < 16; ++i) cb[i] = __shfl_xor(ca[i], 32);
#pragma unroll
      for (int i = 0; i < 16; ++i) best[i] = vmaxf(ca[i], cb[15 - i]); }
    { float e[16], se = 0.f;
      const float bmx = __builtin_fmaxf(best[0], best[15]);
#pragma unroll
      for (int it = 0; it < 16; ++it) { e[it] = __expf(best[it] - bmx); se += e[it]; }
      const float inv = 1.0f / se;
      if (hi == 0) {
#pragma unroll
          for (int it = 0; it < 16; ++it) { const unsigned bits = __float_as_uint(best[it]); const int ci = (bits >> 4) & 15, cj = bits & 15;
              const int ia = (int)(__float_as_uint(ta_l[ci]) & 127u), ib = (int)(__float_as_uint(tb_l[cj]) & 127u);
              sidx[tokl * 128 + w * 16 + it] = (unsigned short)(ia * 128 + ib); sgate[tokl * 128 + w * 16 + it] = e[it] * inv; }
      } }
}
template <int MODE  >
__device__ __forceinline__ void peer_apply(const Params& P, const Ctx& C, int grp, const LAS unsigned short* sidx, const LAS float* sgate, bool dostore) {
    int lane_ = C.lane; asm volatile("" : "+v"(lane_));
    const int lane = lane_, w = C.wave;
    LAS float* actw = (LAS float*)(C.lds + 82432) + w * 128;
    LAS unsigned short* hrow = (LAS unsigned short*)(C.lds + 86528) + w * 1024;
    LAS float* suw = (LAS float*)(C.lds + 102912) + w * 256; LAS float* svw = suw + 128;
    const unsigned char* U8 = P.ws + WS_U8; const unsigned char* V8 = P.ws + WS_V8; const float* SU = (const float*)(P.ws + WS_SU); const float* SV = (const float*)(P.ws + WS_SV);
    const bf16* H1B = (const bf16*)(P.ws + WS_H1B);
    const float* g2 = P.in[I_LN2G]; const float* b2 = P.in[I_LN2B];
    const int tok0 = grp * 32;
        for (int tt = 0; tt < 4; ++tt) {
            const int tl = w * 4 + tt; const size_t tok = (size_t)tok0 + tl;
            f32x2v h2[8];
            { const v4u a = *(const v4u*)(H1B + tok * DM + lane * 16), b = *(const v4u*)(H1B + tok * DM + lane * 16 + 8);
              h2[0] = (f32x2v){bflo(a.x), bfhi(a.x)}; h2[1] = (f32x2v){bflo(a.y), bfhi(a.y)}; h2[2] = (f32x2v){bflo(a.z), bfhi(a.z)}; h2[3] = (f32x2v){bflo(a.w), bfhi(a.w)};
              h2[4] = (f32x2v){bflo(b.x), bfhi(b.x)}; h2[5] = (f32x2v){bflo(b.y), bfhi(b.y)}; h2[6] = (f32x2v){bflo(b.z), bfhi(b.z)}; h2[7] = (f32x2v){bflo(b.w), bfhi(b.w)}; }
            { const int e0 = sidx[tl * 128 + lane], e1 = sidx[tl * 128 + 64 + lane];
              const f32x2v s0 = *(const f32x2v*)(SU + 2 * e0), s1 = *(const f32x2v*)(SU + 2 * e1);
              suw[lane] = s0[0]; suw[64 + lane] = s1[0]; svw[lane] = s0[1]; svw[64 + lane] = s1[1]; }
            {
                v4u uA[8], uB[8]; float pd[16];
#define U_LOAD(ST, kb) do { _Pragma("unroll") for (int q = 0; q < 8; ++q) { const int e = __builtin_amdgcn_readfirstlane((int)sidx[tl * 128 + (kb) * 8 + q]); ST[q] = *(const v4u*)(U8 + (size_t)e * DM + lane * 16); } } while (0)
#define U_DOT(ST, off) do { _Pragma("unroll") for (int q = 0; q < 8; ++q) { const v4u x = ST[q]; \
                    f32x2v sacc = __builtin_amdgcn_cvt_pk_f32_fp8((int)x.x, false) * h2[0]; sacc = __builtin_elementwise_fma(__builtin_amdgcn_cvt_pk_f32_fp8((int)x.x, true), h2[1], sacc); \
                    sacc = __builtin_elementwise_fma(__builtin_amdgcn_cvt_pk_f32_fp8((int)x.y, false), h2[2], sacc); sacc = __builtin_elementwise_fma(__builtin_amdgcn_cvt_pk_f32_fp8((int)x.y, true), h2[3], sacc); \
                    sacc = __builtin_elementwise_fma(__builtin_amdgcn_cvt_pk_f32_fp8((int)x.z, false), h2[4], sacc); sacc = __builtin_elementwise_fma(__builtin_amdgcn_cvt_pk_f32_fp8((int)x.z, true), h2[5], sacc); \
                    sacc = __builtin_elementwise_fma(__builtin_amdgcn_cvt_pk_f32_fp8((int)x.w, false), h2[6], sacc); sacc = __builtin_elementwise_fma(__builtin_amdgcn_cvt_pk_f32_fp8((int)x.w, true), h2[7], sacc); \
                    pd[(off) + q] = sacc[0] + sacc[1]; } } while (0)
#define U_REDUCE(kb2) do { float r8[8], r4[4], r2[2], r1; const bool b5 = lane & 32, b4 = lane & 16, b3 = lane & 8, b2 = lane & 4; \
                    _Pragma("unroll") for (int j = 0; j < 8; ++j) { const float keep = b5 ? pd[j + 8] : pd[j], send = b5 ? pd[j] : pd[j + 8]; r8[j] = keep + __shfl_xor(send, 32); } \
                    _Pragma("unroll") for (int j = 0; j < 4; ++j) { const float keep = b4 ? r8[j + 4] : r8[j], send = b4 ? r8[j] : r8[j + 4]; r4[j] = keep + __shfl_xor(send, 16); } \
                    _Pragma("unroll") for (int j = 0; j < 2; ++j) { const float keep = b3 ? r4[j + 2] : r4[j], send = b3 ? r4[j] : r4[j + 2]; r2[j] = keep + __shfl_xor(send, 8); } \
                    { const float keep = b2 ? r2[1] : r2[0], send = b2 ? r2[0] : r2[1]; r1 = keep + __shfl_xor(send, 4); } \
                    r1 += __shfl_xor(r1, 2); r1 += __shfl_xor(r1, 1); \
                    if ((lane & 3) == 0) { const int k = (kb2) * 16 + ((lane >> 5) & 1) * 8 + ((lane >> 4) & 1) * 4 + ((lane >> 3) & 1) * 2 + ((lane >> 2) & 1); \
                        actw[k] = gelu_tanh(r1 * suw[k]) * sgate[tl * 128 + k] * svw[k]; } } while (0)
                asm volatile("s_waitcnt lgkmcnt(0)" ::: "memory");
                U_LOAD(uA, 0);
#pragma unroll 1
                for (int kb = 0; kb < 16; kb += 2) {
                    U_LOAD(uB, kb + 1);
                    U_DOT(uA, 0);
                    if (kb + 2 < 16) U_LOAD(uA, kb + 2);
                    U_DOT(uB, 8);
                    U_REDUCE(kb >> 1);
                }
#undef U_LOAD
#undef U_DOT
#undef U_REDUCE
            }
            v4u vA[8], vB[8];
#define V_LOAD(ST, kb) do { _Pragma("unroll") for (int q = 0; q < 8; ++q) { const int e = __builtin_amdgcn_readfirstlane((int)sidx[tl * 128 + (kb) * 8 + q]); ST[q] = *(const v4u*)(V8 + (size_t)e * DM + lane * 16); } } while (0)
            if (MODE == 0) V_LOAD(vA, 0);
            asm volatile("s_waitcnt lgkmcnt(0)" ::: "memory");
            if (MODE == 1) {
                if (lane < 32) *(pg8::f32x4*)((float*)(P.ws + WS_ACT) + tok * 128 + lane * 4) = *(const LAS pg8::f32x4*)(actw + lane * 4);
                else if (lane < 48) *(v4u*)((unsigned short*)(P.ws + WS_SIDX) + tok * 128 + (lane - 32) * 8) = *(const LAS v4u*)(sidx + tl * 128 + (lane - 32) * 8);
                continue;
            }
            float out[16];
#pragma unroll
            for (int i = 0; i < 16; ++i) out[i] = 0.f;
            {
#define V_COMP(ST, kb) do { _Pragma("unroll") for (int q = 0; q < 8; ++q) { const float a = actw[(kb) * 8 + q]; const f32x2v a2 = {a, a}; const v4u x = ST[q]; \
                    out2[0] = __builtin_elementwise_fma(__builtin_amdgcn_cvt_pk_f32_fp8((int)x.x, false), a2, out2[0]); out2[1] = __builtin_elementwise_fma(__builtin_amdgcn_cvt_pk_f32_fp8((int)x.x, true), a2, out2[1]); \
                    out2[2] = __builtin_elementwise_fma(__builtin_amdgcn_cvt_pk_f32_fp8((int)x.y, false), a2, out2[2]); out2[3] = __builtin_elementwise_fma(__builtin_amdgcn_cvt_pk_f32_fp8((int)x.y, true), a2, out2[3]); \
                    out2[4] = __builtin_elementwise_fma(__builtin_amdgcn_cvt_pk_f32_fp8((int)x.z, false), a2, out2[4]); out2[5] = __builtin_elementwise_fma(__builtin_amdgcn_cvt_pk_f32_fp8((int)x.z, true), a2, out2[5]); \
                    out2[6] = __builtin_elementwise_fma(__builtin_amdgcn_cvt_pk_f32_fp8((int)x.w, false), a2, out2[6]); out2[7] = __builtin_elementwise_fma(__builtin_amdgcn_cvt_pk_f32_fp8((int)x.w, true), a2, out2[7]); } } while (0)
                f32x2v out2[8];
#pragma unroll
                for (int i = 0; i < 8; ++i) out2[i] = (f32x2v){0.f, 0.f};
#pragma unroll 1
                for (int kb = 0; kb < 16; kb += 2) {
                    V_LOAD(vB, kb + 1);
                    V_COMP(vA, kb);
                    if (kb + 2 < 16) V_LOAD(vA, kb + 2);
                    V_COMP(vB, kb + 1);
                }
#undef V_LOAD
#undef V_COMP
#pragma unroll
                for (int i = 0; i < 8; ++i) { out[2 * i] = out2[i][0]; out[2 * i + 1] = out2[i][1]; }
            }
            float* orow = P.out + tok * DM + lane * 16;
            float s = 0.f;
#pragma unroll
            for (int q = 0; q < 4; ++q) { const pg8::f32x4 hv = *(const pg8::f32x4*)(orow + 4 * q);
#pragma unroll
                for (int e = 0; e < 4; ++e) { out[4 * q + e] = fmaf(ALPHA, hv[e], out[4 * q + e]); s += out[4 * q + e]; } }
            const float mean = wave_sum(s) * (1.f / DM); float s2 = 0.f;
#pragma unroll
            for (int i = 0; i < 16; ++i) { out[i] -= mean; s2 += out[i] * out[i]; }
            const float rstd = 1.f / sqrtf(wave_sum(s2) * (1.f / DM) + EPS);
#pragma unroll
            for (int q = 0; q < 4; ++q) { const pg8::f32x4 gg = *(const pg8::f32x4*)(g2 + lane * 16 + 4 * q), b4 = *(const pg8::f32x4*)(b2 + lane * 16 + 4 * q);
                pg8::f32x4 o; o[0] = out[4 * q] * rstd * gg[0] + b4[0]; o[1] = out[4 * q + 1] * rstd * gg[1] + b4[1]; o[2] = out[4 * q + 2] * rstd * gg[2] + b4[2]; o[3] = out[4 * q + 3] * rstd * gg[3] + b4[3];
                if (dostore) *(pg8::f32x4*)(orow + 4 * q) = o; }
        }
}
__device__ __forceinline__ void peer_phase(const Params& P, const Ctx& C, bool dostore) {
    LAS float* topv = (LAS float*)(C.lds + 49152);
    const int n = (MR / 32 - C.vcu + C.G - 1) / C.G;
#pragma unroll 1
    for (int i = -1; i < n; ++i) {
        const int grp = C.vcu + i * C.G; const int cur = (i & 1) * 24576, nxt = 24576 - cur;
#pragma unroll 1
        for (int slot = 0; slot < 2; ++slot) {
            const bool do_apply = (slot == 0) == (C.wave < 4 || PEER_SAMEORDER);
            if (do_apply) { if (i >= 0) {
#ifdef APPLY_REPS
                for (int ar = 1; ar < APPLY_REPS; ++ar) peer_apply<PEER_SPLIT>(P, C, grp, (const LAS unsigned short*)(C.lds + cur), (const LAS float*)(C.lds + cur + 8192), false);
#endif
                peer_apply<PEER_SPLIT>(P, C, grp, (const LAS unsigned short*)(C.lds + cur), (const LAS float*)(C.lds + cur + 8192), dostore); } }
            else if (i + 1 < n) {
#ifdef ROUTE_REPS
                for (int rr = 1; rr < ROUTE_REPS; ++rr) peer_route(P, C, grp + C.G, (LAS unsigned short*)(C.lds + nxt), (LAS float*)(C.lds + nxt + 8192), topv);
#endif
                peer_route(P, C, grp + C.G, (LAS unsigned short*)(C.lds + nxt), (LAS float*)(C.lds + nxt + 8192), topv); }
        }
        __syncthreads();
    }
}

__device__ __forceinline__ void peer_v_phase(const Params& P, const Ctx& C, bool dostore) {
    int lane_ = C.lane; asm volatile("" : "+v"(lane_));
    const int lane = lane_, w = C.wave;
    LAS float* actw = (LAS float*)C.lds + w * 128;
    LAS unsigned short* sidw = (LAS unsigned short*)(C.lds + 4096) + w * 128;
    const unsigned char* V8 = P.ws + WS_V8; const float* ACT = (const float*)(P.ws + WS_ACT); const unsigned short* SIDX = (const unsigned short*)(P.ws + WS_SIDX);
    const float* g2 = P.in[I_LN2G]; const float* b2 = P.in[I_LN2B];
    const int gw = C.vcu * 8 + w, NGW = C.G * 8;
    v4u nrow = {0u, 0u, 0u, 0u};
#define VROW_FETCH(t_) do { if (lane < 32) nrow = *(const v4u*)(ACT + (size_t)(t_) * 128 + lane * 4); else if (lane < 48) nrow = *(const v4u*)(SIDX + (size_t)(t_) * 128 + (lane - 32) * 8); } while (0)
    if (gw < MR) VROW_FETCH(gw);
#pragma unroll 1
    for (int tk = gw; tk < MR; tk += NGW) {
        const size_t tok = (size_t)tk;
        if (lane < 32) *(LAS v4u*)(actw + lane * 4) = nrow;
        else if (lane < 48) *(LAS v4u*)(sidw + (lane - 32) * 8) = nrow;
        if (tk + NGW < MR) VROW_FETCH(tk + NGW);
        asm volatile("s_waitcnt lgkmcnt(0)" ::: "memory");
        v4u vA[8], vB[8];
#define V_LOAD(ST, kb) do { _Pragma("unroll") for (int q = 0; q < 8; ++q) { const int e = __builtin_amdgcn_readfirstlane((int)sidw[(kb) * 8 + q]); ST[q] = *(const v4u*)(V8 + (size_t)e * DM + lane * 16); } } while (0)
#define V_COMP(ST, kb) do { _Pragma("unroll") for (int q = 0; q < 8; ++q) { const float a = actw[(kb) * 8 + q]; const f32x2v a2 = {a, a}; const v4u x = ST[q]; \
            out2[0] = __builtin_elementwise_fma(__builtin_amdgcn_cvt_pk_f32_fp8((int)x.x, false), a2, out2[0]); out2[1] = __builtin_elementwise_fma(__builtin_amdgcn_cvt_pk_f32_fp8((int)x.x, true), a2, out2[1]); \
            out2[2] = __builtin_elementwise_fma(__builtin_amdgcn_cvt_pk_f32_fp8((int)x.y, false), a2, out2[2]); out2[3] = __builtin_elementwise_fma(__builtin_amdgcn_cvt_pk_f32_fp8((int)x.y, true), a2, out2[3]); \
            out2[4] = __builtin_elementwise_fma(__builtin_amdgcn_cvt_pk_f32_fp8((int)x.z, false), a2, out2[4]); out2[5] = __builtin_elementwise_fma(__builtin_amdgcn_cvt_pk_f32_fp8((int)x.z, true), a2, out2[5]); \
            out2[6] = __builtin_elementwise_fma(__builtin_amdgcn_cvt_pk_f32_fp8((int)x.w, false), a2, out2[6]); out2[7] = __builtin_elementwise_fma(__builtin_amdgcn_cvt_pk_f32_fp8((int)x.w, true), a2, out2[7]); } } while (0)
        f32x2v out2[8];
#pragma unroll
        for (int i = 0; i < 8; ++i) out2[i] = (f32x2v){0.f, 0.f};
        V_LOAD(vA, 0);
#pragma unroll 1
        for (int kb = 0; kb < 16; kb += 2) {
            V_LOAD(vB, kb + 1);
            V_COMP(vA, kb);
            if (kb + 2 < 16) V_LOAD(vA, kb + 2);
            V_COMP(vB, kb + 1);
        }
#undef V_LOAD
#undef V_COMP
        float out[16];
#pragma unroll
        for (int i = 0; i < 8; ++i) { out[2 * i] = out2[i][0]; out[2 * i + 1] = out2[i][1]; }
        float* orow = P.out + tok * DM + lane * 16;
        float s = 0.f;
#pragma unroll
        for (int q = 0; q < 4; ++q) { const pg8::f32x4 hv = *(const pg8::f32x4*)(orow + 4 * q);
#pragma unroll
            for (int e = 0; e < 4; ++e) { out[4 * q + e] = fmaf(ALPHA, hv[e], out[4 * q + e]); s += out[4 * q + e]; } }
        const float mean = wave_sum(s) * (1.f / DM); float s2 = 0.f;
#pragma unroll
        for (int i = 0; i < 16; ++i) { out[i] -= mean; s2 += out[i] * out[i]; }
        const float rstd = 1.f / sqrtf(wave_sum(s2) * (1.f / DM) + EPS);
#pragma unroll
        for (int q = 0; q < 4; ++q) { const pg8::f32x4 gg = *(const pg8::f32x4*)(g2 + lane * 16 + 4 * q), b4 = *(const pg8::f32x4*)(b2 + lane * 16 + 4 * q);
            pg8::f32x4 o; o[0] = out[4 * q] * rstd * gg[0] + b4[0]; o[1] = out[4 * q + 1] * rstd * gg[1] + b4[1]; o[2] = out[4 * q + 2] * rstd * gg[2] + b4[2]; o[3] = out[4 * q + 3] * rstd * gg[3] + b4[3];
            if (dostore) *(pg8::f32x4*)(orow + 4 * q) = o; }
    }
}

#define XB_TMO      128
#define XB_XCNT(j)  (256  + 64 * (j))
#define XB_XSUB(j)  (1280 + 64 * (j))
#define XB_XGEN(j)  (2304 + 64 * (j))
#define XB_TOP      3328
#define XB_TOPGEN   3392
#define XCD_BAR_WORDS 3456
#define XB_SPIN_CAP (1u << 18)

__device__ __forceinline__ unsigned xb_ld(unsigned* p)              { return __hip_atomic_load(p, __ATOMIC_RELAXED, __HIP_MEMORY_SCOPE_AGENT); }
__device__ __forceinline__ unsigned xb_add(unsigned* p, unsigned v) { return __hip_atomic_fetch_add(p, v, __ATOMIC_RELAXED, __HIP_MEMORY_SCOPE_AGENT); }
__device__ __forceinline__ unsigned xb_xcc_id() { return (unsigned)__builtin_amdgcn_s_getreg((3 << 11) | 20) & 0xFu; }
#define XB_SPIN(cond, bar) do { unsigned _sp = 0; while (cond) { __builtin_amdgcn_s_sleep(1); \
    if ((++_sp & 255u) == 0u) { if (xb_ld(&(bar)[XB_TMO])) break; if (_sp > XB_SPIN_CAP) { atomicAdd(&(bar)[XB_TMO], 1u); break; } } } } while (0)

struct XcdBarrier {
    unsigned* bar; unsigned x;
    volatile LAS unsigned* st;
};

__device__ __forceinline__ XcdBarrier xcd_barrier_post(unsigned* bar, volatile LAS unsigned* st) {
    XcdBarrier b; b.bar = bar; b.x = xb_xcc_id(); b.st = st;
    if (threadIdx.x == 0) (void)xb_add(&bar[XB_XCNT(b.x)], 1u);
    return b;
}
__device__ __forceinline__ void xcd_barrier_complete(unsigned* bar, unsigned x, unsigned& nloc, unsigned& nx) {
    const unsigned G = gridDim.x * gridDim.y * gridDim.z;
    unsigned sum, cnt, mine, sp = 0u;
    for (;;) {
        sum = 0u; cnt = 0u; mine = 0u;
#pragma unroll
        for (unsigned j = 0; j < 16; ++j) { const unsigned c = xb_ld(&bar[XB_XCNT(j)]); sum += c; cnt += (c > 0u) ? 1u : 0u; mine = (j == x) ? c : mine; }
        if (sum == G) break;
        __builtin_amdgcn_s_sleep(1);
        if ((++sp & 255u) == 0u) { if (xb_ld(&bar[XB_TMO])) break; if (sp > XB_SPIN_CAP) { atomicAdd(&bar[XB_TMO], 1u); break; } }
    }
    nloc = mine > 0u ? mine : 1u; nx = cnt > 0u ? cnt : 1u;
}

__device__ __forceinline__ void xcd_barrier(const XcdBarrier& b) {
    asm volatile("s_waitcnt vmcnt(0)" ::: "memory");
    __syncthreads();
    if (threadIdx.x == 0) {
        unsigned* bar = b.bar;
        __builtin_amdgcn_s_waitcnt(0);
        unsigned nloc = b.st[0], nx = b.st[1];
        if (nloc == 0u) { xcd_barrier_complete(bar, b.x, nloc, nx); b.st[0] = nloc; b.st[1] = nx; }
        const unsigned old = xb_add(&bar[XB_XSUB(b.x)], 1u);
        const unsigned gen = old / nloc;
        if (old + 1u == (gen + 1u) * nloc) {
            __builtin_amdgcn_fence(__ATOMIC_RELEASE, "agent");
            asm volatile("s_waitcnt vmcnt(0)" ::: "memory");
            const unsigned og = xb_add(&bar[XB_TOP], 1u);
            const unsigned tg = og / nx;
            if (og + 1u == (tg + 1u) * nx) xb_add(&bar[XB_TOPGEN], 1u);
            else XB_SPIN(xb_ld(&bar[XB_TOPGEN]) == tg, bar);
            __builtin_amdgcn_fence(__ATOMIC_ACQUIRE, "agent");
            xb_add(&bar[XB_XGEN(b.x)], 1u);
            asm volatile("s_waitcnt vmcnt(0)" ::: "memory");
        } else {
            XB_SPIN(xb_ld(&bar[XB_XGEN(b.x)]) == gen, bar);
            __builtin_amdgcn_fence(__ATOMIC_ACQUIRE, "agent");
            asm volatile("s_waitcnt vmcnt(0)" ::: "memory");
        }
    }
    __syncthreads();
}

__device__ __forceinline__ void sub_barrier(unsigned* cnt, unsigned n) {
    asm volatile("s_waitcnt vmcnt(0)" ::: "memory");
    __syncthreads();
    if (threadIdx.x == 0) {
        __builtin_amdgcn_fence(__ATOMIC_RELEASE, "agent");
        asm volatile("s_waitcnt vmcnt(0)" ::: "memory");
        __hip_atomic_fetch_add(cnt, 1u, __ATOMIC_RELAXED, __HIP_MEMORY_SCOPE_AGENT);
        unsigned sp = 0;
        while (__hip_atomic_load(cnt, __ATOMIC_RELAXED, __HIP_MEMORY_SCOPE_AGENT) < n) { __builtin_amdgcn_s_sleep(2); if (++sp > (1u << 22)) break; }
        __builtin_amdgcn_fence(__ATOMIC_ACQUIRE, "agent");
        asm volatile("s_waitcnt vmcnt(0)" ::: "memory");
    }
    __syncthreads();
}

constexpr int N_PHASES = 12 + PEER_SPLIT;
__global__ void __launch_bounds__(512, 2) mega_fwd(Params P) {
    extern __shared__ __attribute__((aligned(16))) unsigned char lds_raw[];
    Ctx C; C.lds = (LAS unsigned char*)lds_raw; C.tid = threadIdx.x; C.lane = C.tid & 63; C.wave = __builtin_amdgcn_readfirstlane(C.tid >> 6);
    C.G = gridDim.x; C.bid = blockIdx.x; C.vcu = (C.G % 8 == 0) ? (C.bid % 8) * (C.G / 8) + C.bid / 8 : C.bid;
    unsigned char* ws = P.ws;
    const int lo = P.ph_lo, hi = P.ph_hi;
    volatile LAS unsigned* bst = (volatile LAS unsigned*)(C.lds + LDS_BYTES - 64);
    if (C.tid < 16) bst[C.tid] = 0u;
    __syncthreads();
    (void)xcd_barrier_post((unsigned*)(ws + WS_CTL) + 1024, bst);
#define RETID() do { int t_ = threadIdx.x; asm volatile("" : "+v"(t_)); C.tid = t_; C.lane = t_ & 63; } while (0)
#ifndef PH_MASK
#define PH_MASK 0x1FFF
#endif
#define IN(k) (((PH_MASK >> (k)) & 1) && lo <= (k) && (k) < hi)
#ifndef DUP_MASK
#define DUP_MASK 0
#endif
#define REPS(k) (((DUP_MASK >> (k)) & 1) ? 2 : 1)
#define SEAM(k) do { if (IN(k) && IN((k) + 1)) { if ((k) == 0) cg::this_grid().sync(); else { XcdBarrier xb_; xb_.bar = (unsigned*)(P.ws + WS_CTL) + 1024; xb_.x = xb_xcc_id(); xb_.st = (volatile LAS unsigned*)(C.lds + LDS_BYTES - 64); xcd_barrier(xb_); } } } while (0)
    typedef pg8::StaticOrder SO;
    if (IN(0)) for (int rep = 0; rep < REPS(0); ++rep) { RETID(); p0_prologue(P, C); }
    SEAM(0);
    if (IN(1)) for (int rep = 0; rep < REPS(1); ++rep) {
        pg8::Gemm g{(const bf16*)(ws + WS_A), (const bf16*)(ws + WS_WIN), MV, N1, DM}; SO S; S.init(MV, N1, C.G, C.bid);
        pg8::EpiInProj E{(bf16*)(ws + WS_HQ), (bf16*)(ws + WS_K1), (bf16*)(ws + WS_HI), (bf16*)(ws + WS_HG), (bf16*)(ws + WS_CQ), (bf16*)(ws + WS_CKV), (bf16*)(ws + WS_KR),
                         (bf16*)P.out, (bf16*)P.out + (size_t)MR * DM, P.in[I_LBL], (const float*)(ws + WS_ROPE)};
#ifdef INPROJ_NOSTORE_FIRST
        if (rep == 0) { pg8::EpiNoStore EN{E.HQ, hi > 100}; pg8::gemm_phase<pg8::EpiNoStore, SO, true, true>(C.lds, g, S, EN); } else
#endif
#ifdef INPROJ_RAW_FIRST
        if (rep == 0) { pg8::EpiInProjT<true> ER{E.HQ, E.K1, E.HI, E.HG, E.CQ, E.CKV, E.KR, E.GA, E.GB, E.lbl, E.rope}; pg8::gemm_phase<pg8::EpiInProjT<true>, SO, true, true>(C.lds, g, S, ER); } else
#endif
        pg8::gemm_phase<pg8::EpiInProj, SO, true, true>(C.lds, g, S, E);
    }
    SEAM(1);
    const bool split2 = false;
    if (IN(2)) for (int rep = 0; rep < REPS(2); ++rep) {
        RETID();
        if (!split2) {
            if (C.G == 256) {
                if (C.bid < 128) { hgrn_item2(P, C, C.bid); late_weights(P, C, C.bid * 8 + C.wave, 128 * 8, (size_t)C.bid * 512 + C.tid, (size_t)128 * 512, 2); }
                else { rowstats(P, C, (C.bid - 128) * 8 + C.wave, 128 * 8); late_weights(P, C, (C.bid - 128) * 8 + C.wave, 128 * 8, (size_t)(C.bid - 128) * 512 + C.tid, (size_t)128 * 512, 1);
                    __syncthreads();
                    pg8::Gemm g{(const bf16*)(ws + WS_A), (const bf16*)(ws + WS_WIN) + (size_t)N1 * DM, MR, 2048, DM}; pg8::GateOrder S; S.init(MR, 2048, 128, C.bid - 128);
                    pg8::EpiGates E{(bf16*)P.out, (bf16*)P.out + (size_t)MR * DM};
                    pg8::gemm_phase<pg8::EpiGates, pg8::GateOrder, true, true>(C.lds, g, S, E); }
            } else {
                rowstats(P, C, C.vcu * 8 + C.wave, C.G * 8); late_weights(P, C, C.vcu * 8 + C.wave, C.G * 8, (size_t)C.vcu * 512 + C.tid, (size_t)C.G * 512, 3);
                for (int item = C.bid; item < NB * HGH; item += C.G) hgrn_item2(P, C, item);
                { pg8::Gemm g{(const bf16*)(ws + WS_A), (const bf16*)(ws + WS_WIN) + (size_t)N1 * DM, MR, 2048, DM}; pg8::GateOrder S; S.init(MR, 2048, C.G, C.bid);
                  pg8::EpiGates E{(bf16*)P.out, (bf16*)P.out + (size_t)MR * DM};
                  pg8::gemm_phase<pg8::EpiGates, pg8::GateOrder, true, true>(C.lds, g, S, E); }
            }
        } else if (C.bid < 128) {
            hgrn_item2(P, C, C.bid);
        } else {
            rowstats(P, C, (C.bid - 128) * 8 + C.wave, 128 * 8);
            sub_barrier((unsigned*)(ws + WS_CTL) + 8192 + 64 * rep, 128u);
            { pg8::Gemm g{(const bf16*)(ws + WS_CQ), (const bf16*)(ws + WS_WUQ), MRH, 3072, QR}; SO S; S.init(MRH, 3072, 128, C.bid - 128);
              pg8::EpiQ E{(bf16*)(ws + WS_QH), (const float*)(ws + WS_RQ), (const float*)(ws + WS_ROPE), 0};
              pg8::gemm_phase<pg8::EpiQ, SO, true, true>(C.lds, g, S, E); }
            { pg8::Gemm g{(const bf16*)(ws + WS_CKV), (const bf16*)(ws + WS_WUKV), MALLH, 4096, KVR}; SO S; S.init(MALLH, 4096, 128, C.bid - 128);
              pg8::EpiScaleBf16 E{(bf16*)(ws + WS_KVH), 4096, (const float*)(ws + WS_RKV), 0};
              pg8::gemm_phase<pg8::EpiScaleBf16, SO, true, true>(C.lds, g, S, E); }
        }
    }
    SEAM(2);
#pragma unroll 1
    for (int hb = 0; hb < NHALF; ++hb) {
        if (IN(3 + 2 * hb) && !(split2 && hb == 0)) for (int rep = 0; rep < REPS(3); ++rep) {
#ifndef NO_QG
            { pg8::Gemm g{(const bf16*)(ws + WS_CQ) + (size_t)hb * MRH * QR, (const bf16*)(ws + WS_WUQ), MRH, 3072, QR}; SO S; S.init(MRH, 3072, C.G, C.bid);
              pg8::EpiQ E{(bf16*)(ws + WS_QH), (const float*)(ws + WS_RQ), (const float*)(ws + WS_ROPE), hb * MRH};
              pg8::gemm_phase<pg8::EpiQ, SO, true, true>(C.lds, g, S, E); }
#endif
#ifndef NO_KVG
            { pg8::Gemm g{(const bf16*)(ws + WS_CKV) + (size_t)hb * MALLH * KVR, (const bf16*)(ws + WS_WUKV), MALLH, 4096, KVR}; SO S; S.init(MALLH, 4096, C.G, C.bid);
              pg8::EpiScaleBf16 E{(bf16*)(ws + WS_KVH), 4096, (const float*)(ws + WS_RKV), hb * MALLH};
              pg8::gemm_phase<pg8::EpiScaleBf16, SO, true, true>(C.lds, g, S, E); }
#endif
        }
        if (!(split2 && hb == 0)) SEAM(3 + 2 * hb);
        if (IN(4 + 2 * hb)) for (int rep = 0; rep < REPS(4); ++rep) {
            const bf16* QH = (const bf16*)(ws + WS_QH); const bf16* KVH = (const bf16*)(ws + WS_KVH); const bf16* KR = (const bf16*)(ws + WS_KR); bf16* AO = (bf16*)(ws + WS_AO);
            for (int wv = C.vcu; wv < 256; wv += C.G) {
                const int bhl = wv >> 1, bl = bhl >> 4, h = bhl & 15, sub = wv & 1, b = hb * HB + bl;
#pragma unroll 1
                for (int i = 0; i < 4; ++i) {
                    const int qb = sub ? (i == 0 ? 2 : i == 1 ? 5 : i == 2 ? 3 : 4) : (i == 0 ? 0 : i == 1 ? 7 : i == 2 ? 1 : 6);
                    attn::attn_unit(QH + ((size_t)bl * SEQ + qb * 256) * 3072 + h * QKD, KVH + ((size_t)bl * PP + 64) * 4096 + h * 256, KR + ((size_t)b * PP + 64) * ROPE,
                                    AO + ((size_t)b * SEQ + qb * 256) * 2048 + h * VD, 4 * qb + 5, (char*)lds_raw);
                }
            }
        }
        SEAM(4 + 2 * hb);
    }
    if (IN(7)) for (int rep = 0; rep < REPS(7); ++rep) {
        RETID();
#pragma unroll 1
        for (int slot = 0; slot < 2; ++slot) {
            if ((slot == 0) == ((C.bid & 1) != 0)) {
                cvt_table_fp8(P.in[I_PU], ws + WS_U8, (float*)(ws + WS_SU), C.vcu * 8 + C.wave, C.G * 8, C.lane);
                cvt_table_fp8(P.in[I_PV], ws + WS_V8, (float*)(ws + WS_SU) + 1, C.vcu * 8 + C.wave, C.G * 8, C.lane);
            } else {
                { pg8::Gemm g{(const bf16*)(ws + WS_ON), (const bf16*)(ws + WS_WPH), MR, DM, 1024}; SO S; S.init(MR, DM, C.G, C.bid);
                  pg8::EpiGate<false> E{(bf16*)(ws + WS_X), (const bf16*)P.out};
                  pg8::gemm_phase<pg8::EpiGate<false>, SO, true, true>(C.lds, g, S, E); }
                { pg8::Gemm g{(const bf16*)(ws + WS_AO), (const bf16*)(ws + WS_WPM), MR, DM, 2048}; SO S; S.init(MR, DM, C.G, C.bid);
                  pg8::EpiGate<true> E{(bf16*)(ws + WS_X), (const bf16*)P.out + (size_t)MR * DM};
                  pg8::gemm_phase<pg8::EpiGate<true>, SO, true, true>(C.lds, g, S, E); }
            }
        }
    }
    SEAM(7);
    if (IN(8)) for (int rep = 0; rep < REPS(8); ++rep) {
        pg8::Gemm g{(const bf16*)(ws + WS_X), (const bf16*)(ws + WS_WO), MR, DM, 1024}; SO S; S.init(MR, DM, C.G, C.bid);
        pg8::EpiResF32 E{P.out, P.in[I_X], ALPHA};
        pg8::gemm_phase<pg8::EpiResF32, SO, true, true>(C.lds, g, S, E);
    }
    SEAM(8);
    if (IN(9)) for (int rep = 0; rep < REPS(9); ++rep) { RETID(); ln1_phase(P, C, rep + 1 == REPS(9) || hi > 100); }
    SEAM(9);
    if (IN(10)) for (int rep = 0; rep < REPS(10); ++rep) {
        pg8::Gemm g{(const bf16*)(ws + WS_H1B), (const bf16*)(ws + WS_WPQ), MR, 2048, 1024}; SO S; S.init(MR, 2048, C.G, C.bid);
        pg8::EpiScaleBf16 E{(bf16*)(ws + WS_PQ), 2048, nullptr, 0};
        pg8::gemm_phase<pg8::EpiScaleBf16, SO, true, true>(C.lds, g, S, E);
    }
    SEAM(10);
    if (IN(11)) for (int rep = 0; rep < REPS(11); ++rep) { RETID(); peer_phase(P, C, rep + 1 == REPS(11) || hi > 100); }
#if PEER_SPLIT
    SEAM(11);
    if (IN(12)) for (int rep = 0; rep < REPS(12); ++rep) { RETID(); peer_v_phase(P, C, rep + 1 == REPS(12) || hi > 100); }
#endif
#undef IN
#undef SEAM
}

extern "C" void kernel_launch(void* const* d_in, const int* in_sizes, int n_in, void* d_out, int out_size, void* d_ws, size_t ws_size, hipStream_t stream) {
    static int grid = 0;
    if (grid == 0) {
        if (n_in != 20 || in_sizes[0] != MR * DM || out_size != MR * DM || ws_size < WS_NEED) {
            fprintf(stderr, "kernel_launch: unexpected shapes: n_in %d in0 %d out %d ws %zu (need %zu)\n", n_in, n_in > 0 ? in_sizes[0] : -1, out_size, ws_size, (size_t)WS_NEED); grid = -1; return; }
        int dev = 0, cus = 0, per_cu = 0;
        if (hipGetDevice(&dev) != hipSuccess || hipDeviceGetAttribute(&cus, hipDeviceAttributeMultiprocessorCount, dev) != hipSuccess) { grid = -1; return; }
        if (hipFuncSetAttribute((const void*)mega_fwd, hipFuncAttributeMaxDynamicSharedMemorySize, LDS_BYTES) != hipSuccess) { fprintf(stderr, "kernel_launch: hipFuncSetAttribute failed\n"); grid = -1; return; }
        if (hipOccupancyMaxActiveBlocksPerMultiprocessor(&per_cu, (const void*)mega_fwd, 512, LDS_BYTES) != hipSuccess || per_cu < 1) { fprintf(stderr, "kernel_launch: occupancy query says %d\n", per_cu); per_cu = 1; }
        (void)hipGetLastError();
        grid = cus;
        if (grid > 256) grid = 256;
    }
    if (grid < 0) return;
    if (hipMemsetAsync((char*)d_ws + WS_CTL, 0, 65536, stream) != hipSuccess) { fprintf(stderr, "kernel_launch: memset failed\n"); return; }
    Params p{};
    for (int i = 0; i < 20; ++i) p.in[i] = (const float*)d_in[i];
    p.out = (float*)d_out; p.ws = (unsigned char*)d_ws;
#if MK_LAUNCHES == 1
    p.ph_lo = 0; p.ph_hi = N_PHASES;
    void* args[] = {&p};
    hipError_t e = hipLaunchCooperativeKernel((const void*)mega_fwd, dim3(grid), dim3(512), args, LDS_BYTES, stream);
    if (e != hipSuccess) fprintf(stderr, "cooperative launch failed: %s (grid %d)\n", hipGetErrorString(e), grid);
#else
    for (int ph = 0; ph < N_PHASES; ++ph) {
        p.ph_lo = ph; p.ph_hi = ph + 1;
        hipLaunchKernelGGL(mega_fwd, dim3(grid), dim3(512), LDS_BYTES, stream, p);
    }
#endif
}
```

```cpp
#include <hip/hip_runtime.h>
#include <hip/hip_cooperative_groups.h>
#include <cstdio>
#include <cstdint>
#include <cmath>
namespace cg = cooperative_groups;

#ifndef MK_LAUNCHES
#define MK_LAUNCHES 1
#endif
#ifndef PEER_SAMEORDER
#define PEER_SAMEORDER 0
#endif
#ifndef PEER_SPLIT
#define PEER_SPLIT 3
#endif

constexpr int NB = 16, SEQ = 2048, DM = 1024, LEAD = 128, NPADR = 112, PP = LEAD + SEQ;
constexpr int MALL = NB * PP;
constexpr int MR = NB * SEQ;
constexpr int INW = 6848, INWP = 6912;
constexpr int N1 = 4864, N1V = 4800;
constexpr int N1G = 5888;
constexpr int PV = PP - NPADR, MV = NB * PV;
constexpr int QR = 384, KVR = 256, ROPE = 64, NH = 16, QKD = 192, VD = 128;
constexpr int HGH = 8;
constexpr float ALPHA = 1.189207115002721f;
constexpr float EPS = 1e-5f;
constexpr int NHALF = 2, HB = NB / NHALF;
constexpr int MRH = HB * SEQ, MALLH = HB * PP;

constexpr size_t MiB = 1u << 20;
constexpr size_t al256(size_t x) { return (x + 255) / 256 * 256; }
constexpr size_t WS_CTL = 0;
constexpr size_t WS_WIN = 1 * MiB;
constexpr size_t WS_WUQ = WS_WIN + (size_t)INWP * DM * 2;
constexpr size_t WS_WUKV = WS_WUQ + (size_t)3072 * QR * 2;
constexpr size_t WS_WPH = WS_WUKV + (size_t)4096 * KVR * 2;
constexpr size_t WS_WPM = WS_WPH + (size_t)1024 * 1024 * 2;
constexpr size_t WS_WO = WS_WPM + (size_t)1024 * 2048 * 2;
constexpr size_t WS_WPQ = WS_WO + (size_t)1024 * 1024 * 2;
constexpr size_t WS_SK = WS_WPQ + (size_t)2048 * 1024 * 2;
constexpr size_t WS_ROPE = WS_SK + (size_t)16 * 128 * 128 * 2;
constexpr size_t WS_RQ = WS_ROPE + (size_t)PP * 32 * 2 * 4;
constexpr size_t WS_RKV = WS_RQ + (size_t)MR * 4;
constexpr size_t WS_WEND = WS_RKV + (size_t)MALL * 4;
static_assert(WS_WEND <= 34 * MiB, "weights region");
constexpr size_t WS_C = 34 * MiB;
constexpr size_t WS_CQ = WS_C, WS_CKV = WS_CQ + (size_t)MR * QR * 2, WS_KR = WS_CKV + (size_t)MALL * KVR * 2;
static_assert(WS_KR + (size_t)MALL * ROPE * 2 <= 81 * MiB, "C region");
constexpr size_t WS_A = 81 * MiB;
constexpr size_t WS_ON = 448 * MiB;
constexpr size_t WS_B = 149 * MiB;
constexpr size_t WS_HQ = WS_B, WS_K1 = WS_HQ + (size_t)MALL * DM * 2, WS_HI = WS_K1 + (size_t)MALL * DM * 2, WS_HG = WS_HI + (size_t)MALL * DM * 2;
static_assert(WS_HG + (size_t)MR * DM * 2 <= 421 * MiB, "B region");
constexpr size_t WS_QH = 81 * MiB;
constexpr size_t WS_KVH = 177 * MiB;
constexpr size_t WS_AO = 313 * MiB;
constexpr size_t WS_X = 81 * MiB;
constexpr size_t WS_H1B = 178 * MiB;
constexpr size_t WS_U8 = 145 * MiB, WS_V8 = 161 * MiB, WS_SU = 177 * MiB, WS_SV = WS_SU + 65536;
constexpr size_t WS_ACT = 242 * MiB, WS_SIDX = 258 * MiB, WS_ACTPRE = 266 * MiB, WS_SUS = 282 * MiB;
constexpr size_t WS_PQ = 313 * MiB;
constexpr size_t WS_NEED = 512 * MiB;
static_assert(WS_AO + (size_t)MR * 2048 * 2 <= WS_ON && WS_ON + (size_t)MR * DM * 2 <= WS_NEED && WS_KVH + (size_t)MALLH * 4096 * 2 <= WS_AO && WS_QH + (size_t)MRH * 3072 * 2 <= WS_KVH && WS_HG + (size_t)MR * DM * 2 <= WS_ON && WS_A + (size_t)MV * DM * 2 <= WS_B, "attention buffers");
static_assert(WS_X + (size_t)MR * DM * 2 <= WS_U8 && WS_SV + 65536 <= WS_H1B && WS_H1B + (size_t)MR * DM * 2 <= WS_PQ && WS_PQ + (size_t)MR * 2048 * 2 <= WS_ON, "late buffers");

constexpr int LDS_BYTES = 147456;

#define LAS __attribute__((address_space(3)))
#define GAS __attribute__((address_space(1)))
typedef unsigned short bf16;
typedef unsigned v4u __attribute__((ext_vector_type(4)));
typedef unsigned v2u __attribute__((ext_vector_type(2)));
typedef float f32x2 __attribute__((ext_vector_type(2)));
typedef float f32x8 __attribute__((ext_vector_type(8)));
typedef float f32x16 __attribute__((ext_vector_type(16)));
typedef short s16x4 __attribute__((ext_vector_type(4)));

__device__ __forceinline__ unsigned f2bf(float f) { unsigned u = __builtin_bit_cast(unsigned, f); return (u + 0x7fffu + ((u >> 16) & 1u)) >> 16; }
__device__ __forceinline__ unsigned pk2(float lo, float hi) { return f2bf(lo) | (f2bf(hi) << 16); }
__device__ __forceinline__ float bflo(unsigned w) { return __builtin_bit_cast(float, w << 16); }
__device__ __forceinline__ float bfhi(unsigned w) { return __builtin_bit_cast(float, w & 0xffff0000u); }
__device__ __forceinline__ float bf2f(unsigned short h) { return __builtin_bit_cast(float, (unsigned)h << 16); }
__device__ __forceinline__ float fsigmoid(float x) { return 1.0f / (1.0f + __expf(-x)); }
__device__ __forceinline__ float wave_sum(float v) {
#pragma unroll
    for (int o = 1; o < 64; o <<= 1) v += __shfl_xor(v, o);
    return v;
}
namespace pg8 {
#define PG8_LAS __attribute__((address_space(3)))
typedef unsigned short bf16_t;
typedef short bf16x8 __attribute__((ext_vector_type(8)));
typedef float f32x4 __attribute__((ext_vector_type(4)));
typedef unsigned u32x4 __attribute__((ext_vector_type(4)));
constexpr int BM = 256, BK = 64, HALF = 128, HTB = HALF * BK * 2  , STAGE_BYTES = 8 * HTB, NXCD = 8, WGM = 8;

__host__ __device__ __forceinline__ int lds_byte(int r, int c) { const int st = (r >> 4) * 2 + (c >> 5), rr = r & 15, cc = c & 31, ob = rr * 64 + cc * 2; return st * 1024 + (ob ^ (((ob >> 9) & 1) << 5)); }
__host__ __device__ __forceinline__ void stage_rc(int b, int& R, int& C) { const int st = b / 1024, sb = b % 1024, swz = sb ^ (((sb >> 9) & 1) << 5); R = (st >> 1) * 16 + swz / 64; C = (st & 1) * 32 + (swz % 64) / 2; }
__host__ __device__ __forceinline__ int perm32(int rho) { const int n = rho >> 4, i = rho & 15; return 8 * (i >> 2) + 4 * n + (i & 3); }

struct Unit { int pm, pn; };
struct Gemm { const bf16_t* A; const bf16_t* Bt; int M, N, K; };

struct StaticOrder {
    int nM, nN, nwg, G, c;
    __host__ __device__ void init(int M, int N, int G_, int c_) { nM = M / BM; nN = N / BM; nwg = nM * nN; G = G_; c = c_; }
    __host__ __device__ bool next(int i, Unit& u) const {
        const long L = (long)i * G + c; if (L >= nwg) return false;
        int wgid = (int)L; { const int q = nwg / NXCD, r = nwg % NXCD, xcd = wgid % NXCD, off = wgid / NXCD; wgid = (xcd < r ? xcd * (q + 1) : r * (q + 1) + (xcd - r) * q) + off; }
        const int nig = WGM * nN, gid = wgid / nig, fm = gid * WGM, gsz = (nM - fm) < WGM ? (nM - fm) : WGM;
        u.pm = fm + ((wgid % nig) % gsz); u.pn = (wgid % nig) / gsz; return true;
    }
    __device__ __forceinline__ int arow(int pm) const { return pm * BM; }
    __device__ __forceinline__ void a_ready(const Unit&) const {}
    __device__ __forceinline__ void done(const Unit&) const {}
};
struct GateOrder : StaticOrder { __device__ __forceinline__ int arow(int pm) const { return (pm >> 3) * 2064 + 16 + (pm & 7) * BM; } };
struct DynGateOrder {
    unsigned* slots; unsigned* counter; int nN, nwg;
    __device__ __forceinline__ bool next(int i, Unit& u) const {
        if (i >= 16) return false;
        unsigned v = 0;
        if ((threadIdx.x & 63) == 0) {
            v = __hip_atomic_load(slots + i, __ATOMIC_RELAXED, __HIP_MEMORY_SCOPE_AGENT);
            if (v == 0u) { unsigned expect = 0u;
                if (__hip_atomic_compare_exchange_strong(slots + i, &expect, 1u, __ATOMIC_RELAXED, __ATOMIC_RELAXED, __HIP_MEMORY_SCOPE_AGENT)) {
                    const unsigned t = __hip_atomic_fetch_add(counter, 1u, __ATOMIC_RELAXED, __HIP_MEMORY_SCOPE_AGENT);
                    __hip_atomic_store(slots + i, t + 2u, __ATOMIC_RELAXED, __HIP_MEMORY_SCOPE_AGENT); } }
            unsigned sp = 0;
            while ((v = __hip_atomic_load(slots + i, __ATOMIC_RELAXED, __HIP_MEMORY_SCOPE_AGENT)) < 2u) { __builtin_amdgcn_s_sleep(1); if (++sp > (1u << 24)) { v = 0x7fffffffu; break; } }
        }
        const int t = (int)__builtin_amdgcn_readfirstlane(v) - 2;
        if (t >= nwg) return false;
        u.pm = t / nN; u.pn = t - u.pm * nN; return true;
    }
    __device__ __forceinline__ int arow(int pm) const { return (pm >> 3) * 2064 + 16 + (pm & 7) * BM; }
    __device__ __forceinline__ void a_ready(const Unit&) const {}
    __device__ __forceinline__ void done(const Unit&) const {}
};
__device__ __forceinline__ unsigned cvt_pk_bf16(float lo, float hi) { unsigned r; asm volatile("v_cvt_pk_bf16_f32 %0, %1, %2" : "=v"(r) : "v"(lo), "v"(hi)); return r; }
typedef float f32x2 __attribute__((ext_vector_type(2)));
template <class Epi, class Sched, bool ALIGN_EPI = false, bool SP2 = false>
__device__ __forceinline__ void gemm_phase(PG8_LAS unsigned char* lds, const Gemm g, const Sched& S, const Epi& E) {
    int tid_ = threadIdx.x; asm volatile("" : "+v"(tid_));
    const int tid = tid_, wid = __builtin_amdgcn_readfirstlane(tid >> 6), lane = tid & 63, wr = wid >> 2, wc = wid & 3, fr = lane & 15, fq = lane >> 4;
    int K_ = g.K; asm volatile("" : "+s"(K_));
    const int K = K_, nt = K / BK;
    unsigned voffA[2], voffB[2];
#pragma unroll
    for (int i = 0; i < 2; ++i) { int R, C; stage_rc(tid * 16 + i * 8192, R, C); const int Rb = Epi::PERM ? ((R & ~31) + perm32(R & 31)) : R;
        voffA[i] = (unsigned)(R * K + C) * 2u; voffB[i] = (unsigned)(Rb * K + C) * 2u; }
    const size_t kstep = (size_t)(BK * 2);
    const size_t hstep = (size_t)HALF * K * 2;
    const size_t tstep = 2 * hstep;
    const unsigned ldsw = (unsigned)wid * 1024u;
    const int aoff = lds_byte(wr * 64 + fr, fq * 8), boff = lds_byte(wc * 32 + fr, fq * 8);
#define PG8_SA(b, h) (((b) * 2 + (h)) * HTB)
#define PG8_SB(b, h) ((4 + (b) * 2 + (h)) * HTB)
#define PG8_STAGE(bufoff, gbase, voff) do { _Pragma("unroll") for (int _i = 0; _i < 2; ++_i) \
        __builtin_amdgcn_global_load_lds((const unsigned*)((const char*)(gbase) + (voff)[_i]), (PG8_LAS unsigned*)(lds + (bufoff) + ldsw + _i * 8192), 16, 0, 0); } while (0)
#define PG8_LDA(dst, b, h) do { _Pragma("unroll") for (int m = 0; m < 4; ++m) _Pragma("unroll") for (int k = 0; k < 2; ++k) dst[m][k] = *(const PG8_LAS bf16x8*)(lds + PG8_SA(b, h) + aoff + m * 2048 + k * 1024); } while (0)
#define PG8_LDB(dst, b, h) do { _Pragma("unroll") for (int n = 0; n < 2; ++n) _Pragma("unroll") for (int k = 0; k < 2; ++k) dst[n][k] = *(const PG8_LAS bf16x8*)(lds + PG8_SB(b, h) + boff + n * 2048 + k * 1024); } while (0)
#define PG8_MMA(ai, bj, At, Bt) do { __builtin_amdgcn_s_setprio(1); _Pragma("unroll") for (int m = 0; m < 4; ++m) _Pragma("unroll") for (int n = 0; n < 2; ++n) _Pragma("unroll") for (int k = 0; k < 2; ++k) \
        acc[ai][bj][m][n] = __builtin_amdgcn_mfma_f32_16x16x32_bf16(Bt[n][k], At[m][k], acc[ai][bj][m][n], 0, 0, 0); __builtin_amdgcn_s_setprio(0); } while (0)
#define PG8_WAIT_V(n) asm volatile("s_waitcnt vmcnt(" #n ")" ::: "memory")
#define PG8_WAIT_L(n) asm volatile("s_waitcnt lgkmcnt(" #n ")" ::: "memory")
#define PG8_BAR __builtin_amdgcn_s_barrier()
#define PG8_SCHED __builtin_amdgcn_sched_barrier(0)
    Unit cur, nxt; int ui = 0;
    if (!S.next(0, cur)) return;
    f32x4 acc[2][2][4][2];
#pragma unroll
    for (int a = 0; a < 2; ++a)
#pragma unroll
        for (int b = 0; b < 2; ++b)
#pragma unroll
            for (int m = 0; m < 4; ++m)
#pragma unroll
                for (int n = 0; n < 2; ++n) acc[a][b][m][n] = (f32x4){0.f, 0.f, 0.f, 0.f};
    bf16x8 At[4][2], B0[2][2], B1[2][2];
    const char* cA = (const char*)g.A + (size_t)S.arow(cur.pm) * (size_t)K * 2; const char* cB = (const char*)g.Bt + (size_t)cur.pn * tstep;
    S.a_ready(cur);
    if constexpr (SP2) {
        PG8_STAGE(PG8_SB(0, 0), cB, voffB); PG8_STAGE(PG8_SB(0, 1), cB + hstep, voffB); PG8_STAGE(PG8_SA(0, 0), cA, voffA); PG8_STAGE(PG8_SA(0, 1), cA + hstep, voffA);
        if (wr == 1) PG8_BAR;
        PG8_WAIT_V(2); PG8_BAR;
        PG8_STAGE(PG8_SB(1, 0), cB + kstep, voffB); PG8_STAGE(PG8_SA(1, 0), cA + kstep, voffA); PG8_STAGE(PG8_SB(1, 1), cB + hstep + kstep, voffB);
        PG8_WAIT_V(6); PG8_BAR;
    } else {
        PG8_STAGE(PG8_SB(0, 0), cB, voffB); PG8_STAGE(PG8_SA(0, 0), cA, voffA); PG8_STAGE(PG8_SB(0, 1), cB + hstep, voffB); PG8_STAGE(PG8_SA(0, 1), cA + hstep, voffA);
        if (wr == 1) PG8_BAR;
        PG8_WAIT_V(4); PG8_BAR;
        PG8_STAGE(PG8_SB(1, 0), cB + kstep, voffB); PG8_STAGE(PG8_SA(1, 0), cA + kstep, voffA); PG8_STAGE(PG8_SB(1, 1), cB + hstep + kstep, voffB);
        PG8_WAIT_V(6); PG8_BAR;
    }
    for (;;) {
        const bool has_next = S.next(ui + 1, nxt);
        const char* nA = has_next ? (const char*)g.A + (size_t)S.arow(nxt.pm) * (size_t)K * 2 : cA; const char* nB = has_next ? (const char*)g.Bt + (size_t)nxt.pn * tstep : cB;
        for (int t = 0; t < nt; t += 2) {
            const bool last = (t == nt - 2);
            const char* a1 = cA + (size_t)(t + 1) * kstep;
            const char* a2 = last ? nA : cA + (size_t)(t + 2) * kstep; const char* b2 = last ? nB : cB + (size_t)(t + 2) * kstep;
            const char* a3 = a2 + kstep; const char* b3 = b2 + kstep;
            if (last && has_next) S.a_ready(nxt);
            if constexpr (SP2) {
            PG8_LDB(B0, 0, 0); PG8_LDB(B1, 0, 1); PG8_SCHED; PG8_LDA(At, 0, 0); PG8_STAGE(PG8_SA(1, 1), a1 + hstep, voffA);
            PG8_WAIT_V(8); PG8_WAIT_L(0); PG8_BAR; PG8_MMA(0, 0, At, B0); PG8_MMA(0, 1, At, B1); PG8_BAR; PG8_SCHED;
            PG8_LDA(At, 0, 1); PG8_STAGE(PG8_SB(0, 0), b2, voffB); PG8_STAGE(PG8_SB(0, 1), b2 + hstep, voffB); PG8_STAGE(PG8_SA(0, 0), a2, voffA);
            PG8_WAIT_V(8); PG8_WAIT_L(0); PG8_BAR; PG8_MMA(1, 0, At, B0); PG8_MMA(1, 1, At, B1); PG8_BAR; PG8_SCHED;
            PG8_LDB(B0, 1, 0); PG8_LDB(B1, 1, 1); PG8_SCHED; PG8_LDA(At, 1, 0); PG8_STAGE(PG8_SA(0, 1), a2 + hstep, voffA);
            PG8_WAIT_V(8); PG8_WAIT_L(0); PG8_BAR; PG8_MMA(0, 0, At, B0); PG8_MMA(0, 1, At, B1); PG8_BAR; PG8_SCHED;
            PG8_LDA(At, 1, 1); PG8_STAGE(PG8_SB(1, 0), b3, voffB); PG8_STAGE(PG8_SB(1, 1), b3 + hstep, voffB); PG8_STAGE(PG8_SA(1, 0), a3, voffA);
            PG8_WAIT_V(8); PG8_WAIT_L(0); PG8_BAR; PG8_MMA(1, 0, At, B0); PG8_MMA(1, 1, At, B1); PG8_BAR; PG8_SCHED;
            } else {
            PG8_LDB(B0, 0, 0); PG8_SCHED; PG8_LDA(At, 0, 0); PG8_STAGE(PG8_SA(1, 1), a1 + hstep, voffA);
            PG8_WAIT_L(8); PG8_BAR; PG8_WAIT_L(0); PG8_MMA(0, 0, At, B0); PG8_BAR; PG8_SCHED;
            PG8_LDB(B1, 0, 1); PG8_STAGE(PG8_SB(0, 0), b2, voffB);
            PG8_BAR; PG8_WAIT_L(0); PG8_MMA(0, 1, At, B1); PG8_BAR;
            PG8_LDA(At, 0, 1); PG8_STAGE(PG8_SA(0, 0), a2, voffA);
            PG8_BAR; PG8_WAIT_L(0); PG8_MMA(1, 0, At, B0); PG8_BAR; PG8_SCHED;
            PG8_STAGE(PG8_SB(0, 1), b2 + hstep, voffB);
            PG8_WAIT_V(6); PG8_BAR; PG8_MMA(1, 1, At, B1); PG8_BAR;
            PG8_LDB(B0, 1, 0); PG8_SCHED; PG8_LDA(At, 1, 0); PG8_STAGE(PG8_SA(0, 1), a2 + hstep, voffA);
            PG8_WAIT_L(8); PG8_BAR; PG8_WAIT_L(0); PG8_MMA(0, 0, At, B0); PG8_BAR; PG8_SCHED;
            PG8_LDB(B1, 1, 1); PG8_STAGE(PG8_SB(1, 0), b3, voffB);
            PG8_BAR; PG8_WAIT_L(0); PG8_MMA(0, 1, At, B1); PG8_BAR;
            PG8_LDA(At, 1, 1); PG8_STAGE(PG8_SA(1, 0), a3, voffA);
            PG8_BAR; PG8_WAIT_L(0); PG8_MMA(1, 0, At, B0); PG8_BAR; PG8_SCHED;
            PG8_STAGE(PG8_SB(1, 1), b3 + hstep, voffB);
            PG8_WAIT_V(6); PG8_BAR; PG8_MMA(1, 1, At, B1); PG8_BAR;
            }
        }
        if constexpr (ALIGN_EPI) { if (wr == 0) PG8_BAR; }
        if constexpr (!Epi::AFTER_DRAIN) { E(acc, cur, wr, wc, fr, fq); S.done(cur); }
        if (!has_next) break;
#pragma unroll
        for (int a = 0; a < 2; ++a)
#pragma unroll
            for (int b = 0; b < 2; ++b)
#pragma unroll
                for (int m = 0; m < 4; ++m)
#pragma unroll
                    for (int n = 0; n < 2; ++n) acc[a][b][m][n] = (f32x4){0.f, 0.f, 0.f, 0.f};
        cur = nxt; cA = nA; cB = nB; ++ui;
        if constexpr (ALIGN_EPI) { if (wr == 1) PG8_BAR; }
    }
    PG8_WAIT_V(0);
    if constexpr (!ALIGN_EPI) { if (wr == 0) PG8_BAR; }
    PG8_BAR;
    if constexpr (Epi::AFTER_DRAIN) { E.fused(acc, cur, wr, wc, fr, fq, lds, wid, lane); S.done(cur); }
#undef PG8_SA
#undef PG8_SB
#undef PG8_STAGE
#undef PG8_LDA
#undef PG8_LDB
#undef PG8_MMA
#undef PG8_WAIT_V
#undef PG8_WAIT_L
#undef PG8_BAR
#undef PG8_SCHED
}
}

namespace pg8 {
__device__ __forceinline__ u32x4 pack8(const f32x4 a, const f32x4 b) { u32x4 w; w.x = cvt_pk_bf16(a[0], a[1]); w.y = cvt_pk_bf16(a[2], a[3]); w.z = cvt_pk_bf16(b[0], b[1]); w.w = cvt_pk_bf16(b[2], b[3]); return w; }

template <bool RAW> struct EpiInProjT {
    static constexpr bool PERM = true, AFTER_DRAIN = false;
    bf16_t *HQ, *K1, *HI, *HG, *CQ, *CKV, *KR, *GA, *GB; const float* lbl; const float* rope;
    __device__ __forceinline__ void operator()(const f32x4 (&acc)[2][2][4][2], const Unit& u, int wr, int wc, int fr_, int fq_) const {
        int fr = fr_, fq = fq_; asm volatile("" : "+v"(fr), "+v"(fq));
#pragma unroll
        for (int bj = 0; bj < 2; ++bj) {
            const int c = u.pn * BM + bj * HALF + wc * 32 + 8 * fq;
            if (c >= N1V) continue;
            int seg, cc;
            if (c < 4096) { seg = c >> 10; cc = c & 1023; }
            else if (c < 4480) { seg = 4; cc = c - 4096; }
            else if (c < 4736) { seg = 5; cc = c - 4480; }
            else { seg = 6; cc = c - 4736; }
            float oml[8];
            if (seg == 1 && !RAW) {
#pragma unroll
                for (int j = 0; j < 8; ++j) { const float l0 = lbl[cc + j], l1 = lbl[1024 + cc + j]; oml[j] = 1.0f - __builtin_amdgcn_rcpf(1.0f + __expf(l1 - l0)); }
            }
#pragma unroll
            for (int ai = 0; ai < 2; ++ai)
#pragma unroll
                for (int m = 0; m < 4; ++m) {
                    const int Rc = u.pm * BM + ai * HALF + wr * 64 + m * 16 + fr;
                    const int b = Rc / PV, p = NPADR + (Rc - b * PV); const int R = b * PP + p; const bool real = p >= LEAD; const size_t rr = (size_t)b * SEQ + (p - LEAD);
                    f32x4 v0 = acc[ai][bj][m][0], v1 = acc[ai][bj][m][1];
                    if (RAW && seg != 0 && seg != 2 && seg != 5) { if (seg == 1) *(u32x4*)(K1 + (size_t)R * DM + cc) = pack8(v0, v1); else if (seg == 6) *(u32x4*)(KR + (size_t)R * ROPE + cc) = pack8(v0, v1); else if (real) { if (seg == 3) *(u32x4*)(HG + rr * DM + cc) = pack8(v0, v1); else if (seg == 4) *(u32x4*)(CQ + rr * QR + cc) = pack8(v0, v1); else *(u32x4*)((seg == 7 ? GA : GB) + rr * DM + cc) = pack8(v0, v1); } }
                    else if (seg == 0) { *(u32x4*)(HQ + (size_t)R * DM + cc) = pack8(v0, v1); }
                    else if (seg == 1) {
#pragma unroll
                        for (int j = 0; j < 4; ++j) { v0[j] = oml[j] * __builtin_amdgcn_rcpf(1.0f + __expf(v0[j])); v1[j] = oml[4 + j] * __builtin_amdgcn_rcpf(1.0f + __expf(v1[j])); }
                        *(u32x4*)(K1 + (size_t)R * DM + cc) = pack8(v0, v1); }
                    else if (seg == 2) { *(u32x4*)(HI + (size_t)R * DM + cc) = pack8(v0, v1); }
                    else if (seg == 3) { if (real) {
#pragma unroll
                        for (int j = 0; j < 4; ++j) { v0[j] = v0[j] * __builtin_amdgcn_rcpf(1.0f + __expf(-v0[j])); v1[j] = v1[j] * __builtin_amdgcn_rcpf(1.0f + __expf(-v1[j])); }
                        *(u32x4*)(HG + rr * DM + cc) = pack8(v0, v1); } }
                    else if (seg == 4) { if (real) *(u32x4*)(CQ + rr * QR + cc) = pack8(v0, v1); }
                    else if (seg == 5) { *(u32x4*)(CKV + (size_t)R * KVR + cc) = pack8(v0, v1); }
                    else if (seg == 6) {
                        const f32x4* tp = (const f32x4*)(rope + ((size_t)p * 32 + (cc >> 1)) * 2);
                        const f32x4 t0 = tp[0], t1 = tp[1];
                        f32x4 o0, o1;
                        o0[0] = v0[0] * t0[0] - v0[1] * t0[1]; o0[1] = v0[1] * t0[0] + v0[0] * t0[1];
                        o0[2] = v0[2] * t0[2] - v0[3] * t0[3]; o0[3] = v0[3] * t0[2] + v0[2] * t0[3];
                        o1[0] = v1[0] * t1[0] - v1[1] * t1[1]; o1[1] = v1[1] * t1[0] + v1[0] * t1[1];
                        o1[2] = v1[2] * t1[2] - v1[3] * t1[3]; o1[3] = v1[3] * t1[2] + v1[2] * t1[3];
                        *(u32x4*)(KR + (size_t)R * ROPE + cc) = pack8(o0, o1); }
                    else { if (real) {
#pragma unroll
                        for (int j = 0; j < 4; ++j) { v0[j] = __builtin_amdgcn_rcpf(1.0f + __expf(-v0[j])); v1[j] = __builtin_amdgcn_rcpf(1.0f + __expf(-v1[j])); }
                        *(u32x4*)((seg == 7 ? GA : GB) + rr * DM + cc) = pack8(v0, v1); } }
                }
        }
    }
};

typedef EpiInProjT<false> EpiInProj;


struct EpiGates {
    static constexpr bool PERM = true, AFTER_DRAIN = false;
    bf16_t *GA, *GB;
    __device__ __forceinline__ void operator()(const f32x4 (&acc)[2][2][4][2], const Unit& u, int wr, int wc, int fr_, int fq_) const {
        int fr = fr_, fq = fq_; asm volatile("" : "+v"(fr), "+v"(fq));
#pragma unroll
        for (int bj = 0; bj < 2; ++bj) { const int c = u.pn * BM + bj * HALF + wc * 32 + 8 * fq; bf16_t* dst = (c < 1024 ? GA : GB) + (c & 1023);
#pragma unroll
            for (int ai = 0; ai < 2; ++ai)
#pragma unroll
                for (int m = 0; m < 4; ++m) { const size_t rr = (size_t)(u.pm * BM + ai * HALF + wr * 64 + m * 16 + fr);
                    f32x4 v0 = acc[ai][bj][m][0], v1 = acc[ai][bj][m][1];
#pragma unroll
                    for (int j = 0; j < 4; ++j) { v0[j] = __builtin_amdgcn_rcpf(1.0f + __expf(-v0[j])); v1[j] = __builtin_amdgcn_rcpf(1.0f + __expf(-v1[j])); }
                    *(u32x4*)(dst + rr * DM) = pack8(v0, v1); } }
    }
};

struct EpiQ {
    static constexpr bool PERM = true, AFTER_DRAIN = false;
    bf16_t* Q; const float* rq; const float* rope; int row_base;
    __device__ __forceinline__ void operator()(const f32x4 (&acc)[2][2][4][2], const Unit& u, int wr, int wc, int fr_, int fq_) const {
        int fr = fr_, fq = fq_; asm volatile("" : "+v"(fr), "+v"(fq));
        float sc[8];
#pragma unroll
        for (int i = 0; i < 8; ++i) sc[i] = rq[row_base + u.pm * BM + (i >> 2) * HALF + wr * 64 + (i & 3) * 16 + fr];
#pragma unroll
        for (int bj = 0; bj < 2; ++bj) {
            const int c = u.pn * BM + bj * HALF + wc * 32 + 8 * fq; const int hc = c % QKD; const bool isr = hc >= 128; const int pi = (hc - 128) >> 1;
#pragma unroll
            for (int ai = 0; ai < 2; ++ai) {
                f32x4 t0[4], t1[4];
                if (isr) {
#pragma unroll
                    for (int m = 0; m < 4; ++m) { const int rr = row_base + u.pm * BM + ai * HALF + wr * 64 + m * 16 + fr; const int p = LEAD + (rr & (SEQ - 1));
                        const f32x4* tp = (const f32x4*)(rope + ((size_t)p * 32 + pi) * 2); t0[m] = tp[0]; t1[m] = tp[1]; }
                }
#pragma unroll
                for (int m = 0; m < 4; ++m) {
                    const int rl = u.pm * BM + ai * HALF + wr * 64 + m * 16 + fr; const float s = sc[ai * 4 + m];
                    f32x4 v0 = acc[ai][bj][m][0] * s, v1 = acc[ai][bj][m][1] * s;
                    if (isr) {
                        f32x4 o0, o1;
                        o0[0] = v0[0] * t0[m][0] - v0[1] * t0[m][1]; o0[1] = v0[1] * t0[m][0] + v0[0] * t0[m][1];
                        o0[2] = v0[2] * t0[m][2] - v0[3] * t0[m][3]; o0[3] = v0[3] * t0[m][2] + v0[2] * t0[m][3];
                        o1[0] = v1[0] * t1[m][0] - v1[1] * t1[m][1]; o1[1] = v1[1] * t1[m][0] + v1[0] * t1[m][1];
                        o1[2] = v1[2] * t1[m][2] - v1[3] * t1[m][3]; o1[3] = v1[3] * t1[m][2] + v1[2] * t1[m][3];
                        v0 = o0; v1 = o1;
                    }
                    *(u32x4*)(Q + (size_t)rl * 3072 + c) = pack8(v0, v1);
                }
            }
        }
    }
};
struct EpiScaleBf16 {
    static constexpr bool PERM = true, AFTER_DRAIN = false;
    bf16_t* O; int ldc; const float* rs; int row_base;
    __device__ __forceinline__ void operator()(const f32x4 (&acc)[2][2][4][2], const Unit& u, int wr, int wc, int fr_, int fq_) const {
        int fr = fr_, fq = fq_; asm volatile("" : "+v"(fr), "+v"(fq));
        float sc[8];
#pragma unroll
        for (int i = 0; i < 8; ++i) sc[i] = rs ? rs[row_base + u.pm * BM + (i >> 2) * HALF + wr * 64 + (i & 3) * 16 + fr] : 1.0f;
#pragma unroll
        for (int ai = 0; ai < 2; ++ai)
#pragma unroll
            for (int m = 0; m < 4; ++m) {
                const int rl = u.pm * BM + ai * HALF + wr * 64 + m * 16 + fr; const float s = sc[ai * 4 + m];
#pragma unroll
                for (int bj = 0; bj < 2; ++bj) { const int c = u.pn * BM + bj * HALF + wc * 32 + 8 * fq;
                    *(u32x4*)(O + (size_t)rl * ldc + c) = pack8(acc[ai][bj][m][0] * s, acc[ai][bj][m][1] * s); }
            }
    }
};
template <bool ACCUM> struct EpiGate {
    static constexpr bool PERM = true, AFTER_DRAIN = false;
    bf16_t* X; const bf16_t* G;
    __device__ __forceinline__ void operator()(const f32x4 (&acc)[2][2][4][2], const Unit& u, int wr, int wc, int fr_, int fq_) const {
        int fr = fr_, fq = fq_; asm volatile("" : "+v"(fr), "+v"(fq));
#pragma unroll
        for (int ai = 0; ai < 2; ++ai)
#pragma unroll
            for (int mh = 0; mh < 2; ++mh) {
                u32x4 g[2][2], x[2][2];
#pragma unroll
                for (int mm = 0; mm < 2; ++mm) { const size_t rl = (size_t)(u.pm * BM + ai * HALF + wr * 64 + (mh * 2 + mm) * 16 + fr);
#pragma unroll
                    for (int bj = 0; bj < 2; ++bj) { const int c = u.pn * BM + bj * HALF + wc * 32 + 8 * fq; g[mm][bj] = *(const u32x4*)(G + rl * DM + c); if (ACCUM) x[mm][bj] = *(const u32x4*)(X + rl * DM + c); } }
#pragma unroll
                for (int mm = 0; mm < 2; ++mm) { const int m = mh * 2 + mm; const size_t rl = (size_t)(u.pm * BM + ai * HALF + wr * 64 + m * 16 + fr);
#pragma unroll
                    for (int bj = 0; bj < 2; ++bj) { const int c = u.pn * BM + bj * HALF + wc * 32 + 8 * fq; const u32x4 gg = g[mm][bj];
                        f32x4 v0 = acc[ai][bj][m][0], v1 = acc[ai][bj][m][1];
                        v0[0] *= bflo(gg.x); v0[1] *= bfhi(gg.x); v0[2] *= bflo(gg.y); v0[3] *= bfhi(gg.y);
                        v1[0] *= bflo(gg.z); v1[1] *= bfhi(gg.z); v1[2] *= bflo(gg.w); v1[3] *= bfhi(gg.w);
                        if (ACCUM) { const u32x4 xx = x[mm][bj];
                            v0[0] += bflo(xx.x); v0[1] += bfhi(xx.x); v0[2] += bflo(xx.y); v0[3] += bfhi(xx.y);
                            v1[0] += bflo(xx.z); v1[1] += bfhi(xx.z); v1[2] += bflo(xx.w); v1[3] += bfhi(xx.w); }
                        *(u32x4*)(X + rl * DM + c) = pack8(v0, v1); } }
            }
    }
};
struct EpiResF32 {
    static constexpr bool PERM = false, AFTER_DRAIN = false;
    float* Y; const float* base; float alpha;
    __device__ __forceinline__ void operator()(const f32x4 (&acc)[2][2][4][2], const Unit& u, int wr, int wc, int fr_, int fq_) const {
        int fr = fr_, fq = fq_; asm volatile("" : "+v"(fr), "+v"(fq));
        const int col0 = u.pn * BM + wc * 32 + 4 * fq;
#pragma unroll
        for (int ai = 0; ai < 2; ++ai)
#pragma unroll
            for (int mh = 0; mh < 2; ++mh) {
                f32x4 bs[2][2][2];
#pragma unroll
                for (int mm = 0; mm < 2; ++mm) { const size_t off = (size_t)(u.pm * BM + ai * HALF + wr * 64 + (mh * 2 + mm) * 16 + fr) * DM + col0;
#pragma unroll
                    for (int bj = 0; bj < 2; ++bj)
#pragma unroll
                        for (int n = 0; n < 2; ++n) bs[mm][bj][n] = *(const f32x4*)(base + off + bj * HALF + n * 16); }
#pragma unroll
                for (int mm = 0; mm < 2; ++mm) { const int m = mh * 2 + mm; const size_t off = (size_t)(u.pm * BM + ai * HALF + wr * 64 + m * 16 + fr) * DM + col0;
#pragma unroll
                    for (int bj = 0; bj < 2; ++bj)
#pragma unroll
                        for (int n = 0; n < 2; ++n) *(f32x4*)(Y + off + bj * HALF + n * 16) = bs[mm][bj][n] * alpha + acc[ai][bj][m][n]; }
            }
    }
};

struct EpiNoStore {
    static constexpr bool PERM = true, AFTER_DRAIN = false;
    bf16_t* O; int flag;
    __device__ __forceinline__ void operator()(const f32x4 (&acc)[2][2][4][2], const Unit& u, int wr, int wc, int fr, int fq) const {
        f32x4 s = {0.f, 0.f, 0.f, 0.f};
#pragma unroll
        for (int ai = 0; ai < 2; ++ai)
#pragma unroll
            for (int bj = 0; bj < 2; ++bj)
#pragma unroll
                for (int m = 0; m < 4; ++m) { s += acc[ai][bj][m][0]; s += acc[ai][bj][m][1]; }
        if (flag) *(f32x4*)(O + (size_t)(u.pm * 256 + fr) * 64 + fq * 8) = s;
    }
};
}

namespace attn {
using bf16x8 = __attribute__((ext_vector_type(8))) short;
using u32x4 = __attribute__((ext_vector_type(4))) unsigned;
constexpr float SCALE = 0.07216878364870322f;
constexpr float THR = 8.f;
constexpr int SHM_V = 16384, SHM_K = 16384, SHM_R = 8192;
constexpr int OFF_V = 0, OFF_K = 2 * SHM_V, OFF_R = OFF_K + 2 * SHM_K, OFF_WS = OFF_R + 2 * SHM_R, LDS_USED = OFF_WS + 8 * 64 * 4;
#define KSWZ(row, colB) ((row) * 256 + ((colB) ^ (((row) & 7) << 4)))
#define RSWZ(row, colB) ((row) * 128 + ((colB) ^ (((row) & 7) << 4)))
#define SBAR() __builtin_amdgcn_sched_barrier(0)
__device__ __forceinline__ int crow(int r, int hi) { return (r & 3) + 8 * (r >> 2) + 4 * hi; }
__device__ __forceinline__ unsigned cvtpk(float lo, float hi) { unsigned r; asm volatile("v_cvt_pk_bf16_f32 %0, %1, %2" : "=v"(r) : "v"(lo), "v"(hi)); return r; }
__device__ __forceinline__ bf16x8 ld8(const bf16* p) { return *reinterpret_cast<const bf16x8*>(p); }

__device__ __forceinline__ void partialSM(f32x16& p0, f32x16& p1, float& m_reg, float& mn, float& alpha) {
  constexpr float C = SCALE * 1.4426950408889634f;
  float pmax = p0[0];
#pragma unroll
  for (int r = 1; r < 16; ++r) pmax = fmaxf(pmax, p0[r]);
#pragma unroll
  for (int r = 0; r < 16; ++r) pmax = fmaxf(pmax, p1[r]);
  { auto rr = __builtin_amdgcn_permlane32_swap(__float_as_uint(pmax), __float_as_uint(pmax), false, false);
    pmax = fmaxf(__uint_as_float(rr[0]), __uint_as_float(rr[1])); }
  if (__builtin_expect(__all(pmax - m_reg <= THR / SCALE), 1)) { mn = m_reg; alpha = 1.f; }
  else { mn = fmaxf(m_reg, pmax); alpha = __builtin_amdgcn_exp2f((m_reg - mn) * C); m_reg = mn; }
  float mnC = -mn * C;
#pragma unroll
  for (int r = 0; r < 16; ++r) p0[r] = fmaf(p0[r], C, mnC);
#pragma unroll
  for (int r = 0; r < 16; ++r) p1[r] = fmaf(p1[r], C, mnC);
#pragma unroll
  for (int r = 0; r < 16; ++r) p0[r] = __builtin_amdgcn_exp2f(p0[r]);
}
__device__ __forceinline__ void finishSM(f32x16& p0, f32x16& p1, float alpha, float& l_reg, bf16x8& pa0, bf16x8& pa1, bf16x8& pa2, bf16x8& pa3) {
#pragma unroll
  for (int r = 0; r < 16; ++r) p1[r] = __builtin_amdgcn_exp2f(p1[r]);
  float ps = 0;
#pragma unroll
  for (int r = 0; r < 16; ++r) ps += p0[r];
#pragma unroll
  for (int r = 0; r < 16; ++r) ps += p1[r];
  { auto rr = __builtin_amdgcn_permlane32_swap(__float_as_uint(ps), __float_as_uint(ps), false, false);
    ps = __uint_as_float(rr[0]) + __uint_as_float(rr[1]); }
  l_reg = l_reg * alpha + ps;
#define PK4(P, BASE, OUT) do { unsigned a0 = cvtpk(P[BASE + 0], P[BASE + 1]), a1 = cvtpk(P[BASE + 2], P[BASE + 3]);   \
    unsigned b0 = cvtpk(P[BASE + 4], P[BASE + 5]), b1 = cvtpk(P[BASE + 6], P[BASE + 7]);                              \
    auto r0 = __builtin_amdgcn_permlane32_swap(a0, b0, false, false); auto r1 = __builtin_amdgcn_permlane32_swap(a1, b1, false, false); \
    u32x4 w = {r0[0], r1[0], r0[1], r1[1]}; OUT = *reinterpret_cast<bf16x8*>(&w); } while (0)
  PK4(p0, 0, pa0); PK4(p0, 8, pa1); PK4(p1, 0, pa2); PK4(p1, 8, pa3);
#undef PK4
}
__device__ __forceinline__ void qkt(f32x16& p0, f32x16& p1, const char* Ks, const char* Rs, const bf16x8* qr, int r32, int hi) {
  p0 = f32x16{}; p1 = f32x16{};
#pragma unroll
  for (int d0 = 0; d0 < 8; ++d0) { int cb = (d0 * 16 + hi * 8) * 2;
    bf16x8 b0 = *reinterpret_cast<const bf16x8*>(Ks + KSWZ(r32, cb));
    bf16x8 b1 = *reinterpret_cast<const bf16x8*>(Ks + KSWZ(32 + r32, cb));
    p0 = __builtin_amdgcn_mfma_f32_32x32x16_bf16(b0, qr[d0], p0, 0, 0, 0);
    p1 = __builtin_amdgcn_mfma_f32_32x32x16_bf16(b1, qr[d0], p1, 0, 0, 0); }
#pragma unroll
  for (int d0 = 0; d0 < 4; ++d0) { int cb = (d0 * 16 + hi * 8) * 2;
    bf16x8 b0 = *reinterpret_cast<const bf16x8*>(Rs + RSWZ(r32, cb));
    bf16x8 b1 = *reinterpret_cast<const bf16x8*>(Rs + RSWZ(32 + r32, cb));
    p0 = __builtin_amdgcn_mfma_f32_32x32x16_bf16(b0, qr[8 + d0], p0, 0, 0, 0);
    p1 = __builtin_amdgcn_mfma_f32_32x32x16_bf16(b1, qr[8 + d0], p1, 0, 0, 0); }
}
__device__ __forceinline__ void amask(f32x16& p0, f32x16& p1, int t, int NT, int qrel, int hi) {
  const float NEG = -INFINITY;
  if (t == 0) {
#pragma unroll
    for (int r = 0; r < 16; ++r) p0[r] = NEG;
#pragma unroll
    for (int r = 0; r < 8; ++r) p1[r] = NEG;
  } else if (t >= NT - 4) {
    const int d = qrel - 64 * (t - (NT - 4)) - 4 * hi;
#pragma unroll
    for (int r = 0; r < 16; ++r) { if ((r & 3) + 8 * (r >> 2) > d) p0[r] = NEG; if ((r & 3) + 8 * (r >> 2) + 32 > d) p1[r] = NEG; }
  }
}
__device__ __forceinline__ int v_st(int k, int c) { const int kk = (k & ~0xC) | ((k & 4) << 1) | ((k & 8) >> 1); return ((kk >> 3) * 4 + (c >> 5)) * 512 + ((kk & 7) * 32 + (c & 31)) * 2; }
__device__ __forceinline__ int v_rd_base(int lane) { return ((lane & 3) << 3) | (((lane >> 2) & 3) << 6) | (((lane >> 4) & 1) << 5) | (((lane >> 5) & 1) << 8); }
constexpr int v_rd_off(int d0, int ks, int half) { return d0 * 512 + ks * 4096 + half * 2048; }
template <int OFF> __device__ __forceinline__ s16x4 tr_read(int vb) {
  s16x4 r; asm volatile("ds_read_b64_tr_b16 %0, %1 offset:%2" : "=&v"(r) : "v"(vb), "i"(OFF) : "memory"); return r;
}
template <int D0> __device__ __forceinline__ void pv_one(f32x16& od, int vb, bf16x8 pa0, bf16x8 pa1, bf16x8 pa2, bf16x8 pa3) {
  const s16x4 l0 = tr_read<v_rd_off(D0, 0, 0)>(vb), h0 = tr_read<v_rd_off(D0, 0, 1)>(vb), l1 = tr_read<v_rd_off(D0, 1, 0)>(vb), h1 = tr_read<v_rd_off(D0, 1, 1)>(vb);
  const s16x4 l2 = tr_read<v_rd_off(D0, 2, 0)>(vb), h2 = tr_read<v_rd_off(D0, 2, 1)>(vb), l3 = tr_read<v_rd_off(D0, 3, 0)>(vb), h3 = tr_read<v_rd_off(D0, 3, 1)>(vb);
  asm volatile("s_waitcnt lgkmcnt(0)" ::: "memory"); SBAR();
#define PK(L, H) (bf16x8){L[0], L[1], L[2], L[3], H[0], H[1], H[2], H[3]}
  od = __builtin_amdgcn_mfma_f32_32x32x16_bf16(pa0, PK(l0, h0), od, 0, 0, 0);
  od = __builtin_amdgcn_mfma_f32_32x32x16_bf16(pa1, PK(l1, h1), od, 0, 0, 0);
  od = __builtin_amdgcn_mfma_f32_32x32x16_bf16(pa2, PK(l2, h2), od, 0, 0, 0);
  od = __builtin_amdgcn_mfma_f32_32x32x16_bf16(pa3, PK(l3, h3), od, 0, 0, 0);
#undef PK
}
__device__ __forceinline__ void pv_d0(f32x16* o, int vb, bf16x8 pa0, bf16x8 pa1, bf16x8 pa2, bf16x8 pa3) {
  pv_one<0>(o[0], vb, pa0, pa1, pa2, pa3); pv_one<1>(o[1], vb, pa0, pa1, pa2, pa3); pv_one<2>(o[2], vb, pa0, pa1, pa2, pa3); pv_one<3>(o[3], vb, pa0, pa1, pa2, pa3);
}

__device__ __forceinline__ void attn_unit(const bf16* __restrict__ Qb, const bf16* __restrict__ Kh, const bf16* __restrict__ Rh, bf16* __restrict__ Ob, int NT, char* lds) {
  int tid_ = threadIdx.x; asm volatile("" : "+v"(tid_));
  const int tid = tid_, wid = tid >> 6, lane = tid & 63, r32 = lane & 31, hi = lane >> 5;
  const bf16* Vh = Kh + 128;
  char* V_lds = lds + OFF_V; char* K_lds = lds + OFF_K; char* R_lds = lds + OFF_R;
  float* ws = (float*)(lds + OFF_WS) + wid * 64; float* li_l = ws; float* al_l = ws + 32;
  float m_reg = -1e30f, l_reg = 0; f32x16 o[4] = {}; bf16x8 qr[12];
  const bf16* Qw = Qb + (long)(wid * 32 + r32) * 3072 + hi * 8;
#pragma unroll
  for (int d0 = 0; d0 < 12; ++d0) qr[d0] = ld8(Qw + d0 * 16);
  const int sr = tid >> 4, sc = (tid & 15) * 8, vst0 = v_st(sr, sc), vst1 = v_st(32 + sr, sc);
  const int rrow = tid >> 3, rcol = (tid & 7) * 8;
  const int vb0 = (int)(uintptr_t)V_lds + v_rd_base(lane);
  const int qrel = wid * 32 + r32;
  bf16x8 vs0, vs1, ks0, ks1, rs0;
#define SLOAD(k0) do { vs0 = ld8(&Vh[(long)((k0) + sr) * 4096 + sc]); vs1 = ld8(&Vh[(long)((k0) + 32 + sr) * 4096 + sc]); \
    ks0 = ld8(&Kh[(long)((k0) + sr) * 4096 + sc]); ks1 = ld8(&Kh[(long)((k0) + 32 + sr) * 4096 + sc]); rs0 = ld8(&Rh[(long)((k0) + rrow) * 64 + rcol]); } while (0)
#define SWRITE(b) do { *(bf16x8*)(V_lds + (b) * SHM_V + vst0) = vs0; *(bf16x8*)(V_lds + (b) * SHM_V + vst1) = vs1; const int kc = sc * 2; \
    *(bf16x8*)(K_lds + (b) * SHM_K + KSWZ(sr, kc)) = ks0; *(bf16x8*)(K_lds + (b) * SHM_K + KSWZ(32 + sr, kc)) = ks1; \
    *(bf16x8*)(R_lds + (b) * SHM_R + RSWZ(rrow, rcol * 2)) = rs0; } while (0)
#define SWAIT() asm volatile("s_waitcnt vmcnt(0)" ::: "memory")
#define RESC(a) do { if (__any((a) < 1.f)) { if (hi == 0) al_l[r32] = (a); asm volatile("s_waitcnt lgkmcnt(0)" ::: "memory"); \
    _Pragma("unroll") for (int d = 0; d < 4; ++d) _Pragma("unroll") for (int r = 0; r < 16; ++r) o[d][r] *= al_l[crow(r, hi)]; } } while (0)
  f32x16 pA0, pA1, pB0, pB1; float mnA, mnB, alA, alB; bf16x8 pa0, pa1, pa2, pa3;
  SLOAD(0); SWAIT(); SWRITE(0); __syncthreads();
  qkt(pA0, pA1, K_lds, R_lds, qr, r32, hi); amask(pA0, pA1, 0, NT, qrel, hi); partialSM(pA0, pA1, m_reg, mnA, alA);
  SLOAD(64); SWAIT(); SWRITE(1); __syncthreads();
  for (int j = 1; j + 1 < NT; j += 2) {
    SBAR(); qkt(pB0, pB1, K_lds + SHM_K, R_lds + SHM_R, qr, r32, hi); amask(pB0, pB1, j, NT, qrel, hi);
    finishSM(pA0, pA1, alA, l_reg, pa0, pa1, pa2, pa3); SBAR();
    SLOAD((j + 1) * 64); SBAR();
    pv_d0(o, vb0, pa0, pa1, pa2, pa3); partialSM(pB0, pB1, m_reg, mnB, alB);
    __syncthreads(); SWAIT(); SWRITE(0);
    RESC(alB); __syncthreads();
    SBAR(); qkt(pA0, pA1, K_lds, R_lds, qr, r32, hi); amask(pA0, pA1, j + 1, NT, qrel, hi);
    finishSM(pB0, pB1, alB, l_reg, pa0, pa1, pa2, pa3); SBAR();
    const bool more = (j + 2 < NT);
    if (more) SLOAD((j + 2) * 64);
    SBAR();
    pv_d0(o, vb0 + SHM_V, pa0, pa1, pa2, pa3); partialSM(pA0, pA1, m_reg, mnA, alA);
    __syncthreads(); SWAIT(); if (more) SWRITE(1);
    RESC(alA); __syncthreads();
  }
  finishSM(pA0, pA1, alA, l_reg, pa0, pa1, pa2, pa3); SBAR();
  pv_d0(o, vb0, pa0, pa1, pa2, pa3);
  if (hi == 0) li_l[r32] = l_reg; asm volatile("s_waitcnt lgkmcnt(0)" ::: "memory");
  float rli[16];
#pragma unroll
  for (int r = 0; r < 16; ++r) rli[r] = __builtin_amdgcn_rcpf(li_l[crow(r, hi)]);
  __syncthreads();
  { unsigned short* stg = (unsigned short*)(lds + wid * 8192);
#pragma unroll
    for (int r = 0; r < 16; ++r) { const int orow = crow(r, hi);
#pragma unroll
      for (int d0 = 0; d0 < 4; ++d0) stg[orow * 128 + d0 * 32 + r32] = (unsigned short)f2bf(o[d0][r] * rli[r]); }
    asm volatile("s_waitcnt lgkmcnt(0)" ::: "memory");
#pragma unroll
    for (int i = 0; i < 8; ++i) { const int row = i * 4 + (lane >> 4), ch = lane & 15;
      const u32x4 v = *(const u32x4*)(stg + row * 128 + ch * 8); *(u32x4*)(Ob + (long)(wid * 32 + row) * 2048 + ch * 8) = v; } }
  __syncthreads();
#undef SLOAD
#undef SWRITE
#undef SWAIT
#undef RESC
}
#undef KSWZ
#undef RSWZ
#undef SBAR
}


struct Params {
    const float* in[20];
    float* out; unsigned char* ws;
    int ph_lo, ph_hi;
};
enum { I_X = 0, I_META, I_LBL, I_WIN, I_QG, I_KVG, I_WUQ, I_WUKV, I_HGG, I_WPH, I_WPM, I_WO, I_LN1G, I_LN1B, I_PQ, I_SK, I_PU, I_PV, I_LN2G, I_LN2B };

struct Ctx { LAS unsigned char* lds; int tid, lane, wave, G, bid, vcu; };

template <class CM> __device__ __forceinline__ void transpose_w(const float* __restrict__ W, int K, int N, int NP, bf16* __restrict__ WT, const float* __restrict__ ks, LAS float* scr, int gw, int NGW, int lane, CM cm) {
    const int nblk = NP / 32, items = (K / 64) * nblk;
    for (int it = gw; it < items; it += NGW) {
        const int kb = it / nblk, nb = it % nblk, k0 = 64 * kb, n0 = 32 * nb;
        const int scol = cm(n0 + (lane & 31));
#pragma unroll 16
        for (int i = 0; i < 32; ++i) { const int kk = 2 * i + (lane >> 5); float v = scol >= 0 ? W[(size_t)(k0 + kk) * N + scol] : 0.f; if (ks) v *= ks[k0 + kk]; scr[kk * 33 + (lane & 31)] = v; }
        asm volatile("s_waitcnt lgkmcnt(0)" ::: "memory");
        const int c = lane & 7;
#pragma unroll
        for (int j = 0; j < 4; ++j) { const int n = (lane >> 3) + 8 * j; const LAS float* s = scr + (8 * c) * 33 + n;
            v4u o; o.x = pk2(s[0 * 33], s[1 * 33]); o.y = pk2(s[2 * 33], s[3 * 33]); o.z = pk2(s[4 * 33], s[5 * 33]); o.w = pk2(s[6 * 33], s[7 * 33]);
            *(v4u*)(WT + (size_t)(n0 + n) * K + k0 + 8 * c) = o; }
        asm volatile("s_waitcnt lgkmcnt(0)" ::: "memory");
    }
}
__device__ __forceinline__ int rope_src(int j) { return (j & 1) ? 32 + (j >> 1) : (j >> 1); }

__device__ __forceinline__ void cvt_rows(const float* __restrict__ src, bf16* __restrict__ dst, size_t n8, size_t gt, size_t NGT) {
    for (size_t i = gt; i < n8; i += NGT) { const pg8::f32x4 a = *(const pg8::f32x4*)(src + i * 8), b = *(const pg8::f32x4*)(src + i * 8 + 4);
        v4u o; o.x = pk2(a[0], a[1]); o.y = pk2(a[2], a[3]); o.z = pk2(b[0], b[1]); o.w = pk2(b[2], b[3]); *(v4u*)(dst + i * 8) = o; }
}


__device__ __forceinline__ void late_weights(const Params& P, const Ctx& C, int gw, int NGW, size_t gt, size_t NGT, int part  ) {
    LAS float* scr = (LAS float*)(C.lds + C.wave * 16384);
    unsigned char* ws = P.ws;
#define ROT(k) ((gw + (k) * (NGW / 6)) % NGW)
    if (part & 1) {
    transpose_w(P.in[I_WUQ], QR, 3072, 3072, (bf16*)(ws + WS_WUQ), P.in[I_QG], scr, ROT(0), NGW, C.lane,
        [](int n) { const int h = n / QKD, c = n - h * QKD; return c < 128 ? n : h * QKD + 128 + rope_src(c - 128); });
    transpose_w(P.in[I_WUKV], KVR, 4096, 4096, (bf16*)(ws + WS_WUKV), P.in[I_KVG], scr, ROT(1), NGW, C.lane, [](int n) { return n; });
    }
    if (part & 2) {
    transpose_w(P.in[I_WPH], 1024, 1024, 1024, (bf16*)(ws + WS_WPH), nullptr, scr, ROT(2), NGW, C.lane, [](int n) { return n; });
    transpose_w(P.in[I_WPM], 2048, 1024, 1024, (bf16*)(ws + WS_WPM), nullptr, scr, ROT(3), NGW, C.lane, [](int n) { return n; });
    transpose_w(P.in[I_WO], 1024, 1024, 1024, (bf16*)(ws + WS_WO), nullptr, scr, ROT(4), NGW, C.lane, [](int n) { return n; });
    transpose_w(P.in[I_PQ], 1024, 2048, 2048, (bf16*)(ws + WS_WPQ), nullptr, scr, ROT(5), NGW, C.lane, [](int n) { return n; });
    cvt_rows(P.in[I_SK], (bf16*)(ws + WS_SK), (size_t)16 * 128 * 128 / 8, gt, NGT);
    }
#undef ROT
}

__device__ __forceinline__ void p0_prologue(const Params& P, const Ctx& C) {
    LAS float* scr = (LAS float*)(C.lds + C.wave * 16384);
    const int gw = C.vcu * 8 + C.wave, NGW = C.G * 8;
    unsigned char* ws = P.ws;
    transpose_w(P.in[I_WIN], DM, INW, INWP, (bf16*)(ws + WS_WIN), nullptr, scr, gw, NGW, C.lane,
        [](int n) { return n < 4736 ? n : n < N1V ? 4736 + rope_src(n - 4736) : n < N1 ? -1 : N1V + (n - N1); });
    const size_t gt = (size_t)C.vcu * 512 + C.tid, NGT = (size_t)C.G * 512;
    { bf16* H = (bf16*)(ws + WS_A); const float* x = P.in[I_X]; const float* meta = P.in[I_META];
      constexpr size_t NI = (size_t)MV * (DM / 8);
      for (size_t i0 = gt; i0 < NI; i0 += 4 * NGT) {
          pg8::f32x4 a[4], bb[4]; bool act[4];
#pragma unroll
          for (int u = 0; u < 4; ++u) { const size_t i = i0 + (size_t)u * NGT; act[u] = i < NI; a[u] = (pg8::f32x4){0.f, 0.f, 0.f, 0.f}; bb[u] = a[u];
              if (act[u]) { const int Rc = (int)(i >> 7), c8 = (int)(i & 127) * 8; const int b = Rc / PV, q = Rc - b * PV;
                  const float* s = q >= 16 ? x + ((size_t)b * SEQ + (q - 16)) * DM + c8 : meta + (size_t)q * DM + c8; a[u] = *(const pg8::f32x4*)s; bb[u] = *(const pg8::f32x4*)(s + 4); } }
#pragma unroll
          for (int u = 0; u < 4; ++u) if (act[u]) { const size_t i = i0 + (size_t)u * NGT; v4u o; o.x = pk2(a[u][0], a[u][1]); o.y = pk2(a[u][2], a[u][3]); o.z = pk2(bb[u][0], bb[u][1]); o.w = pk2(bb[u][2], bb[u][3]); *(v4u*)(H + i * 8) = o; }
      } }
    { bf16* HQ = (bf16*)(ws + WS_HQ); bf16* K1 = (bf16*)(ws + WS_K1); bf16* HI = (bf16*)(ws + WS_HI); bf16* CKV = (bf16*)(ws + WS_CKV);
      const v4u z = {0u, 0u, 0u, 0u};
      for (size_t i = gt; i < (size_t)NB * 48 * 128; i += NGT) { const int b = (int)(i / (48 * 128)), r = (int)(i % (48 * 128)); const size_t off = ((size_t)b * PP + 64) * DM + (size_t)r * 8;
          *(v4u*)(HQ + off) = z; *(v4u*)(K1 + off) = z; *(v4u*)(HI + off) = z; }
      for (size_t i = gt; i < (size_t)NB * 48 * 32; i += NGT) { const int b = (int)(i / (48 * 32)), r = (int)(i % (48 * 32)); *(v4u*)(CKV + ((size_t)b * PP + 64) * KVR + (size_t)r * 8) = z; } }
    { float* T = (float*)(ws + WS_ROPE);
      for (size_t i = gt; i < (size_t)PP * 32; i += NGT) { const int p = (int)(i >> 5), k = (int)(i & 31);
          const float ang = (float)(p - NPADR) * exp2f(-(float)k * 0.4152410118609203f);
          const double rev = (double)ang * 0.15915494309189535; const float fr = (float)(rev - floor(rev));
          T[i * 2] = __builtin_amdgcn_cosf(fr); T[i * 2 + 1] = __builtin_amdgcn_sinf(fr); } }
}

__device__ __forceinline__ float sq8(const v4u w) {
    return bflo(w.x) * bflo(w.x) + bfhi(w.x) * bfhi(w.x) + bflo(w.y) * bflo(w.y) + bfhi(w.y) * bfhi(w.y) + bflo(w.z) * bflo(w.z) + bfhi(w.z) * bfhi(w.z) + bflo(w.w) * bflo(w.w) + bfhi(w.w) * bfhi(w.w);
}
template <int W> __device__ __forceinline__ void rowstat_rows(const bf16* __restrict__ X, float* __restrict__ out, int nrows, int gw, int NGW, int lane) {
    const int g = lane >> 4, l16 = lane & 15;
    for (int r0 = gw * 8; r0 < nrows; r0 += NGW * 8) {
        v4u a[2][W / 128];
#pragma unroll
        for (int u = 0; u < 2; ++u) { const int r = r0 + u * 4 + g;
#pragma unroll
            for (int j = 0; j < W / 128; ++j) a[u][j] = r < nrows ? *(const v4u*)(X + (size_t)r * W + (l16 + 16 * j) * 8) : (v4u){0u, 0u, 0u, 0u}; }
#pragma unroll
        for (int u = 0; u < 2; ++u) { const int r = r0 + u * 4 + g; float s = 0.f;
#pragma unroll
            for (int j = 0; j < W / 128; ++j) s += sq8(a[u][j]);
            s += __shfl_xor(s, 1); s += __shfl_xor(s, 2); s += __shfl_xor(s, 4); s += __shfl_xor(s, 8);
            if (l16 == 0 && r < nrows) out[r] = 1.0f / sqrtf(s * (1.0f / W) + EPS); }
    }
}
__device__ __forceinline__ void rowstats(const Params& P, const Ctx& C, int gw, int NGW) {
    rowstat_rows<QR>((const bf16*)(P.ws + WS_CQ), (float*)(P.ws + WS_RQ), MR, gw, NGW, C.lane);
    rowstat_rows<KVR>((const bf16*)(P.ws + WS_CKV), (float*)(P.ws + WS_RKV), MALL, gw, NGW, C.lane);
}

__device__ __forceinline__ void hgrn_item(const Params& P, const Ctx& C, int item) {
    const int b = item >> 3, h = item & 7, tid = C.tid, v = tid & 127, kq = tid >> 7;
    LAS float* fq = (LAS float*)C.lds; LAS float* ff = fq + 2048; LAS float* fk = ff + 2048; LAS float* fi = fk + 2048; LAS float* opart = fi + 2048;
    const bf16* HQ = (const bf16*)(P.ws + WS_HQ); const bf16* K1 = (const bf16*)(P.ws + WS_K1); const bf16* HI = (const bf16*)(P.ws + WS_HI); const bf16* HG = (const bf16*)(P.ws + WS_HG);
    bf16* ON = (bf16*)(P.ws + WS_ON); const float* gain = P.in[I_HGG];
    float S[32];
#pragma unroll
    for (int j = 0; j < 32; ++j) S[j] = 0.f;
    const int lt = tid >> 5, c4 = (tid & 31) * 4;
    for (int ch = NPADR / 16; ch < PP / 16; ++ch) {
        const int p0 = ch * 16;
        { const size_t off = ((size_t)b * PP + p0 + lt) * DM + h * 128 + c4;
          const v2u q = *(const v2u*)(HQ + off), k = *(const v2u*)(K1 + off), iv = *(const v2u*)(HI + off);
          const int o = lt * 128 + c4;
          fq[o] = bflo(q.x); fq[o + 1] = bfhi(q.x); fq[o + 2] = bflo(q.y); fq[o + 3] = bfhi(q.y);
          const float k0 = bflo(k.x), k1 = bfhi(k.x), k2 = bflo(k.y), k3 = bfhi(k.y);
          fk[o] = k0; fk[o + 1] = k1; fk[o + 2] = k2; fk[o + 3] = k3;
          ff[o] = 1.f - k0; ff[o + 1] = 1.f - k1; ff[o + 2] = 1.f - k2; ff[o + 3] = 1.f - k3;
          fi[o] = bflo(iv.x); fi[o + 1] = bfhi(iv.x); fi[o + 2] = bflo(iv.y); fi[o + 3] = bfhi(iv.y); }
        __syncthreads();
#pragma unroll 2
        for (int t = 0; t < 16; ++t) {
            const float ivv = fi[t * 128 + v]; float op = 0.f;
            const LAS pg8::f32x4* f4 = (const LAS pg8::f32x4*)(ff + t * 128 + kq * 32);
            const LAS pg8::f32x4* k4 = (const LAS pg8::f32x4*)(fk + t * 128 + kq * 32);
            const LAS pg8::f32x4* q4 = (const LAS pg8::f32x4*)(fq + t * 128 + kq * 32);
#pragma unroll
            for (int j4 = 0; j4 < 8; ++j4) { const pg8::f32x4 fv = f4[j4], kv = k4[j4], qv = q4[j4];
#pragma unroll
                for (int e = 0; e < 4; ++e) { const float s = fmaf(fv[e], S[j4 * 4 + e], kv[e] * ivv); S[j4 * 4 + e] = s; op = fmaf(qv[e], s, op); } }
            opart[(t * 4 + kq) * 128 + v] = op;
        }
        __syncthreads();
        { pg8::f32x4 o = *(const LAS pg8::f32x4*)(opart + (lt * 4 + 0) * 128 + c4);
          o += *(const LAS pg8::f32x4*)(opart + (lt * 4 + 1) * 128 + c4); o += *(const LAS pg8::f32x4*)(opart + (lt * 4 + 2) * 128 + c4); o += *(const LAS pg8::f32x4*)(opart + (lt * 4 + 3) * 128 + c4);
          float ss = o[0] * o[0] + o[1] * o[1] + o[2] * o[2] + o[3] * o[3];
#pragma unroll
          for (int m = 1; m < 32; m <<= 1) ss += __shfl_xor(ss, m);
          const int p = p0 + lt;
          if (p >= LEAD) { const float rstd = 1.0f / sqrtf(ss * (1.0f / 128.f) + EPS); const size_t rr = (size_t)b * SEQ + (p - LEAD);
              const v2u g = *(const v2u*)(HG + rr * DM + h * 128 + c4); const pg8::f32x4 gn = *(const pg8::f32x4*)(gain + h * 128 + c4);
              v2u w; w.x = pk2(o[0] * rstd * gn[0] * bflo(g.x), o[1] * rstd * gn[1] * bfhi(g.x)); w.y = pk2(o[2] * rstd * gn[2] * bflo(g.y), o[3] * rstd * gn[3] * bfhi(g.y));
              *(v2u*)(ON + rr * DM + h * 128 + c4) = w; } }
    }
    __syncthreads();
}


__device__ __forceinline__ void hgrn_item2(const Params& P, const Ctx& C, int item) {
    typedef short bf16x8v __attribute__((ext_vector_type(8)));
    int tid_ = threadIdx.x; asm volatile("" : "+v"(tid_));
    const int tid = tid_, lane = tid & 63, w = C.wave, fr = lane & 15, g = lane >> 4;
    const int b = item >> 3, h = item & 7;
    constexpr int SQ = 272, SP = 144;
    constexpr int O_QD = 0, O_KI = 17408, O_KST = 34816, O_IT = 53248, O_P = 71680, O_ST = 80896, O_SEG = 115712, O_DEC = 119808;
    LAS unsigned char* L = C.lds;
    const bf16* HQ = (const bf16*)(P.ws + WS_HQ); const bf16* K1 = (const bf16*)(P.ws + WS_K1); const bf16* HI = (const bf16*)(P.ws + WS_HI); const bf16* HG = (const bf16*)(P.ws + WS_HG);
    bf16* ON = (bf16*)(P.ws + WS_ON); const float* gain = P.in[I_HGG];
    const int kp = tid & 63;
    for (int i = tid; i < 34816 / 16; i += 512) *(LAS v4u*)(L + O_ST + i * 16) = (v4u){0u, 0u, 0u, 0u};
    pg8::f32x4 S[8];
#pragma unroll
    for (int j = 0; j < 8; ++j) S[j] = (pg8::f32x4){0.f, 0.f, 0.f, 0.f};
    unsigned rq[8], rk[8], ri[8];
    const size_t colbase = (size_t)h * 128 + 2 * kp;
#define LOADRAW(c) do { const size_t r0_ = ((size_t)b * PP + 64 + 64 * (c) + 8 * w) * DM + colbase; \
        _Pragma("unroll") for (int i = 0; i < 8; ++i) { rq[i] = *(const unsigned*)(HQ + r0_ + (size_t)i * DM); rk[i] = *(const unsigned*)(K1 + r0_ + (size_t)i * DM); ri[i] = *(const unsigned*)(HI + r0_ + (size_t)i * DM); } } while (0)
    LOADRAW(0);
    __syncthreads();
#pragma unroll 1
    for (int c = 0; c < 33; ++c) {
        float cum0[8], cum1[8], ka[8], kb[8]; float cs0 = 0.f, cs1 = 0.f;
#pragma unroll
        for (int i = 0; i < 8; ++i) { const bool valid = (64 + 64 * c + 8 * w + i) >= NPADR; const float k0 = valid ? bflo(rk[i]) : 0.f, k1 = valid ? bfhi(rk[i]) : 0.f; ka[i] = k0; kb[i] = k1;
            cs0 += __builtin_amdgcn_logf(1.0f - k0); cs1 += __builtin_amdgcn_logf(1.0f - k1); cum0[i] = cs0; cum1[i] = cs1; }
        *(LAS f32x2*)(L + O_SEG + (w * 128 + 2 * kp) * 4) = (f32x2){cs0, cs1};
        { v4u w0, w1;
          w0.x = (ri[0] & 0xffffu) | (ri[1] << 16); w0.y = (ri[2] & 0xffffu) | (ri[3] << 16); w0.z = (ri[4] & 0xffffu) | (ri[5] << 16); w0.w = (ri[6] & 0xffffu) | (ri[7] << 16);
          w1.x = (ri[0] >> 16) | (ri[1] & 0xffff0000u); w1.y = (ri[2] >> 16) | (ri[3] & 0xffff0000u); w1.z = (ri[4] >> 16) | (ri[5] & 0xffff0000u); w1.w = (ri[6] >> 16) | (ri[7] & 0xffff0000u);
          *(LAS v4u*)(L + O_IT + (2 * kp) * SP + w * 16) = w0; *(LAS v4u*)(L + O_IT + (2 * kp + 1) * SP + w * 16) = w1; }
        __syncthreads();
        { float p0 = 0.f, p1 = 0.f, t0 = 0.f, t1 = 0.f;
#pragma unroll
          for (int j = 0; j < 8; ++j) { const f32x2 sj = *(const LAS f32x2*)(L + O_SEG + (j * 128 + 2 * kp) * 4); t0 += sj[0]; t1 += sj[1]; if (j < w) { p0 += sj[0]; p1 += sj[1]; } }
          const float d0 = __builtin_amdgcn_exp2f(t0), d1 = __builtin_amdgcn_exp2f(t1);
          float ks0[8], ks1[8];
#pragma unroll
          for (int i = 0; i < 8; ++i) { const float e0 = __builtin_amdgcn_exp2f(p0 + cum0[i]), e1 = __builtin_amdgcn_exp2f(p1 + cum1[i]);
              const float ki0 = ka[i] * __builtin_amdgcn_rcpf(e0), ki1 = kb[i] * __builtin_amdgcn_rcpf(e1);
              const int t = 8 * w + i;
              *(LAS unsigned*)(L + O_QD + t * SQ + kp * 4) = pg8::cvt_pk_bf16(bflo(rq[i]) * e0, bfhi(rq[i]) * e1);
              *(LAS unsigned*)(L + O_KI + t * SQ + kp * 4) = pg8::cvt_pk_bf16(ki0, ki1);
              ks0[i] = ki0 * d0; ks1[i] = ki1 * d1; }
          *(LAS v4u*)(L + O_KST + (2 * kp) * SP + w * 16) = (v4u){pg8::cvt_pk_bf16(ks0[0], ks0[1]), pg8::cvt_pk_bf16(ks0[2], ks0[3]), pg8::cvt_pk_bf16(ks0[4], ks0[5]), pg8::cvt_pk_bf16(ks0[6], ks0[7])};
          *(LAS v4u*)(L + O_KST + (2 * kp + 1) * SP + w * 16) = (v4u){pg8::cvt_pk_bf16(ks1[0], ks1[1]), pg8::cvt_pk_bf16(ks1[2], ks1[3]), pg8::cvt_pk_bf16(ks1[4], ks1[5]), pg8::cvt_pk_bf16(ks1[6], ks1[7])};
          if (w == 0) *(LAS f32x2*)(L + O_DEC + (2 * kp) * 4) = (f32x2){d0, d1}; }
        if (c + 1 < 33) LOADRAW(c + 1);
        __syncthreads();
#pragma unroll
        for (int q = 0; q < 2; ++q) { const int ti = 2 * w + q, tr = ti >> 2, sc = ti & 3;
            pg8::f32x4 acc = (pg8::f32x4){0.f, 0.f, 0.f, 0.f};
            if (sc <= tr) {
#pragma unroll
                for (int kk = 0; kk < 4; ++kk) { const bf16x8v a = *(const LAS bf16x8v*)(L + O_QD + (tr * 16 + fr) * SQ + kk * 64 + g * 16), bb = *(const LAS bf16x8v*)(L + O_KI + (sc * 16 + fr) * SQ + kk * 64 + g * 16);
                    acc = __builtin_amdgcn_mfma_f32_16x16x32_bf16(a, bb, acc, 0, 0, 0); }
            }
#pragma unroll
            for (int r = 0; r < 4; ++r) { const float v = (sc < tr || (sc == tr && fr <= 4 * g + r)) ? acc[r] : 0.f;
                *(LAS unsigned short*)(L + O_P + (tr * 16 + 4 * g + r) * SP + (sc * 16 + fr) * 2) = (unsigned short)f2bf(v); } }
        __syncthreads();
        pg8::f32x4 oacc[4];
        { const int tr = w >> 1, vb0 = (w & 1) * 4;
#pragma unroll
          for (int j = 0; j < 4; ++j) oacc[j] = (pg8::f32x4){0.f, 0.f, 0.f, 0.f};
#pragma unroll
          for (int kk = 0; kk < 2; ++kk) if (32 * kk <= 16 * tr + 15) { const bf16x8v a = *(const LAS bf16x8v*)(L + O_P + (tr * 16 + fr) * SP + kk * 64 + g * 16);
#pragma unroll
              for (int j = 0; j < 4; ++j) { const bf16x8v bb = *(const LAS bf16x8v*)(L + O_IT + ((vb0 + j) * 16 + fr) * SP + kk * 64 + g * 16); oacc[j] = __builtin_amdgcn_mfma_f32_16x16x32_bf16(a, bb, oacc[j], 0, 0, 0); } }
#pragma unroll
          for (int kk = 0; kk < 4; ++kk) { const bf16x8v a = *(const LAS bf16x8v*)(L + O_QD + (tr * 16 + fr) * SQ + kk * 64 + g * 16);
#pragma unroll
              for (int j = 0; j < 4; ++j) { const bf16x8v bb = *(const LAS bf16x8v*)(L + O_ST + ((vb0 + j) * 16 + fr) * SQ + kk * 64 + g * 16); oacc[j] = __builtin_amdgcn_mfma_f32_16x16x32_bf16(a, bb, oacc[j], 0, 0, 0); } } }
        { const pg8::f32x4 dv = *(const LAS pg8::f32x4*)(L + O_DEC + (16 * w + 4 * g) * 4);
#pragma unroll
          for (int j = 0; j < 8; ++j) S[j] = S[j] * dv;
#pragma unroll
          for (int kk = 0; kk < 2; ++kk) { const bf16x8v a = *(const LAS bf16x8v*)(L + O_KST + (16 * w + fr) * SP + kk * 64 + g * 16);
#pragma unroll
              for (int j = 0; j < 8; ++j) { const bf16x8v bb = *(const LAS bf16x8v*)(L + O_IT + (j * 16 + fr) * SP + kk * 64 + g * 16); S[j] = __builtin_amdgcn_mfma_f32_16x16x32_bf16(a, bb, S[j], 0, 0, 0); } } }
        __syncthreads();
        { const int tr = w >> 1, vb0 = (w & 1) * 4;
#pragma unroll
          for (int j = 0; j < 4; ++j)
#pragma unroll
              for (int r = 0; r < 4; ++r) ((LAS float*)L)[(tr * 16 + 4 * g + r) * 132 + (vb0 + j) * 16 + fr] = oacc[j][r];
#pragma unroll
          for (int j = 0; j < 8; ++j) { v2u pkd; pkd.x = pk2(S[j][0], S[j][1]); pkd.y = pk2(S[j][2], S[j][3]); *(LAS v2u*)(L + O_ST + (j * 16 + fr) * SQ + (16 * w + 4 * g) * 2) = pkd; } }
        __syncthreads();
        if (c >= 1) { const int t = tid >> 3, c16 = (tid & 7) * 16; const LAS pg8::f32x4* op = (const LAS pg8::f32x4*)((LAS float*)L + t * 132 + c16);
            pg8::f32x4 o[4]; float ss = 0.f;
#pragma unroll
            for (int q = 0; q < 4; ++q) { o[q] = op[q]; ss += (o[q][0] * o[q][0] + o[q][1] * o[q][1]) + (o[q][2] * o[q][2] + o[q][3] * o[q][3]); }
            ss += __shfl_xor(ss, 1); ss += __shfl_xor(ss, 2); ss += __shfl_xor(ss, 4);
            const float rstd = 1.0f / sqrtf(ss * (1.0f / 128.f) + EPS);
            const size_t rr = (size_t)b * SEQ + (64 * c - 64 + t); const size_t off = rr * DM + h * 128 + c16;
            const v4u g0 = *(const v4u*)(HG + off), g1 = *(const v4u*)(HG + off + 8);
            const pg8::f32x4* gp = (const pg8::f32x4*)(gain + h * 128 + c16); const pg8::f32x4 n0 = gp[0], n1 = gp[1], n2 = gp[2], n3 = gp[3];
            v4u w0, w1;
            w0.x = pk2(o[0][0] * rstd * n0[0] * bflo(g0.x), o[0][1] * rstd * n0[1] * bfhi(g0.x)); w0.y = pk2(o[0][2] * rstd * n0[2] * bflo(g0.y), o[0][3] * rstd * n0[3] * bfhi(g0.y));
            w0.z = pk2(o[1][0] * rstd * n1[0] * bflo(g0.z), o[1][1] * rstd * n1[1] * bfhi(g0.z)); w0.w = pk2(o[1][2] * rstd * n1[2] * bflo(g0.w), o[1][3] * rstd * n1[3] * bfhi(g0.w));
            w1.x = pk2(o[2][0] * rstd * n2[0] * bflo(g1.x), o[2][1] * rstd * n2[1] * bfhi(g1.x)); w1.y = pk2(o[2][2] * rstd * n2[2] * bflo(g1.y), o[2][3] * rstd * n2[3] * bfhi(g1.y));
            w1.z = pk2(o[3][0] * rstd * n3[0] * bflo(g1.z), o[3][1] * rstd * n3[1] * bfhi(g1.z)); w1.w = pk2(o[3][2] * rstd * n3[2] * bflo(g1.w), o[3][3] * rstd * n3[3] * bfhi(g1.w));
            *(v4u*)(ON + off) = w0; *(v4u*)(ON + off + 8) = w1; }
    }
#undef LOADRAW
    __syncthreads();
}

__device__ __forceinline__ void ln1_phase(const Params& P, const Ctx& C, bool dostore) {
    const int gw = C.vcu * 8 + C.wave, NGW = C.G * 8; bf16* H1B = (bf16*)(P.ws + WS_H1B);
    const float* g = P.in[I_LN1G]; const float* bb = P.in[I_LN1B];
    for (int r = gw; r < MR; r += NGW) {
        pg8::f32x4* row = (pg8::f32x4*)(P.out + (size_t)r * DM) + C.lane;
        pg8::f32x4 v[4]; float s = 0.f;
#pragma unroll
        for (int j = 0; j < 4; ++j) { v[j] = row[64 * j]; s += (v[j][0] + v[j][1]) + (v[j][2] + v[j][3]); }
        const float mean = wave_sum(s) * (1.f / DM); float s2 = 0.f;
#pragma unroll
        for (int j = 0; j < 4; ++j) { v[j] = v[j] - mean; s2 += (v[j][0] * v[j][0] + v[j][1] * v[j][1]) + (v[j][2] * v[j][2] + v[j][3] * v[j][3]); }
        const float rstd = 1.f / sqrtf(wave_sum(s2) * (1.f / DM) + EPS);
#pragma unroll
        for (int j = 0; j < 4; ++j) { const int c = (C.lane + 64 * j) * 4; const pg8::f32x4 gg = *(const pg8::f32x4*)(g + c), b4 = *(const pg8::f32x4*)(bb + c);
            const pg8::f32x4 o = v[j] * rstd * gg + b4; if (dostore) row[64 * j] = o;
            v2u w; w.x = pk2(o[0], o[1]); w.y = pk2(o[2], o[3]); if (dostore) *(v2u*)(H1B + (size_t)r * DM + c) = w; }
    }
}


typedef float f32x2v __attribute__((ext_vector_type(2)));
__device__ __forceinline__ void cvt_table_fp8(const float* __restrict__ src, unsigned char* __restrict__ dst, float* __restrict__ inv  , int gw, int NGW, int lane) {
    for (int r = gw; r < 16384; r += NGW) {
        const pg8::f32x4* p = (const pg8::f32x4*)(src + (size_t)r * 1024 + lane * 16);
        pg8::f32x4 v[4]; float mx = 0.f;
#pragma unroll
        for (int j = 0; j < 4; ++j) { v[j] = p[j]; mx = fmaxf(mx, fmaxf(fmaxf(fabsf(v[j][0]), fabsf(v[j][1])), fmaxf(fabsf(v[j][2]), fabsf(v[j][3])))); }
#pragma unroll
        for (int o = 1; o < 64; o <<= 1) mx = fmaxf(mx, __shfl_xor(mx, o));
        const float sc = mx > 0.f ? exp2f(floorf(log2f(256.0f / mx))) : 1.0f;
        v4u w;
        { int t = 0; t = __builtin_amdgcn_cvt_pk_fp8_f32(v[0][0] * sc, v[0][1] * sc, t, false); t = __builtin_amdgcn_cvt_pk_fp8_f32(v[0][2] * sc, v[0][3] * sc, t, true); w.x = (unsigned)t; }
        { int t = 0; t = __builtin_amdgcn_cvt_pk_fp8_f32(v[1][0] * sc, v[1][1] * sc, t, false); t = __builtin_amdgcn_cvt_pk_fp8_f32(v[1][2] * sc, v[1][3] * sc, t, true); w.y = (unsigned)t; }
        { int t = 0; t = __builtin_amdgcn_cvt_pk_fp8_f32(v[2][0] * sc, v[2][1] * sc, t, false); t = __builtin_amdgcn_cvt_pk_fp8_f32(v[2][2] * sc, v[2][3] * sc, t, true); w.z = (unsigned)t; }
        { int t = 0; t = __builtin_amdgcn_cvt_pk_fp8_f32(v[3][0] * sc, v[3][1] * sc, t, false); t = __builtin_amdgcn_cvt_pk_fp8_f32(v[3][2] * sc, v[3][3] * sc, t, true); w.w = (unsigned)t; }
        *(v4u*)(dst + (size_t)r * 1024 + lane * 16) = w;
        if (lane == 0) inv[2 * r] = 1.0f / sc;
    }
}
__device__ __forceinline__ void fp8x4_to_bf16x4(unsigned w, unsigned& lo, unsigned& hi) {
    const f32x2v a = __builtin_amdgcn_cvt_pk_f32_fp8((int)w, false), b = __builtin_amdgcn_cvt_pk_f32_fp8((int)w, true);
    lo = pg8::cvt_pk_bf16(a[0], a[1]); hi = pg8::cvt_pk_bf16(b[0], b[1]);
}

__device__ __forceinline__ float gelu_tanh(float a) { const float u = 0.7978845608028654f * (a + 0.044715f * a * a * a); return a / (1.0f + __expf(-2.0f * u)); }
typedef short bf16x8v __attribute__((ext_vector_type(8)));

__device__ __forceinline__ float vmaxf(float a, float b) { float r; asm("v_max_f32 %0, %1, %2" : "=v"(r) : "v"(a), "v"(b)); return r; }
__device__ __forceinline__ float vminf(float a, float b) { float r; asm("v_min_f32 %0, %1, %2" : "=v"(r) : "v"(a), "v"(b)); return r; }
#define CE_DESC(a, b) do { const float hi_ = vmaxf(a, b), lo_ = vminf(a, b); a = hi_; b = lo_; } while (0)
template <int N> __device__ __forceinline__ void bitonic_merge_desc(float (&v)[N]) {
#pragma unroll
    for (int j = N / 2; j > 0; j >>= 1)
#pragma unroll
        for (int i = 0; i < N; ++i) { const int l = i ^ j; if (l > i) CE_DESC(v[i], v[l]); }
}
template <int N> __device__ __forceinline__ void bitonic_sort_desc(float (&v)[N]) {
#pragma unroll
    for (int k = 2; k <= N; k <<= 1)
#pragma unroll
        for (int j = k >> 1; j > 0; j >>= 1)
#pragma unroll
            for (int i = 0; i < N; ++i) { const int l = i ^ j; if (l > i) { if ((i & k) == 0 || k == N) CE_DESC(v[i], v[l]); else CE_DESC(v[l], v[i]); } }
}
__device__ __forceinline__ void top16_merge(float (&a)[16], const float (&b)[16]) {
#pragma unroll
    for (int i = 0; i < 16; ++i) a[i] = vmaxf(a[i], b[15 - i]);
    bitonic_merge_desc<16>(a);
}
__device__ __forceinline__ void peer_route(const Params& P, const Ctx& C, int grp, LAS unsigned short* sidx, LAS float* sgate, LAS float* topv) {
    int lane_ = C.lane; asm volatile("" : "+v"(lane_));
    const int lane = lane_, w = C.wave, tokl = lane & 31, hi = lane >> 5;
    const bf16* PQ = (const bf16*)(P.ws + WS_PQ); const bf16* SK = (const bf16*)(P.ws + WS_SK);
    const int tok0 = grp * 32;
#pragma unroll 1
    for (int pp = 0; pp < 2; ++pp) {
        const int hp = 2 * w + pp;
        f32x16 acc[4] = {};
#pragma unroll
        for (int s = 0; s < 8; ++s) {
            const bf16x8v bfrag = *(const bf16x8v*)(PQ + (size_t)(tok0 + tokl) * 2048 + hp * 128 + s * 16 + hi * 8);
#pragma unroll
            for (int mb = 0; mb < 4; ++mb) { const bf16x8v afrag = *(const bf16x8v*)(SK + (size_t)(hp * 128 + mb * 32 + tokl) * 128 + s * 16 + hi * 8);
                acc[mb] = __builtin_amdgcn_mfma_f32_32x32x16_bf16(afrag, bfrag, acc[mb], 0, 0, 0); }
        }
        float g0[16], g1[16], g2[16], g3[16];
#pragma unroll
        for (int r = 0; r < 16; ++r) { const unsigned kb = (unsigned)((r & 3) + 8 * (r >> 2) + 4 * hi);
            g0[r] = __uint_as_float((__float_as_uint(acc[0][r]) & ~127u) | kb); g1[r] = __uint_as_float((__float_as_uint(acc[1][r]) & ~127u) | (kb + 32u));
            g2[r] = __uint_as_float((__float_as_uint(acc[2][r]) & ~127u) | (kb + 64u)); g3[r] = __uint_as_float((__float_as_uint(acc[3][r]) & ~127u) | (kb + 96u)); }
        bitonic_sort_desc<16>(g0); bitonic_sort_desc<16>(g1); bitonic_sort_desc<16>(g2); bitonic_sort_desc<16>(g3);
        top16_merge(g0, g1); top16_merge(g2, g3); top16_merge(g0, g2);
        { float o[16];
#pragma unroll
          for (int i = 0; i < 16; ++i) o[i] = __shfl_xor(g0[i], 32);
          top16_merge(g0, o); }
        if (hi == 0) { LAS pg8::f32x4* tp = (LAS pg8::f32x4*)(topv + tokl * 260 + hp * 16);
            tp[0] = (pg8::f32x4){g0[0], g0[1], g0[2], g0[3]}; tp[1] = (pg8::f32x4){g0[4], g0[5], g0[6], g0[7]}; tp[2] = (pg8::f32x4){g0[8], g0[9], g0[10], g0[11]}; tp[3] = (pg8::f32x4){g0[12], g0[13], g0[14], g0[15]}; }
    }
    asm volatile("s_waitcnt lgkmcnt(0)" ::: "memory");
    const LAS float* ta_l = topv + tokl * 260 + (2 * w) * 16; const LAS float* tb_l = ta_l + 16;
    float ta[16], tb[16];
#pragma unroll
    for (int q = 0; q < 4; ++q) { const pg8::f32x4 x = ((const LAS pg8::f32x4*)ta_l)[q], y = ((const LAS pg8::f32x4*)tb_l)[q];
        ta[4 * q] = x[0]; ta[4 * q + 1] = x[1]; ta[4 * q + 2] = x[2]; ta[4 * q + 3] = x[3]; tb[4 * q] = y[0]; tb[4 * q + 1] = y[1]; tb[4 * q + 2] = y[2]; tb[4 * q + 3] = y[3]; }
    float cand[25];
    { int n = 0;
#pragma unroll
      for (int i = 0; i < 16; ++i)
#pragma unroll
          for (int j = 0; j < 16; ++j) if ((i + 1) * (j + 1) <= 16) {
              const float sv = ta[i] + tb[j]; const float tagged = __uint_as_float((__float_as_uint(sv) & ~255u) | (unsigned)((i << 4) | j));
              if ((n & 1) == 0) cand[n >> 1] = tagged; else cand[n >> 1] = hi ? tagged : cand[n >> 1];
              ++n; } }
    float best[16];
    { float ca[16], cb[16];
#pragma unroll
      for (int i = 0; i < 16; ++i) { ca[i] = cand[i]; cb[i] = i < 9 ? cand[16 + i] : -INFINITY; }
      bitonic_sort_desc<16>(ca); bitonic_sort_desc<16>(cb); top16_merge(ca, cb);
#pragma unroll
      for (int i = 0; i < 16; ++i) cb[i] = __shfl_xor(ca[i], 32);
#pragma unroll
      for (int i = 0; i < 16; ++i) best[i] = vmaxf(ca[i], cb[15 - i]); }
    { float e[16], se = 0.f;
      const float bmx = __builtin_fmaxf(best[0], best[15]);
#pragma unroll
      for (int it = 0; it < 16; ++it) { e[it] = __expf(best[it] - bmx); se += e[it]; }
      const float inv = 1.0f / se;
      if (hi == 0) {
#pragma unroll
          for (int it = 0; it < 16; ++it) { const unsigned bits = __float_as_uint(best[it]); const int ci = (bits >> 4) & 15, cj = bits & 15;
              const int ia = (int)(__float_as_uint(ta_l[ci]) & 127u), ib = (int)(__float_as_uint(tb_l[cj]) & 127u);
              sidx[tokl * 128 + w * 16 + it] = (unsigned short)(ia * 128 + ib); sgate[tokl * 128 + w * 16 + it] = e[it] * inv; }
      } }
}
template <int MODE  >
__device__ __forceinline__ void peer_apply(const Params& P, const Ctx& C, int grp, const LAS unsigned short* sidx, const LAS float* sgate, bool dostore) {
    int lane_ = C.lane; asm volatile("" : "+v"(lane_));
    const int lane = lane_, w = C.wave;
    LAS float* actw = (LAS float*)(C.lds + 82432) + w * 128;
    LAS unsigned short* hrow = (LAS unsigned short*)(C.lds + 86528) + w * 1024;
    LAS float* suw = (LAS float*)(C.lds + 102912) + w * 256; LAS float* svw = suw + 128;
    const unsigned char* U8 = P.ws + WS_U8; const unsigned char* V8 = P.ws + WS_V8; const float* SU = (const float*)(P.ws + WS_SU); const float* SV = (const float*)(P.ws + WS_SV);
    const bf16* H1B = (const bf16*)(P.ws + WS_H1B);
    const float* g2 = P.in[I_LN2G]; const float* b2 = P.in[I_LN2B];
    const int tok0 = grp * 32;
        for (int tt = 0; tt < 4; ++tt) {
            const int tl = w * 4 + tt; const size_t tok = (size_t)tok0 + tl;
            f32x2v h2[8];
            { const v4u a = *(const v4u*)(H1B + tok * DM + lane * 16), b = *(const v4u*)(H1B + tok * DM + lane * 16 + 8);
              h2[0] = (f32x2v){bflo(a.x), bfhi(a.x)}; h2[1] = (f32x2v){bflo(a.y), bfhi(a.y)}; h2[2] = (f32x2v){bflo(a.z), bfhi(a.z)}; h2[3] = (f32x2v){bflo(a.w), bfhi(a.w)};
              h2[4] = (f32x2v){bflo(b.x), bfhi(b.x)}; h2[5] = (f32x2v){bflo(b.y), bfhi(b.y)}; h2[6] = (f32x2v){bflo(b.z), bfhi(b.z)}; h2[7] = (f32x2v){bflo(b.w), bfhi(b.w)}; }
            { const int e0 = sidx[tl * 128 + lane], e1 = sidx[tl * 128 + 64 + lane];
              const f32x2v s0 = *(const f32x2v*)(SU + 2 * e0), s1 = *(const f32x2v*)(SU + 2 * e1);
              suw[lane] = s0[0]; suw[64 + lane] = s1[0]; svw[lane] = s0[1]; svw[64 + lane] = s1[1]; }
            {
                v4u uA[8], uB[8]; float pd[16];
#define U_LOAD(ST, kb) do { _Pragma("unroll") for (int q = 0; q < 8; ++q) { const int e = __builtin_amdgcn_readfirstlane((int)sidx[tl * 128 + (kb) * 8 + q]); ST[q] = *(const v4u*)(U8 + (size_t)e * DM + lane * 16); } } while (0)
#define U_DOT(ST, off) do { _Pragma("unroll") for (int q = 0; q < 8; ++q) { const v4u x = ST[q]; \
                    f32x2v sacc = __builtin_amdgcn_cvt_pk_f32_fp8((int)x.x, false) * h2[0]; sacc = __builtin_elementwise_fma(__builtin_amdgcn_cvt_pk_f32_fp8((int)x.x, true), h2[1], sacc); \
                    sacc = __builtin_elementwise_fma(__builtin_amdgcn_cvt_pk_f32_fp8((int)x.y, false), h2[2], sacc); sacc = __builtin_elementwise_fma(__builtin_amdgcn_cvt_pk_f32_fp8((int)x.y, true), h2[3], sacc); \
                    sacc = __builtin_elementwise_fma(__builtin_amdgcn_cvt_pk_f32_fp8((int)x.z, false), h2[4], sacc); sacc = __builtin_elementwise_fma(__builtin_amdgcn_cvt_pk_f32_fp8((int)x.z, true), h2[5], sacc); \
                    sacc = __builtin_elementwise_fma(__builtin_amdgcn_cvt_pk_f32_fp8((int)x.w, false), h2[6], sacc); sacc = __builtin_elementwise_fma(__builtin_amdgcn_cvt_pk_f32_fp8((int)x.w, true), h2[7], sacc); \
                    pd[(off) + q] = sacc[0] + sacc[1]; } } while (0)
#define U_REDUCE(kb2) do { float r8[8], r4[4], r2[2], r1; const bool b5 = lane & 32, b4 = lane & 16, b3 = lane & 8, b2 = lane & 4; \
                    _Pragma("unroll") for (int j = 0; j < 8; ++j) { const float keep = b5 ? pd[j + 8] : pd[j], send = b5 ? pd[j] : pd[j + 8]; r8[j] = keep + __shfl_xor(send, 32); } \
                    _Pragma("unroll") for (int j = 0; j < 4; ++j) { const float keep = b4 ? r8[j + 4] : r8[j], send = b4 ? r8[j] : r8[j + 4]; r4[j] = keep + __shfl_xor(send, 16); } \
                    _Pragma("unroll") for (int j = 0; j < 2; ++j) { const float keep = b3 ? r4[j + 2] : r4[j], send = b3 ? r4[j] : r4[j + 2]; r2[j] = keep + __shfl_xor(send, 8); } \
                    { const float keep = b2 ? r2[1] : r2[0], send = b2 ? r2[0] : r2[1]; r1 = keep + __shfl_xor(send, 4); } \
                    r1 += __shfl_xor(r1, 2); r1 += __shfl_xor(r1, 1); \
                    if ((lane & 3) == 0) { const int k = (kb2) * 16 + ((lane >> 5) & 1) * 8 + ((lane >> 4) & 1) * 4 + ((lane >> 3) & 1) * 2 + ((lane >> 2) & 1); \
                        actw[k] = gelu_tanh(r1 * suw[k]) * sgate[tl * 128 + k] * svw[k]; } } while (0)
                asm volatile("s_waitcnt lgkmcnt(0)" ::: "memory");
                U_LOAD(uA, 0);
#pragma unroll 1
                for (int kb = 0; kb < 16; kb += 2) {
                    U_LOAD(uB, kb + 1);
                    U_DOT(uA, 0);
                    if (kb + 2 < 16) U_LOAD(uA, kb + 2);
                    U_DOT(uB, 8);
                    U_REDUCE(kb >> 1);
                }
#undef U_LOAD
#undef U_DOT
#undef U_REDUCE
            }
            v4u vA[8], vB[8];
#define V_LOAD(ST, kb) do { _Pragma("unroll") for (int q = 0; q < 8; ++q) { const int e = __builtin_amdgcn_readfirstlane((int)sidx[tl * 128 + (kb) * 8 + q]); ST[q] = *(const v4u*)(V8 + (size_t)e * DM + lane * 16); } } while (0)
            if (MODE == 0) V_LOAD(vA, 0);
            asm volatile("s_waitcnt lgkmcnt(0)" ::: "memory");
            if (MODE == 1) {
                if (lane < 32) *(pg8::f32x4*)((float*)(P.ws + WS_ACT) + tok * 128 + lane * 4) = *(const LAS pg8::f32x4*)(actw + lane * 4);
                else if (lane < 48) *(v4u*)((unsigned short*)(P.ws + WS_SIDX) + tok * 128 + (lane - 32) * 8) = *(const LAS v4u*)(sidx + tl * 128 + (lane - 32) * 8);
                continue;
            }
            float out[16];
#pragma unroll
            for (int i = 0; i < 16; ++i) out[i] = 0.f;
            {
#define V_COMP(ST, kb) do { _Pragma("unroll") for (int q = 0; q < 8; ++q) { const float a = actw[(kb) * 8 + q]; const f32x2v a2 = {a, a}; const v4u x = ST[q]; \
                    out2[0] = __builtin_elementwise_fma(__builtin_amdgcn_cvt_pk_f32_fp8((int)x.x, false), a2, out2[0]); out2[1] = __builtin_elementwise_fma(__builtin_amdgcn_cvt_pk_f32_fp8((int)x.x, true), a2, out2[1]); \
                    out2[2] = __builtin_elementwise_fma(__builtin_amdgcn_cvt_pk_f32_fp8((int)x.y, false), a2, out2[2]); out2[3] = __builtin_elementwise_fma(__builtin_amdgcn_cvt_pk_f32_fp8((int)x.y, true), a2, out2[3]); \
                    out2[4] = __builtin_elementwise_fma(__builtin_amdgcn_cvt_pk_f32_fp8((int)x.z, false), a2, out2[4]); out2[5] = __builtin_elementwise_fma(__builtin_amdgcn_cvt_pk_f32_fp8((int)x.z, true), a2, out2[5]); \
                    out2[6] = __builtin_elementwise_fma(__builtin_amdgcn_cvt_pk_f32_fp8((int)x.w, false), a2, out2[6]); out2[7] = __builtin_elementwise_fma(__builtin_amdgcn_cvt_pk_f32_fp8((int)x.w, true), a2, out2[7]); } } while (0)
                f32x2v out2[8];
#pragma unroll
                for (int i = 0; i < 8; ++i) out2[i] = (f32x2v){0.f, 0.f};
#pragma unroll 1
                for (int kb = 0; kb < 16; kb += 2) {
                    V_LOAD(vB, kb + 1);
                    V_COMP(vA, kb);
                    if (kb + 2 < 16) V_LOAD(vA, kb + 2);
                    V_COMP(vB, kb + 1);
                }
#undef V_LOAD
#undef V_COMP
#pragma unroll
                for (int i = 0; i < 8; ++i) { out[2 * i] = out2[i][0]; out[2 * i + 1] = out2[i][1]; }
            }
            float* orow = P.out + tok * DM + lane * 16;
            float s = 0.f;
#pragma unroll
            for (int q = 0; q < 4; ++q) { const pg8::f32x4 hv = *(const pg8::f32x4*)(orow + 4 * q);
#pragma unroll
                for (int e = 0; e < 4; ++e) { out[4 * q + e] = fmaf(ALPHA, hv[e], out[4 * q + e]); s += out[4 * q + e]; } }
            const float mean = wave_sum(s) * (1.f / DM); float s2 = 0.f;
#pragma unroll
            for (int i = 0; i < 16; ++i) { out[i] -= mean; s2 += out[i] * out[i]; }
            const float rstd = 1.f / sqrtf(wave_sum(s2) * (1.f / DM) + EPS);
#pragma unroll
            for (int q = 0; q < 4; ++q) { const pg8::f32x4 gg = *(const pg8::f32x4*)(g2 + lane * 16 + 4 * q), b4 = *(const pg8::f32x4*)(b2 + lane * 16 + 4 * q);
                pg8::f32x4 o; o[0] = out[4 * q] * rstd * gg[0] + b4[0]; o[1] = out[4 * q + 1] * rstd * gg[1] + b4[1]; o[2] = out[4 * q + 2] * rstd * gg[2] + b4[2]; o[3] = out[4 * q + 3] * rstd * gg[3] + b4[3];
                if (dostore) *(pg8::f32x4*)(orow + 4 * q) = o; }
        }
}

__device__ __forceinline__ void cvt_table_fp8_sliced(const float* __restrict__ src, unsigned char* __restrict__ dst, float* __restrict__ inv, int gw, int NGW, int lane) {
    for (int r = gw; r < 16384; r += NGW) {
        const pg8::f32x4* p = (const pg8::f32x4*)(src + (size_t)r * 1024 + lane * 16);
        pg8::f32x4 v[4]; float mx = 0.f;
#pragma unroll
        for (int j = 0; j < 4; ++j) { v[j] = p[j]; mx = fmaxf(mx, fmaxf(fmaxf(fabsf(v[j][0]), fabsf(v[j][1])), fmaxf(fabsf(v[j][2]), fabsf(v[j][3])))); }
#pragma unroll
        for (int o = 1; o < 64; o <<= 1) mx = fmaxf(mx, __shfl_xor(mx, o));
        const float sc = mx > 0.f ? exp2f(floorf(log2f(256.0f / mx))) : 1.0f;
        v4u w;
        { int t = 0; t = __builtin_amdgcn_cvt_pk_fp8_f32(v[0][0] * sc, v[0][1] * sc, t, false); t = __builtin_amdgcn_cvt_pk_fp8_f32(v[0][2] * sc, v[0][3] * sc, t, true); w.x = (unsigned)t; }
        { int t = 0; t = __builtin_amdgcn_cvt_pk_fp8_f32(v[1][0] * sc, v[1][1] * sc, t, false); t = __builtin_amdgcn_cvt_pk_fp8_f32(v[1][2] * sc, v[1][3] * sc, t, true); w.y = (unsigned)t; }
        { int t = 0; t = __builtin_amdgcn_cvt_pk_fp8_f32(v[2][0] * sc, v[2][1] * sc, t, false); t = __builtin_amdgcn_cvt_pk_fp8_f32(v[2][2] * sc, v[2][3] * sc, t, true); w.z = (unsigned)t; }
        { int t = 0; t = __builtin_amdgcn_cvt_pk_fp8_f32(v[3][0] * sc, v[3][1] * sc, t, false); t = __builtin_amdgcn_cvt_pk_fp8_f32(v[3][2] * sc, v[3][3] * sc, t, true); w.w = (unsigned)t; }
        *(v4u*)(dst + (size_t)(lane >> 3) * (16384 * 128) + (size_t)r * 128 + (lane & 7) * 16) = w;
        if (lane == 0) inv[2 * r] = 1.0f / sc;
    }
}
__device__ __forceinline__ void peer_route_publish_phase(const Params& P, const Ctx& C) {
    LAS float* topv = (LAS float*)(C.lds + 49152);
    LAS unsigned short* sidx = (LAS unsigned short*)C.lds; LAS float* sgate = (LAS float*)(C.lds + 8192);
    const float* SUV = (const float*)(P.ws + WS_SU);
    const int n = (MR / 32 - C.vcu + C.G - 1) / C.G;
#pragma unroll 1
    for (int i = 0; i < n; ++i) {
        const int grp = C.vcu + i * C.G;
        peer_route(P, C, grp, sidx, sgate, topv);
        __syncthreads();
        { int lane_ = C.lane; asm volatile("" : "+v"(lane_)); const int lane = lane_, w = C.wave;
          for (int tt = 0; tt < 4; ++tt) { const int tl = w * 4 + tt; const size_t tok = (size_t)grp * 32 + tl;
              const int e0 = sidx[tl * 128 + lane], e1 = sidx[tl * 128 + 64 + lane]; const float g0 = sgate[tl * 128 + lane], g1 = sgate[tl * 128 + 64 + lane];
              const f32x2v s0 = *(const f32x2v*)(SUV + 2 * e0), s1 = *(const f32x2v*)(SUV + 2 * e1);
              unsigned short* so = (unsigned short*)(P.ws + WS_SIDX) + tok * 128; float* su_o = (float*)(P.ws + WS_SUS) + tok * 128; float* ap_o = (float*)(P.ws + WS_ACTPRE) + tok * 128;
              so[lane] = (unsigned short)e0; so[64 + lane] = (unsigned short)e1; su_o[lane] = s0[0]; su_o[64 + lane] = s1[0]; ap_o[lane] = g0 * s0[1]; ap_o[64 + lane] = g1 * s1[1]; } }
        __syncthreads();
    }
}
__device__ __forceinline__ void peer_u_sliced_phase(const Params& P, const Ctx& C) {
    int lane_ = C.lane; asm volatile("" : "+v"(lane_));
    const int lane = lane_, w = C.wave, l8 = lane & 7, grp8 = lane >> 3;
    LAS float* psum = (LAS float*)C.lds + w * 2048;
    LAS unsigned short* sidc = (LAS unsigned short*)(C.lds + 65536) + w * 2048;
    const unsigned char* U8 = P.ws + WS_U8; const bf16* H1B = (const bf16*)(P.ws + WS_H1B);
    const unsigned short* SIDX = (const unsigned short*)(P.ws + WS_SIDX);
    const int n = (MR / 32 - C.vcu + C.G - 1) / C.G; const int ntok = n * 4;
#define TOKOF(t_) ((size_t)(C.vcu + ((t_) >> 2) * C.G) * 32 + w * 4 + ((t_) & 3))
    for (int t = 0; t < ntok; ++t) { const size_t tok = TOKOF(t);
        sidc[t * 128 + lane] = SIDX[tok * 128 + lane]; sidc[t * 128 + 64 + lane] = SIDX[tok * 128 + 64 + lane];
        psum[t * 128 + lane] = 0.f; psum[t * 128 + 64 + lane] = 0.f; }
    asm volatile("s_waitcnt vmcnt(0) lgkmcnt(0)" ::: "memory");
#pragma unroll 1
    for (int c = 0; c < 8; ++c) {
        const unsigned char* Uc = U8 + (size_t)c * (16384 * 128) + l8 * 16;
#pragma unroll 1
        for (int t = 0; t < ntok; ++t) {
            const size_t tok = TOKOF(t);
            f32x2v h2[8];
            { const v4u a = *(const v4u*)(H1B + tok * DM + c * 128 + l8 * 16), b = *(const v4u*)(H1B + tok * DM + c * 128 + l8 * 16 + 8);
              h2[0] = (f32x2v){bflo(a.x), bfhi(a.x)}; h2[1] = (f32x2v){bflo(a.y), bfhi(a.y)}; h2[2] = (f32x2v){bflo(a.z), bfhi(a.z)}; h2[3] = (f32x2v){bflo(a.w), bfhi(a.w)};
              h2[4] = (f32x2v){bflo(b.x), bfhi(b.x)}; h2[5] = (f32x2v){bflo(b.y), bfhi(b.y)}; h2[6] = (f32x2v){bflo(b.z), bfhi(b.z)}; h2[7] = (f32x2v){bflo(b.w), bfhi(b.w)}; }
            v4u xr[16];
#pragma unroll
            for (int q = 0; q < 16; ++q) { const int e = sidc[t * 128 + 8 * q + grp8]; xr[q] = *(const v4u*)(Uc + (size_t)e * 128); }
            float pd[16];
#pragma unroll
            for (int q = 0; q < 16; ++q) { const v4u x = xr[q];
                f32x2v sacc = __builtin_amdgcn_cvt_pk_f32_fp8((int)x.x, false) * h2[0]; sacc = __builtin_elementwise_fma(__builtin_amdgcn_cvt_pk_f32_fp8((int)x.x, true), h2[1], sacc);
                sacc = __builtin_elementwise_fma(__builtin_amdgcn_cvt_pk_f32_fp8((int)x.y, false), h2[2], sacc); sacc = __builtin_elementwise_fma(__builtin_amdgcn_cvt_pk_f32_fp8((int)x.y, true), h2[3], sacc);
                sacc = __builtin_elementwise_fma(__builtin_amdgcn_cvt_pk_f32_fp8((int)x.z, false), h2[4], sacc); sacc = __builtin_elementwise_fma(__builtin_amdgcn_cvt_pk_f32_fp8((int)x.z, true), h2[5], sacc);
                sacc = __builtin_elementwise_fma(__builtin_amdgcn_cvt_pk_f32_fp8((int)x.w, false), h2[6], sacc); sacc = __builtin_elementwise_fma(__builtin_amdgcn_cvt_pk_f32_fp8((int)x.w, true), h2[7], sacc);
                pd[q] = sacc[0] + sacc[1]; }
            float r8[8], r4[4], r2[2]; const bool b2 = lane & 4, b1 = lane & 2, b0 = lane & 1;
#pragma unroll
            for (int j = 0; j < 8; ++j) { const float keep = b2 ? pd[j + 8] : pd[j], send = b2 ? pd[j] : pd[j + 8]; r8[j] = keep + __shfl_xor(send, 4); }
#pragma unroll
            for (int j = 0; j < 4; ++j) { const float keep = b1 ? r8[j + 4] : r8[j], send = b1 ? r8[j] : r8[j + 4]; r4[j] = keep + __shfl_xor(send, 2); }
#pragma unroll
            for (int j = 0; j < 2; ++j) { const float keep = b0 ? r4[j + 2] : r4[j], send = b0 ? r4[j] : r4[j + 2]; r2[j] = keep + __shfl_xor(send, 1); }
            const int q0 = (b2 ? 8 : 0) + (b1 ? 4 : 0) + (b0 ? 2 : 0);
            psum[t * 128 + 8 * q0 + grp8] += r2[0]; psum[t * 128 + 8 * (q0 + 1) + grp8] += r2[1];
        }
    }
    asm volatile("s_waitcnt lgkmcnt(0)" ::: "memory");
    for (int t = 0; t < ntok; ++t) { const size_t tok = TOKOF(t);
        const float* su_i = (const float*)(P.ws + WS_SUS) + tok * 128; const float* ap_i = (const float*)(P.ws + WS_ACTPRE) + tok * 128; float* act_o = (float*)(P.ws + WS_ACT) + tok * 128;
        act_o[lane] = gelu_tanh(psum[t * 128 + lane] * su_i[lane]) * ap_i[lane]; act_o[64 + lane] = gelu_tanh(psum[t * 128 + 64 + lane] * su_i[64 + lane]) * ap_i[64 + lane]; }
#undef TOKOF
}

__device__ __forceinline__ void peer_phase(const Params& P, const Ctx& C, bool dostore) {
    LAS float* topv = (LAS float*)(C.lds + 49152);
    const int n = (MR / 32 - C.vcu + C.G - 1) / C.G;
#pragma unroll 1
    for (int i = -1; i < n; ++i) {
        const int grp = C.vcu + i * C.G; const int cur = (i & 1) * 24576, nxt = 24576 - cur;
#pragma unroll 1
        for (int slot = 0; slot < 2; ++slot) {
            const bool do_apply = (slot == 0) == (C.wave < 4 || PEER_SAMEORDER);
            if (do_apply) { if (i >= 0) {
#ifdef APPLY_REPS
                for (int ar = 1; ar < APPLY_REPS; ++ar) peer_apply<PEER_SPLIT>(P, C, grp, (const LAS unsigned short*)(C.lds + cur), (const LAS float*)(C.lds + cur + 8192), false);
#endif
                peer_apply<PEER_SPLIT>(P, C, grp, (const LAS unsigned short*)(C.lds + cur), (const LAS float*)(C.lds + cur + 8192), dostore); } }
            else if (i + 1 < n) {
#ifdef ROUTE_REPS
                for (int rr = 1; rr < ROUTE_REPS; ++rr) peer_route(P, C, grp + C.G, (LAS unsigned short*)(C.lds + nxt), (LAS float*)(C.lds + nxt + 8192), topv);
#endif
                peer_route(P, C, grp + C.G, (LAS unsigned short*)(C.lds + nxt), (LAS float*)(C.lds + nxt + 8192), topv); }
        }
        __syncthreads();
    }
}

__device__ __forceinline__ void peer_v_phase(const Params& P, const Ctx& C, bool dostore) {
    int lane_ = C.lane; asm volatile("" : "+v"(lane_));
    const int lane = lane_, w = C.wave;
    LAS float* actw = (LAS float*)C.lds + w * 128;
    LAS unsigned short* sidw = (LAS unsigned short*)(C.lds + 4096) + w * 128;
    const unsigned char* V8 = P.ws + WS_V8; const float* ACT = (const float*)(P.ws + WS_ACT); const unsigned short* SIDX = (const unsigned short*)(P.ws + WS_SIDX);
    const float* g2 = P.in[I_LN2G]; const float* b2 = P.in[I_LN2B];
    const int gw = C.vcu * 8 + w, NGW = C.G * 8;
    v4u nrow = {0u, 0u, 0u, 0u};
#define VROW_FETCH(t_) do { if (lane < 32) nrow = *(const v4u*)(ACT + (size_t)(t_) * 128 + lane * 4); else if (lane < 48) nrow = *(const v4u*)(SIDX + (size_t)(t_) * 128 + (lane - 32) * 8); } while (0)
    if (gw < MR) VROW_FETCH(gw);
#pragma unroll 1
    for (int tk = gw; tk < MR; tk += NGW) {
        const size_t tok = (size_t)tk;
        if (lane < 32) *(LAS v4u*)(actw + lane * 4) = nrow;
        else if (lane < 48) *(LAS v4u*)(sidw + (lane - 32) * 8) = nrow;
        if (tk + NGW < MR) VROW_FETCH(tk + NGW);
        asm volatile("s_waitcnt lgkmcnt(0)" ::: "memory");
        v4u vA[8], vB[8];
#define V_LOAD(ST, kb) do { _Pragma("unroll") for (int q = 0; q < 8; ++q) { const int e = __builtin_amdgcn_readfirstlane((int)sidw[(kb) * 8 + q]); ST[q] = *(const v4u*)(V8 + (size_t)e * DM + lane * 16); } } while (0)
#define V_COMP(ST, kb) do { _Pragma("unroll") for (int q = 0; q < 8; ++q) { const float a = actw[(kb) * 8 + q]; const f32x2v a2 = {a, a}; const v4u x = ST[q]; \
            out2[0] = __builtin_elementwise_fma(__builtin_amdgcn_cvt_pk_f32_fp8((int)x.x, false), a2, out2[0]); out2[1] = __builtin_elementwise_fma(__builtin_amdgcn_cvt_pk_f32_fp8((int)x.x, true), a2, out2[1]); \
            out2[2] = __builtin_elementwise_fma(__builtin_amdgcn_cvt_pk_f32_fp8((int)x.y, false), a2, out2[2]); out2[3] = __builtin_elementwise_fma(__builtin_amdgcn_cvt_pk_f32_fp8((int)x.y, true), a2, out2[3]); \
            out2[4] = __builtin_elementwise_fma(__builtin_amdgcn_cvt_pk_f32_fp8((int)x.z, false), a2, out2[4]); out2[5] = __builtin_elementwise_fma(__builtin_amdgcn_cvt_pk_f32_fp8((int)x.z, true), a2, out2[5]); \
            out2[6] = __builtin_elementwise_fma(__builtin_amdgcn_cvt_pk_f32_fp8((int)x.w, false), a2, out2[6]); out2[7] = __builtin_elementwise_fma(__builtin_amdgcn_cvt_pk_f32_fp8((int)x.w, true), a2, out2[7]); } } while (0)
        f32x2v out2[8];
#pragma unroll
        for (int i = 0; i < 8; ++i) out2[i] = (f32x2v){0.f, 0.f};
        V_LOAD(vA, 0);
#pragma unroll 1
        for (int kb = 0; kb < 16; kb += 2) {
            V_LOAD(vB, kb + 1);
            V_COMP(vA, kb);
            if (kb + 2 < 16) V_LOAD(vA, kb + 2);
            V_COMP(vB, kb + 1);
        }
#undef V_LOAD
#undef V_COMP
        float out[16];
#pragma unroll
        for (int i = 0; i < 8; ++i) { out[2 * i] = out2[i][0]; out[2 * i + 1] = out2[i][1]; }
        float* orow = P.out + tok * DM + lane * 16;
        float s = 0.f;
#pragma unroll
        for (int q = 0; q < 4; ++q) { const pg8::f32x4 hv = *(const pg8::f32x4*)(orow + 4 * q);
#pragma unroll
            for (int e = 0; e < 4; ++e) { out[4 * q + e] = fmaf(ALPHA, hv[e], out[4 * q + e]); s += out[4 * q + e]; } }
        const float mean = wave_sum(s) * (1.f / DM); float s2 = 0.f;
#pragma unroll
        for (int i = 0; i < 16; ++i) { out[i] -= mean; s2 += out[i] * out[i]; }
        const float rstd = 1.f / sqrtf(wave_sum(s2) * (1.f / DM) + EPS);
#pragma unroll
        for (int q = 0; q < 4; ++q) { const pg8::f32x4 gg = *(const pg8::f32x4*)(g2 + lane * 16 + 4 * q), b4 = *(const pg8::f32x4*)(b2 + lane * 16 + 4 * q);
            pg8::f32x4 o; o[0] = out[4 * q] * rstd * gg[0] + b4[0]; o[1] = out[4 * q + 1] * rstd * gg[1] + b4[1]; o[2] = out[4 * q + 2] * rstd * gg[2] + b4[2]; o[3] = out[4 * q + 3] * rstd * gg[3] + b4[3];
            if (dostore) *(pg8::f32x4*)(orow + 4 * q) = o; }
    }
}

#define XB_TMO      128
#define XB_XCNT(j)  (256  + 64 * (j))
#define XB_XSUB(j)  (1280 + 64 * (j))
#define XB_XGEN(j)  (2304 + 64 * (j))
#define XB_TOP      3328
#define XB_TOPGEN   3392
#define XCD_BAR_WORDS 3456
#define XB_SPIN_CAP (1u << 18)

__device__ __forceinline__ unsigned xb_ld(unsigned* p)              { return __hip_atomic_load(p, __ATOMIC_RELAXED, __HIP_MEMORY_SCOPE_AGENT); }
__device__ __forceinline__ unsigned xb_add(unsigned* p, unsigned v) { return __hip_atomic_fetch_add(p, v, __ATOMIC_RELAXED, __HIP_MEMORY_SCOPE_AGENT); }
__device__ __forceinline__ unsigned xb_xcc_id() { return (unsigned)__builtin_amdgcn_s_getreg((3 << 11) | 20) & 0xFu; }
#define XB_SPIN(cond, bar) do { unsigned _sp = 0; while (cond) { __builtin_amdgcn_s_sleep(1); \
    if ((++_sp & 255u) == 0u) { if (xb_ld(&(bar)[XB_TMO])) break; if (_sp > XB_SPIN_CAP) { atomicAdd(&(bar)[XB_TMO], 1u); break; } } } } while (0)

struct XcdBarrier {
    unsigned* bar; unsigned x;
    volatile LAS unsigned* st;
};

__device__ __forceinline__ XcdBarrier xcd_barrier_post(unsigned* bar, volatile LAS unsigned* st) {
    XcdBarrier b; b.bar = bar; b.x = xb_xcc_id(); b.st = st;
    if (threadIdx.x == 0) (void)xb_add(&bar[XB_XCNT(b.x)], 1u);
    return b;
}
__device__ __forceinline__ void xcd_barrier_complete(unsigned* bar, unsigned x, unsigned& nloc, unsigned& nx) {
    const unsigned G = gridDim.x * gridDim.y * gridDim.z;
    unsigned sum, cnt, mine, sp = 0u;
    for (;;) {
        sum = 0u; cnt = 0u; mine = 0u;
#pragma unroll
        for (unsigned j = 0; j < 16; ++j) { const unsigned c = xb_ld(&bar[XB_XCNT(j)]); sum += c; cnt += (c > 0u) ? 1u : 0u; mine = (j == x) ? c : mine; }
        if (sum == G) break;
        __builtin_amdgcn_s_sleep(1);
        if ((++sp & 255u) == 0u) { if (xb_ld(&bar[XB_TMO])) break; if (sp > XB_SPIN_CAP) { atomicAdd(&bar[XB_TMO], 1u); break; } }
    }
    nloc = mine > 0u ? mine : 1u; nx = cnt > 0u ? cnt : 1u;
}

__device__ __forceinline__ void xcd_barrier(const XcdBarrier& b) {
    asm volatile("s_waitcnt vmcnt(0)" ::: "memory");
    __syncthreads();
    if (threadIdx.x == 0) {
        unsigned* bar = b.bar;
        __builtin_amdgcn_s_waitcnt(0);
        unsigned nloc = b.st[0], nx = b.st[1];
        if (nloc == 0u) { xcd_barrier_complete(bar, b.x, nloc, nx); b.st[0] = nloc; b.st[1] = nx; }
        const unsigned old = xb_add(&bar[XB_XSUB(b.x)], 1u);
        const unsigned gen = old / nloc;
        if (old + 1u == (gen + 1u) * nloc) {
            __builtin_amdgcn_fence(__ATOMIC_RELEASE, "agent");
            asm volatile("s_waitcnt vmcnt(0)" ::: "memory");
            const unsigned og = xb_add(&bar[XB_TOP], 1u);
            const unsigned tg = og / nx;
            if (og + 1u == (tg + 1u) * nx) xb_add(&bar[XB_TOPGEN], 1u);
            else XB_SPIN(xb_ld(&bar[XB_TOPGEN]) == tg, bar);
            __builtin_amdgcn_fence(__ATOMIC_ACQUIRE, "agent");
            xb_add(&bar[XB_XGEN(b.x)], 1u);
            asm volatile("s_waitcnt vmcnt(0)" ::: "memory");
        } else {
            XB_SPIN(xb_ld(&bar[XB_XGEN(b.x)]) == gen, bar);
            __builtin_amdgcn_fence(__ATOMIC_ACQUIRE, "agent");
            asm volatile("s_waitcnt vmcnt(0)" ::: "memory");
        }
    }
    __syncthreads();
}

__device__ __forceinline__ void sub_barrier(unsigned* cnt, unsigned n) {
    asm volatile("s_waitcnt vmcnt(0)" ::: "memory");
    __syncthreads();
    if (threadIdx.x == 0) {
        __builtin_amdgcn_fence(__ATOMIC_RELEASE, "agent");
        asm volatile("s_waitcnt vmcnt(0)" ::: "memory");
        __hip_atomic_fetch_add(cnt, 1u, __ATOMIC_RELAXED, __HIP_MEMORY_SCOPE_AGENT);
        unsigned sp = 0;
        while (__hip_atomic_load(cnt, __ATOMIC_RELAXED, __HIP_MEMORY_SCOPE_AGENT) < n) { __builtin_amdgcn_s_sleep(2); if (++sp > (1u << 22)) break; }
        __builtin_amdgcn_fence(__ATOMIC_ACQUIRE, "agent");
        asm volatile("s_waitcnt vmcnt(0)" ::: "memory");
    }
    __syncthreads();
}

constexpr int N_PHASES = 12 + (PEER_SPLIT == 3 ? 2 : PEER_SPLIT);
__global__ void __launch_bounds__(512, 2) mega_fwd(Params P) {
    extern __shared__ __attribute__((aligned(16))) unsigned char lds_raw[];
    Ctx C; C.lds = (LAS unsigned char*)lds_raw; C.tid = threadIdx.x; C.lane = C.tid & 63; C.wave = __builtin_amdgcn_readfirstlane(C.tid >> 6);
    C.G = gridDim.x; C.bid = blockIdx.x; C.vcu = (C.G % 8 == 0) ? (C.bid % 8) * (C.G / 8) + C.bid / 8 : C.bid;
    unsigned char* ws = P.ws;
    const int lo = P.ph_lo, hi = P.ph_hi;
    volatile LAS unsigned* bst = (volatile LAS unsigned*)(C.lds + LDS_BYTES - 64);
    if (C.tid < 16) bst[C.tid] = 0u;
    __syncthreads();
    (void)xcd_barrier_post((unsigned*)(ws + WS_CTL) + 1024, bst);
#define RETID() do { int t_ = threadIdx.x; asm volatile("" : "+v"(t_)); C.tid = t_; C.lane = t_ & 63; } while (0)
#ifndef PH_MASK
#define PH_MASK 0x3FFF
#endif
#define IN(k) (((PH_MASK >> (k)) & 1) && lo <= (k) && (k) < hi)
#ifndef DUP_MASK
#define DUP_MASK 0
#endif
#define REPS(k) (((DUP_MASK >> (k)) & 1) ? 2 : 1)
#define SEAM(k) do { if (IN(k) && IN((k) + 1)) { if ((k) == 0) cg::this_grid().sync(); else { XcdBarrier xb_; xb_.bar = (unsigned*)(P.ws + WS_CTL) + 1024; xb_.x = xb_xcc_id(); xb_.st = (volatile LAS unsigned*)(C.lds + LDS_BYTES - 64); xcd_barrier(xb_); } } } while (0)
    typedef pg8::StaticOrder SO;
    if (IN(0)) for (int rep = 0; rep < REPS(0); ++rep) { RETID(); p0_prologue(P, C); }
    SEAM(0);
    if (IN(1)) for (int rep = 0; rep < REPS(1); ++rep) {
        pg8::Gemm g{(const bf16*)(ws + WS_A), (const bf16*)(ws + WS_WIN), MV, N1, DM}; SO S; S.init(MV, N1, C.G, C.bid);
        pg8::EpiInProj E{(bf16*)(ws + WS_HQ), (bf16*)(ws + WS_K1), (bf16*)(ws + WS_HI), (bf16*)(ws + WS_HG), (bf16*)(ws + WS_CQ), (bf16*)(ws + WS_CKV), (bf16*)(ws + WS_KR),
                         (bf16*)P.out, (bf16*)P.out + (size_t)MR * DM, P.in[I_LBL], (const float*)(ws + WS_ROPE)};
#ifdef INPROJ_NOSTORE_FIRST
        if (rep == 0) { pg8::EpiNoStore EN{E.HQ, hi > 100}; pg8::gemm_phase<pg8::EpiNoStore, SO, true, true>(C.lds, g, S, EN); } else
#endif
#ifdef INPROJ_RAW_FIRST
        if (rep == 0) { pg8::EpiInProjT<true> ER{E.HQ, E.K1, E.HI, E.HG, E.CQ, E.CKV, E.KR, E.GA, E.GB, E.lbl, E.rope}; pg8::gemm_phase<pg8::EpiInProjT<true>, SO, true, true>(C.lds, g, S, ER); } else
#endif
        pg8::gemm_phase<pg8::EpiInProj, SO, true, true>(C.lds, g, S, E);
    }
    SEAM(1);
    const bool split2 = false;
    if (IN(2)) for (int rep = 0; rep < REPS(2); ++rep) {
        RETID();
        if (!split2) {
            if (C.G == 256) {
                if (C.bid < 128) { hgrn_item2(P, C, C.bid); late_weights(P, C, C.bid * 8 + C.wave, 128 * 8, (size_t)C.bid * 512 + C.tid, (size_t)128 * 512, 2); }
                else { rowstats(P, C, (C.bid - 128) * 8 + C.wave, 128 * 8); late_weights(P, C, (C.bid - 128) * 8 + C.wave, 128 * 8, (size_t)(C.bid - 128) * 512 + C.tid, (size_t)128 * 512, 1);
                    __syncthreads();
                    pg8::Gemm g{(const bf16*)(ws + WS_A), (const bf16*)(ws + WS_WIN) + (size_t)N1 * DM, MR, 2048, DM}; pg8::GateOrder S; S.init(MR, 2048, 128, C.bid - 128);
                    pg8::EpiGates E{(bf16*)P.out, (bf16*)P.out + (size_t)MR * DM};
                    pg8::gemm_phase<pg8::EpiGates, pg8::GateOrder, true, true>(C.lds, g, S, E); }
            } else {
                rowstats(P, C, C.vcu * 8 + C.wave, C.G * 8); late_weights(P, C, C.vcu * 8 + C.wave, C.G * 8, (size_t)C.vcu * 512 + C.tid, (size_t)C.G * 512, 3);
                for (int item = C.bid; item < NB * HGH; item += C.G) hgrn_item2(P, C, item);
                { pg8::Gemm g{(const bf16*)(ws + WS_A), (const bf16*)(ws + WS_WIN) + (size_t)N1 * DM, MR, 2048, DM}; pg8::GateOrder S; S.init(MR, 2048, C.G, C.bid);
                  pg8::EpiGates E{(bf16*)P.out, (bf16*)P.out + (size_t)MR * DM};
                  pg8::gemm_phase<pg8::EpiGates, pg8::GateOrder, true, true>(C.lds, g, S, E); }
            }
        } else if (C.bid < 128) {
            hgrn_item2(P, C, C.bid);
        } else {
            rowstats(P, C, (C.bid - 128) * 8 + C.wave, 128 * 8);
            sub_barrier((unsigned*)(ws + WS_CTL) + 8192 + 64 * rep, 128u);
            { pg8::Gemm g{(const bf16*)(ws + WS_CQ), (const bf16*)(ws + WS_WUQ), MRH, 3072, QR}; SO S; S.init(MRH, 3072, 128, C.bid - 128);
              pg8::EpiQ E{(bf16*)(ws + WS_QH), (const float*)(ws + WS_RQ), (const float*)(ws + WS_ROPE), 0};
              pg8::gemm_phase<pg8::EpiQ, SO, true, true>(C.lds, g, S, E); }
            { pg8::Gemm g{(const bf16*)(ws + WS_CKV), (const bf16*)(ws + WS_WUKV), MALLH, 4096, KVR}; SO S; S.init(MALLH, 4096, 128, C.bid - 128);
              pg8::EpiScaleBf16 E{(bf16*)(ws + WS_KVH), 4096, (const float*)(ws + WS_RKV), 0};
              pg8::gemm_phase<pg8::EpiScaleBf16, SO, true, true>(C.lds, g, S, E); }
        }
    }
    SEAM(2);
#pragma unroll 1
    for (int hb = 0; hb < NHALF; ++hb) {
        if (IN(3 + 2 * hb) && !(split2 && hb == 0)) for (int rep = 0; rep < REPS(3); ++rep) {
#ifndef NO_QG
            { pg8::Gemm g{(const bf16*)(ws + WS_CQ) + (size_t)hb * MRH * QR, (const bf16*)(ws + WS_WUQ), MRH, 3072, QR}; SO S; S.init(MRH, 3072, C.G, C.bid);
              pg8::EpiQ E{(bf16*)(ws + WS_QH), (const float*)(ws + WS_RQ), (const float*)(ws + WS_ROPE), hb * MRH};
              pg8::gemm_phase<pg8::EpiQ, SO, true, true>(C.lds, g, S, E); }
#endif
#ifndef NO_KVG
            { pg8::Gemm g{(const bf16*)(ws + WS_CKV) + (size_t)hb * MALLH * KVR, (const bf16*)(ws + WS_WUKV), MALLH, 4096, KVR}; SO S; S.init(MALLH, 4096, C.G, C.bid);
              pg8::EpiScaleBf16 E{(bf16*)(ws + WS_KVH), 4096, (const float*)(ws + WS_RKV), hb * MALLH};
              pg8::gemm_phase<pg8::EpiScaleBf16, SO, true, true>(C.lds, g, S, E); }
#endif
        }
        if (!(split2 && hb == 0)) SEAM(3 + 2 * hb);
        if (IN(4 + 2 * hb)) for (int rep = 0; rep < REPS(4); ++rep) {
            const bf16* QH = (const bf16*)(ws + WS_QH); const bf16* KVH = (const bf16*)(ws + WS_KVH); const bf16* KR = (const bf16*)(ws + WS_KR); bf16* AO = (bf16*)(ws + WS_AO);
            for (int wv = C.vcu; wv < 256; wv += C.G) {
                const int bhl = wv >> 1, bl = bhl >> 4, h = bhl & 15, sub = wv & 1, b = hb * HB + bl;
#pragma unroll 1
                for (int i = 0; i < 4; ++i) {
                    const int qb = sub ? (i == 0 ? 2 : i == 1 ? 5 : i == 2 ? 3 : 4) : (i == 0 ? 0 : i == 1 ? 7 : i == 2 ? 1 : 6);
                    attn::attn_unit(QH + ((size_t)bl * SEQ + qb * 256) * 3072 + h * QKD, KVH + ((size_t)bl * PP + 64) * 4096 + h * 256, KR + ((size_t)b * PP + 64) * ROPE,
                                    AO + ((size_t)b * SEQ + qb * 256) * 2048 + h * VD, 4 * qb + 5, (char*)lds_raw);
                }
            }
        }
        SEAM(4 + 2 * hb);
    }
    if (IN(7)) for (int rep = 0; rep < REPS(7); ++rep) {
        RETID();
#pragma unroll 1
        for (int slot = 0; slot < 2; ++slot) {
            if ((slot == 0) == ((C.bid & 1) != 0)) {
#if PEER_SPLIT == 3
                cvt_table_fp8_sliced(P.in[I_PU], ws + WS_U8, (float*)(ws + WS_SU), C.vcu * 8 + C.wave, C.G * 8, C.lane);
#else
                cvt_table_fp8(P.in[I_PU], ws + WS_U8, (float*)(ws + WS_SU), C.vcu * 8 + C.wave, C.G * 8, C.lane);
#endif
                cvt_table_fp8(P.in[I_PV], ws + WS_V8, (float*)(ws + WS_SU) + 1, C.vcu * 8 + C.wave, C.G * 8, C.lane);
            } else {
                { pg8::Gemm g{(const bf16*)(ws + WS_ON), (const bf16*)(ws + WS_WPH), MR, DM, 1024}; SO S; S.init(MR, DM, C.G, C.bid);
                  pg8::EpiGate<false> E{(bf16*)(ws + WS_X), (const bf16*)P.out};
                  pg8::gemm_phase<pg8::EpiGate<false>, SO, true, true>(C.lds, g, S, E); }
                { pg8::Gemm g{(const bf16*)(ws + WS_AO), (const bf16*)(ws + WS_WPM), MR, DM, 2048}; SO S; S.init(MR, DM, C.G, C.bid);
                  pg8::EpiGate<true> E{(bf16*)(ws + WS_X), (const bf16*)P.out + (size_t)MR * DM};
                  pg8::gemm_phase<pg8::EpiGate<true>, SO, true, true>(C.lds, g, S, E); }
            }
        }
    }
    SEAM(7);
    if (IN(8)) for (int rep = 0; rep < REPS(8); ++rep) {
        pg8::Gemm g{(const bf16*)(ws + WS_X), (const bf16*)(ws + WS_WO), MR, DM, 1024}; SO S; S.init(MR, DM, C.G, C.bid);
        pg8::EpiResF32 E{P.out, P.in[I_X], ALPHA};
        pg8::gemm_phase<pg8::EpiResF32, SO, true, true>(C.lds, g, S, E);
    }
    SEAM(8);
    if (IN(9)) for (int rep = 0; rep < REPS(9); ++rep) { RETID(); ln1_phase(P, C, rep + 1 == REPS(9) || hi > 100); }
    SEAM(9);
    if (IN(10)) for (int rep = 0; rep < REPS(10); ++rep) {
        pg8::Gemm g{(const bf16*)(ws + WS_H1B), (const bf16*)(ws + WS_WPQ), MR, 2048, 1024}; SO S; S.init(MR, 2048, C.G, C.bid);
        pg8::EpiScaleBf16 E{(bf16*)(ws + WS_PQ), 2048, nullptr, 0};
        pg8::gemm_phase<pg8::EpiScaleBf16, SO, true, true>(C.lds, g, S, E);
    }
    SEAM(10);
#if PEER_SPLIT == 3
    if (IN(11)) { RETID(); peer_route_publish_phase(P, C); }
    SEAM(11);
    if (IN(12)) { RETID(); peer_u_sliced_phase(P, C); }
    SEAM(12);
    if (IN(13)) for (int rep = 0; rep < REPS(13); ++rep) { RETID(); peer_v_phase(P, C, rep + 1 == REPS(13) || hi > 100); }
#else
    if (IN(11)) for (int rep = 0; rep < REPS(11); ++rep) { RETID(); peer_phase(P, C, rep + 1 == REPS(11) || hi > 100); }
#if PEER_SPLIT
    SEAM(11);
    if (IN(12)) for (int rep = 0; rep < REPS(12); ++rep) { RETID(); peer_v_phase(P, C, rep + 1 == REPS(12) || hi > 100); }
#endif
#endif
#undef IN
#undef SEAM
}

extern "C" void kernel_launch(void* const* d_in, const int* in_sizes, int n_in, void* d_out, int out_size, void* d_ws, size_t ws_size, hipStream_t stream) {
    static int grid = 0;
    if (grid == 0) {
        if (n_in != 20 || in_sizes[0] != MR * DM || out_size != MR * DM || ws_size < WS_NEED) {
            fprintf(stderr, "kernel_launch: unexpected shapes: n_in %d in0 %d out %d ws %zu (need %zu)\n", n_in, n_in > 0 ? in_sizes[0] : -1, out_size, ws_size, (size_t)WS_NEED); grid = -1; return; }
        int dev = 0, cus = 0, per_cu = 0;
        if (hipGetDevice(&dev) != hipSuccess || hipDeviceGetAttribute(&cus, hipDeviceAttributeMultiprocessorCount, dev) != hipSuccess) { grid = -1; return; }
        if (hipFuncSetAttribute((const void*)mega_fwd, hipFuncAttributeMaxDynamicSharedMemorySize, LDS_BYTES) != hipSuccess) { fprintf(stderr, "kernel_launch: hipFuncSetAttribute failed\n"); grid = -1; return; }
        if (hipOccupancyMaxActiveBlocksPerMultiprocessor(&per_cu, (const void*)mega_fwd, 512, LDS_BYTES) != hipSuccess || per_cu < 1) { fprintf(stderr, "kernel_launch: occupancy query says %d\n", per_cu); per_cu = 1; }
        (void)hipGetLastError();
        grid = cus;
        if (grid > 256) grid = 256;
    }
    if (grid < 0) return;
    if (hipMemsetAsync((char*)d_ws + WS_CTL, 0, 65536, stream) != hipSuccess) { fprintf(stderr, "kernel_launch: memset failed\n"); return; }
    Params p{};
    for (int i = 0; i < 20; ++i) p.in[i] = (const float*)d_in[i];
    p.out = (float*)d_out; p.ws = (unsigned char*)d_ws;
#if MK_LAUNCHES == 1
    p.ph_lo = 0; p.ph_hi = N_PHASES;
    void* args[] = {&p};
    hipError_t e = hipLaunchCooperativeKernel((const void*)mega_fwd, dim3(grid), dim3(512), args, LDS_BYTES, stream);
    if (e != hipSuccess) fprintf(stderr, "cooperative launch failed: %s (grid %d)\n", hipGetErrorString(e), grid);
#else
    for (int ph = 0; ph < N_PHASES; ++ph) {
        p.ph_lo = ph; p.ph_hi = ph + 1;
        hipLaunchKernelGGL(mega_fwd, dim3(grid), dim3(512), LDS_BYTES, stream, p);
    }
#endif
}
```

```cpp
#include <hip/hip_runtime.h>
#include <hip/hip_cooperative_groups.h>
#include <cstdio>
#include <cstdint>
#include <cmath>
namespace cg = cooperative_groups;

#ifndef MK_LAUNCHES
#define MK_LAUNCHES 1
#endif
#ifndef PEER_SAMEORDER
#define PEER_SAMEORDER 0
#endif
#ifndef PEER_SPLIT
#define PEER_SPLIT 3
#endif

constexpr int NB = 16, SEQ = 2048, DM = 1024, LEAD = 128, NPADR = 112, PP = LEAD + SEQ;
constexpr int MALL = NB * PP;
constexpr int MR = NB * SEQ;
constexpr int INW = 6848, INWP = 6912;
constexpr int N1 = 4864, N1V = 4800;
constexpr int N1G = 5888;
constexpr int PV = PP - NPADR, MV = NB * PV;
constexpr int QR = 384, KVR = 256, ROPE = 64, NH = 16, QKD = 192, VD = 128;
constexpr int HGH = 8;
constexpr float ALPHA = 1.189207115002721f;
constexpr float EPS = 1e-5f;
constexpr int NHALF = 2, HB = NB / NHALF;
constexpr int MRH = HB * SEQ, MALLH = HB * PP;

constexpr size_t MiB = 1u << 20;
constexpr size_t al256(size_t x) { return (x + 255) / 256 * 256; }
constexpr size_t WS_CTL = 0;
constexpr size_t WS_WIN = 1 * MiB;
constexpr size_t WS_WUQ = WS_WIN + (size_t)INWP * DM * 2;
constexpr size_t WS_WUKV = WS_WUQ + (size_t)3072 * QR * 2;
constexpr size_t WS_WPH = WS_WUKV + (size_t)4096 * KVR * 2;
constexpr size_t WS_WPM = WS_WPH + (size_t)1024 * 1024 * 2;
constexpr size_t WS_WO = WS_WPM + (size_t)1024 * 2048 * 2;
constexpr size_t WS_WPQ = WS_WO + (size_t)1024 * 1024 * 2;
constexpr size_t WS_SK = WS_WPQ + (size_t)2048 * 1024 * 2;
constexpr size_t WS_ROPE = WS_SK + (size_t)16 * 128 * 128 * 2;
constexpr size_t WS_RQ = WS_ROPE + (size_t)PP * 32 * 2 * 4;
constexpr size_t WS_RKV = WS_RQ + (size_t)MR * 4;
constexpr size_t WS_WEND = WS_RKV + (size_t)MALL * 4;
static_assert(WS_WEND <= 34 * MiB, "weights region");
constexpr size_t WS_C = 34 * MiB;
constexpr size_t WS_CQ = WS_C, WS_CKV = WS_CQ + (size_t)MR * QR * 2, WS_KR = WS_CKV + (size_t)MALL * KVR * 2;
static_assert(WS_KR + (size_t)MALL * ROPE * 2 <= 81 * MiB, "C region");
constexpr size_t WS_A = 81 * MiB;
constexpr size_t WS_ON = 448 * MiB;
constexpr size_t WS_B = 149 * MiB;
constexpr size_t WS_HQ = WS_B, WS_K1 = WS_HQ + (size_t)MALL * DM * 2, WS_HI = WS_K1 + (size_t)MALL * DM * 2, WS_HG = WS_HI + (size_t)MALL * DM * 2;
static_assert(WS_HG + (size_t)MR * DM * 2 <= 421 * MiB, "B region");
constexpr size_t WS_QH = 81 * MiB;
constexpr size_t WS_KVH = 177 * MiB;
constexpr size_t WS_AO = 313 * MiB;
constexpr size_t WS_X = 81 * MiB;
constexpr size_t WS_H1B = 178 * MiB;
constexpr size_t WS_U8 = 145 * MiB, WS_V8 = 161 * MiB, WS_SU = 177 * MiB, WS_SV = WS_SU + 65536;
constexpr size_t WS_ACT = 242 * MiB, WS_SIDX = 258 * MiB, WS_ACTPRE = 266 * MiB, WS_SUS = 282 * MiB;
constexpr size_t WS_PQ = 313 * MiB;
constexpr size_t WS_NEED = 512 * MiB;
static_assert(WS_AO + (size_t)MR * 2048 * 2 <= WS_ON && WS_ON + (size_t)MR * DM * 2 <= WS_NEED && WS_KVH + (size_t)MALLH * 4096 * 2 <= WS_AO && WS_QH + (size_t)MRH * 3072 * 2 <= WS_KVH && WS_HG + (size_t)MR * DM * 2 <= WS_ON && WS_A + (size_t)MV * DM * 2 <= WS_B, "attention buffers");
static_assert(WS_X + (size_t)MR * DM * 2 <= WS_U8 && WS_SV + 65536 <= WS_H1B && WS_H1B + (size_t)MR * DM * 2 <= WS_PQ && WS_PQ + (size_t)MR * 2048 * 2 <= WS_ON, "late buffers");

constexpr int LDS_BYTES = 147456;

#define LAS __attribute__((address_space(3)))
#define GAS __attribute__((address_space(1)))
typedef unsigned short bf16;
typedef unsigned v4u __attribute__((ext_vector_type(4)));
typedef unsigned v2u __attribute__((ext_vector_type(2)));
typedef float f32x2 __attribute__((ext_vector_type(2)));
typedef float f32x8 __attribute__((ext_vector_type(8)));
typedef float f32x16 __attribute__((ext_vector_type(16)));
typedef short s16x4 __attribute__((ext_vector_type(4)));

__device__ __forceinline__ unsigned f2bf(float f) { unsigned u = __builtin_bit_cast(unsigned, f); return (u + 0x7fffu + ((u >> 16) & 1u)) >> 16; }
__device__ __forceinline__ unsigned pk2(float lo, float hi) { return f2bf(lo) | (f2bf(hi) << 16); }
__device__ __forceinline__ float bflo(unsigned w) { return __builtin_bit_cast(float, w << 16); }
__device__ __forceinline__ float bfhi(unsigned w) { return __builtin_bit_cast(float, w & 0xffff0000u); }
__device__ __forceinline__ float bf2f(unsigned short h) { return __builtin_bit_cast(float, (unsigned)h << 16); }
__device__ __forceinline__ float fsigmoid(float x) { return 1.0f / (1.0f + __expf(-x)); }
__device__ __forceinline__ float wave_sum(float v) {
#pragma unroll
    for (int o = 1; o < 64; o <<= 1) v += __shfl_xor(v, o);
    return v;
}
namespace pg8 {
#define PG8_LAS __attribute__((address_space(3)))
typedef unsigned short bf16_t;
typedef short bf16x8 __attribute__((ext_vector_type(8)));
typedef float f32x4 __attribute__((ext_vector_type(4)));
typedef unsigned u32x4 __attribute__((ext_vector_type(4)));
constexpr int BM = 256, BK = 64, HALF = 128, HTB = HALF * BK * 2  , STAGE_BYTES = 8 * HTB, NXCD = 8, WGM = 8;

__host__ __device__ __forceinline__ int lds_byte(int r, int c) { const int st = (r >> 4) * 2 + (c >> 5), rr = r & 15, cc = c & 31, ob = rr * 64 + cc * 2; return st * 1024 + (ob ^ (((ob >> 9) & 1) << 5)); }
__host__ __device__ __forceinline__ void stage_rc(int b, int& R, int& C) { const int st = b / 1024, sb = b % 1024, swz = sb ^ (((sb >> 9) & 1) << 5); R = (st >> 1) * 16 + swz / 64; C = (st & 1) * 32 + (swz % 64) / 2; }
__host__ __device__ __forceinline__ int perm32(int rho) { const int n = rho >> 4, i = rho & 15; return 8 * (i >> 2) + 4 * n + (i & 3); }

struct Unit { int pm, pn; };
struct Gemm { const bf16_t* A; const bf16_t* Bt; int M, N, K; };

struct StaticOrder {
    int nM, nN, nwg, G, c;
    __host__ __device__ void init(int M, int N, int G_, int c_) { nM = M / BM; nN = N / BM; nwg = nM * nN; G = G_; c = c_; }
    __host__ __device__ bool next(int i, Unit& u) const {
        const long L = (long)i * G + c; if (L >= nwg) return false;
        int wgid = (int)L; { const int q = nwg / NXCD, r = nwg % NXCD, xcd = wgid % NXCD, off = wgid / NXCD; wgid = (xcd < r ? xcd * (q + 1) : r * (q + 1) + (xcd - r) * q) + off; }
        const int nig = WGM * nN, gid = wgid / nig, fm = gid * WGM, gsz = (nM - fm) < WGM ? (nM - fm) : WGM;
        u.pm = fm + ((wgid % nig) % gsz); u.pn = (wgid % nig) / gsz; return true;
    }
    __device__ __forceinline__ int arow(int pm) const { return pm * BM; }
    __device__ __forceinline__ void a_ready(const Unit&) const {}
    __device__ __forceinline__ void done(const Unit&) const {}
};
struct GateOrder : StaticOrder { __device__ __forceinline__ int arow(int pm) const { return (pm >> 3) * 2064 + 16 + (pm & 7) * BM; } };
struct DynGateOrder {
    unsigned* slots; unsigned* counter; int nN, nwg;
    __device__ __forceinline__ bool next(int i, Unit& u) const {
        if (i >= 16) return false;
        unsigned v = 0;
        if ((threadIdx.x & 63) == 0) {
            v = __hip_atomic_load(slots + i, __ATOMIC_RELAXED, __HIP_MEMORY_SCOPE_AGENT);
            if (v == 0u) { unsigned expect = 0u;
                if (__hip_atomic_compare_exchange_strong(slots + i, &expect, 1u, __ATOMIC_RELAXED, __ATOMIC_RELAXED, __HIP_MEMORY_SCOPE_AGENT)) {
                    const unsigned t = __hip_atomic_fetch_add(counter, 1u, __ATOMIC_RELAXED, __HIP_MEMORY_SCOPE_AGENT);
                    __hip_atomic_store(slots + i, t + 2u, __ATOMIC_RELAXED, __HIP_MEMORY_SCOPE_AGENT); } }
            unsigned sp = 0;
            while ((v = __hip_atomic_load(slots + i, __ATOMIC_RELAXED, __HIP_MEMORY_SCOPE_AGENT)) < 2u) { __builtin_amdgcn_s_sleep(1); if (++sp > (1u << 24)) { v = 0x7fffffffu; break; } }
        }
        const int t = (int)__builtin_amdgcn_readfirstlane(v) - 2;
        if (t >= nwg) return false;
        u.pm = t / nN; u.pn = t - u.pm * nN; return true;
    }
    __device__ __forceinline__ int arow(int pm) const { return (pm >> 3) * 2064 + 16 + (pm & 7) * BM; }
    __device__ __forceinline__ void a_ready(const Unit&) const {}
    __device__ __forceinline__ void done(const Unit&) const {}
};
__device__ __forceinline__ unsigned cvt_pk_bf16(float lo, float hi) { unsigned r; asm volatile("v_cvt_pk_bf16_f32 %0, %1, %2" : "=v"(r) : "v"(lo), "v"(hi)); return r; }
typedef float f32x2 __attribute__((ext_vector_type(2)));
template <class Epi, class Sched, bool ALIGN_EPI = false, bool SP2 = false>
__device__ __forceinline__ void gemm_phase(PG8_LAS unsigned char* lds, const Gemm g, const Sched& S, const Epi& E) {
    int tid_ = threadIdx.x; asm volatile("" : "+v"(tid_));
    const int tid = tid_, wid = __builtin_amdgcn_readfirstlane(tid >> 6), lane = tid & 63, wr = wid >> 2, wc = wid & 3, fr = lane & 15, fq = lane >> 4;
    int K_ = g.K; asm volatile("" : "+s"(K_));
    const int K = K_, nt = K / BK;
    unsigned voffA[2], voffB[2];
#pragma unroll
    for (int i = 0; i < 2; ++i) { int R, C; stage_rc(tid * 16 + i * 8192, R, C); const int Rb = Epi::PERM ? ((R & ~31) + perm32(R & 31)) : R;
        voffA[i] = (unsigned)(R * K + C) * 2u; voffB[i] = (unsigned)(Rb * K + C) * 2u; }
    const size_t kstep = (size_t)(BK * 2);
    const size_t hstep = (size_t)HALF * K * 2;
    const size_t tstep = 2 * hstep;
    const unsigned ldsw = (unsigned)wid * 1024u;
    const int aoff = lds_byte(wr * 64 + fr, fq * 8), boff = lds_byte(wc * 32 + fr, fq * 8);
#define PG8_SA(b, h) (((b) * 2 + (h)) * HTB)
#define PG8_SB(b, h) ((4 + (b) * 2 + (h)) * HTB)
#define PG8_STAGE(bufoff, gbase, voff) do { _Pragma("unroll") for (int _i = 0; _i < 2; ++_i) \
        __builtin_amdgcn_global_load_lds((const unsigned*)((const char*)(gbase) + (voff)[_i]), (PG8_LAS unsigned*)(lds + (bufoff) + ldsw + _i * 8192), 16, 0, 0); } while (0)
#define PG8_LDA(dst, b, h) do { _Pragma("unroll") for (int m = 0; m < 4; ++m) _Pragma("unroll") for (int k = 0; k < 2; ++k) dst[m][k] = *(const PG8_LAS bf16x8*)(lds + PG8_SA(b, h) + aoff + m * 2048 + k * 1024); } while (0)
#define PG8_LDB(dst, b, h) do { _Pragma("unroll") for (int n = 0; n < 2; ++n) _Pragma("unroll") for (int k = 0; k < 2; ++k) dst[n][k] = *(const PG8_LAS bf16x8*)(lds + PG8_SB(b, h) + boff + n * 2048 + k * 1024); } while (0)
#define PG8_MMA(ai, bj, At, Bt) do { __builtin_amdgcn_s_setprio(1); _Pragma("unroll") for (int m = 0; m < 4; ++m) _Pragma("unroll") for (int n = 0; n < 2; ++n) _Pragma("unroll") for (int k = 0; k < 2; ++k) \
        acc[ai][bj][m][n] = __builtin_amdgcn_mfma_f32_16x16x32_bf16(Bt[n][k], At[m][k], acc[ai][bj][m][n], 0, 0, 0); __builtin_amdgcn_s_setprio(0); } while (0)
#define PG8_WAIT_V(n) asm volatile("s_waitcnt vmcnt(" #n ")" ::: "memory")
#define PG8_WAIT_L(n) asm volatile("s_waitcnt lgkmcnt(" #n ")" ::: "memory")
#define PG8_BAR __builtin_amdgcn_s_barrier()
#define PG8_SCHED __builtin_amdgcn_sched_barrier(0)
    Unit cur, nxt; int ui = 0;
    if (!S.next(0, cur)) return;
    f32x4 acc[2][2][4][2];
#pragma unroll
    for (int a = 0; a < 2; ++a)
#pragma unroll
        for (int b = 0; b < 2; ++b)
#pragma unroll
            for (int m = 0; m < 4; ++m)
#pragma unroll
                for (int n = 0; n < 2; ++n) acc[a][b][m][n] = (f32x4){0.f, 0.f, 0.f, 0.f};
    bf16x8 At[4][2], B0[2][2], B1[2][2];
    const char* cA = (const char*)g.A + (size_t)S.arow(cur.pm) * (size_t)K * 2; const char* cB = (const char*)g.Bt + (size_t)cur.pn * tstep;
    S.a_ready(cur);
    if constexpr (SP2) {
        PG8_STAGE(PG8_SB(0, 0), cB, voffB); PG8_STAGE(PG8_SB(0, 1), cB + hstep, voffB); PG8_STAGE(PG8_SA(0, 0), cA, voffA); PG8_STAGE(PG8_SA(0, 1), cA + hstep, voffA);
        if (wr == 1) PG8_BAR;
        PG8_WAIT_V(2); PG8_BAR;
        PG8_STAGE(PG8_SB(1, 0), cB + kstep, voffB); PG8_STAGE(PG8_SA(1, 0), cA + kstep, voffA); PG8_STAGE(PG8_SB(1, 1), cB + hstep + kstep, voffB);
        PG8_WAIT_V(6); PG8_BAR;
    } else {
        PG8_STAGE(PG8_SB(0, 0), cB, voffB); PG8_STAGE(PG8_SA(0, 0), cA, voffA); PG8_STAGE(PG8_SB(0, 1), cB + hstep, voffB); PG8_STAGE(PG8_SA(0, 1), cA + hstep, voffA);
        if (wr == 1) PG8_BAR;
        PG8_WAIT_V(4); PG8_BAR;
        PG8_STAGE(PG8_SB(1, 0), cB + kstep, voffB); PG8_STAGE(PG8_SA(1, 0), cA + kstep, voffA); PG8_STAGE(PG8_SB(1, 1), cB + hstep + kstep, voffB);
        PG8_WAIT_V(6); PG8_BAR;
    }
    for (;;) {
        const bool has_next = S.next(ui + 1, nxt);
        const char* nA = has_next ? (const char*)g.A + (size_t)S.arow(nxt.pm) * (size_t)K * 2 : cA; const char* nB = has_next ? (const char*)g.Bt + (size_t)nxt.pn * tstep : cB;
        for (int t = 0; t < nt; t += 2) {
            const bool last = (t == nt - 2);
            const char* a1 = cA + (size_t)(t + 1) * kstep;
            const char* a2 = last ? nA : cA + (size_t)(t + 2) * kstep; const char* b2 = last ? nB : cB + (size_t)(t + 2) * kstep;
            const char* a3 = a2 + kstep; const char* b3 = b2 + kstep;
            if (last && has_next) S.a_ready(nxt);
            if constexpr (SP2) {
            PG8_LDB(B0, 0, 0); PG8_LDB(B1, 0, 1); PG8_SCHED; PG8_LDA(At, 0, 0); PG8_STAGE(PG8_SA(1, 1), a1 + hstep, voffA);
            PG8_WAIT_V(8); PG8_WAIT_L(0); PG8_BAR; PG8_MMA(0, 0, At, B0); PG8_MMA(0, 1, At, B1); PG8_BAR; PG8_SCHED;
            PG8_LDA(At, 0, 1); PG8_STAGE(PG8_SB(0, 0), b2, voffB); PG8_STAGE(PG8_SB(0, 1), b2 + hstep, voffB); PG8_STAGE(PG8_SA(0, 0), a2, voffA);
            PG8_WAIT_V(8); PG8_WAIT_L(0); PG8_BAR; PG8_MMA(1, 0, At, B0); PG8_MMA(1, 1, At, B1); PG8_BAR; PG8_SCHED;
            PG8_LDB(B0, 1, 0); PG8_LDB(B1, 1, 1); PG8_SCHED; PG8_LDA(At, 1, 0); PG8_STAGE(PG8_SA(0, 1), a2 + hstep, voffA);
            PG8_WAIT_V(8); PG8_WAIT_L(0); PG8_BAR; PG8_MMA(0, 0, At, B0); PG8_MMA(0, 1, At, B1); PG8_BAR; PG8_SCHED;
            PG8_LDA(At, 1, 1); PG8_STAGE(PG8_SB(1, 0), b3, voffB); PG8_STAGE(PG8_SB(1, 1), b3 + hstep, voffB); PG8_STAGE(PG8_SA(1, 0), a3, voffA);
            PG8_WAIT_V(8); PG8_WAIT_L(0); PG8_BAR; PG8_MMA(1, 0, At, B0); PG8_MMA(1, 1, At, B1); PG8_BAR; PG8_SCHED;
            } else {
            PG8_LDB(B0, 0, 0); PG8_SCHED; PG8_LDA(At, 0, 0); PG8_STAGE(PG8_SA(1, 1), a1 + hstep, voffA);
            PG8_WAIT_L(8); PG8_BAR; PG8_WAIT_L(0); PG8_MMA(0, 0, At, B0); PG8_BAR; PG8_SCHED;
            PG8_LDB(B1, 0, 1); PG8_STAGE(PG8_SB(0, 0), b2, voffB);
            PG8_BAR; PG8_WAIT_L(0); PG8_MMA(0, 1, At, B1); PG8_BAR;
            PG8_LDA(At, 0, 1); PG8_STAGE(PG8_SA(0, 0), a2, voffA);
            PG8_BAR; PG8_WAIT_L(0); PG8_MMA(1, 0, At, B0); PG8_BAR; PG8_SCHED;
            PG8_STAGE(PG8_SB(0, 1), b2 + hstep, voffB);
            PG8_WAIT_V(6); PG8_BAR; PG8_MMA(1, 1, At, B1); PG8_BAR;
            PG8_LDB(B0, 1, 0); PG8_SCHED; PG8_LDA(At, 1, 0); PG8_STAGE(PG8_SA(0, 1), a2 + hstep, voffA);
            PG8_WAIT_L(8); PG8_BAR; PG8_WAIT_L(0); PG8_MMA(0, 0, At, B0); PG8_BAR; PG8_SCHED;
            PG8_LDB(B1, 1, 1); PG8_STAGE(PG8_SB(1, 0), b3, voffB);
            PG8_BAR; PG8_WAIT_L(0); PG8_MMA(0, 1, At, B1); PG8_BAR;
            PG8_LDA(At, 1, 1); PG8_STAGE(PG8_SA(1, 0), a3, voffA);
            PG8_BAR; PG8_WAIT_L(0); PG8_MMA(1, 0, At, B0); PG8_BAR; PG8_SCHED;
            PG8_STAGE(PG8_SB(1, 1), b3 + hstep, voffB);
            PG8_WAIT_V(6); PG8_BAR; PG8_MMA(1, 1, At, B1); PG8_BAR;
            }
        }
        if constexpr (ALIGN_EPI) { if (wr == 0) PG8_BAR; }
        if constexpr (!Epi::AFTER_DRAIN) { E(acc, cur, wr, wc, fr, fq); S.done(cur); }
        if (!has_next) break;
#pragma unroll
        for (int a = 0; a < 2; ++a)
#pragma unroll
            for (int b = 0; b < 2; ++b)
#pragma unroll
                for (int m = 0; m < 4; ++m)
#pragma unroll
                    for (int n = 0; n < 2; ++n) acc[a][b][m][n] = (f32x4){0.f, 0.f, 0.f, 0.f};
        cur = nxt; cA = nA; cB = nB; ++ui;
        if constexpr (ALIGN_EPI) { if (wr == 1) PG8_BAR; }
    }
    PG8_WAIT_V(0);
    if constexpr (!ALIGN_EPI) { if (wr == 0) PG8_BAR; }
    PG8_BAR;
    if constexpr (Epi::AFTER_DRAIN) { E.fused(acc, cur, wr, wc, fr, fq, lds, wid, lane); S.done(cur); }
#undef PG8_SA
#undef PG8_SB
#undef PG8_STAGE
#undef PG8_LDA
#undef PG8_LDB
#undef PG8_MMA
#undef PG8_WAIT_V
#undef PG8_WAIT_L
#undef PG8_BAR
#undef PG8_SCHED
}
}

namespace pg8 {
__device__ __forceinline__ u32x4 pack8(const f32x4 a, const f32x4 b) { u32x4 w; w.x = cvt_pk_bf16(a[0], a[1]); w.y = cvt_pk_bf16(a[2], a[3]); w.z = cvt_pk_bf16(b[0], b[1]); w.w = cvt_pk_bf16(b[2], b[3]); return w; }

template <bool RAW> struct EpiInProjT {
    static constexpr bool PERM = true, AFTER_DRAIN = false;
    bf16_t *HQ, *K1, *HI, *HG, *CQ, *CKV, *KR, *GA, *GB; const float* lbl; const float* rope;
    __device__ __forceinline__ void operator()(const f32x4 (&acc)[2][2][4][2], const Unit& u, int wr, int wc, int fr_, int fq_) const {
        int fr = fr_, fq = fq_; asm volatile("" : "+v"(fr), "+v"(fq));
#pragma unroll
        for (int bj = 0; bj < 2; ++bj) {
            const int c = u.pn * BM + bj * HALF + wc * 32 + 8 * fq;
            if (c >= N1V) continue;
            int seg, cc;
            if (c < 4096) { seg = c >> 10; cc = c & 1023; }
            else if (c < 4480) { seg = 4; cc = c - 4096; }
            else if (c < 4736) { seg = 5; cc = c - 4480; }
            else { seg = 6; cc = c - 4736; }
            float oml[8];
            if (seg == 1 && !RAW) {
#pragma unroll
                for (int j = 0; j < 8; ++j) { const float l0 = lbl[cc + j], l1 = lbl[1024 + cc + j]; oml[j] = 1.0f - __builtin_amdgcn_rcpf(1.0f + __expf(l1 - l0)); }
            }
#pragma unroll
            for (int ai = 0; ai < 2; ++ai)
#pragma unroll
                for (int m = 0; m < 4; ++m) {
                    const int Rc = u.pm * BM + ai * HALF + wr * 64 + m * 16 + fr;
                    const int b = Rc / PV, p = NPADR + (Rc - b * PV); const int R = b * PP + p; const bool real = p >= LEAD; const size_t rr = (size_t)b * SEQ + (p - LEAD);
                    f32x4 v0 = acc[ai][bj][m][0], v1 = acc[ai][bj][m][1];
                    if (RAW && seg != 0 && seg != 2 && seg != 5) { if (seg == 1) *(u32x4*)(K1 + (size_t)R * DM + cc) = pack8(v0, v1); else if (seg == 6) *(u32x4*)(KR + (size_t)R * ROPE + cc) = pack8(v0, v1); else if (real) { if (seg == 3) *(u32x4*)(HG + rr * DM + cc) = pack8(v0, v1); else if (seg == 4) *(u32x4*)(CQ + rr * QR + cc) = pack8(v0, v1); else *(u32x4*)((seg == 7 ? GA : GB) + rr * DM + cc) = pack8(v0, v1); } }
                    else if (seg == 0) { *(u32x4*)(HQ + (size_t)R * DM + cc) = pack8(v0, v1); }
                    else if (seg == 1) {
#pragma unroll
                        for (int j = 0; j < 4; ++j) { v0[j] = oml[j] * __builtin_amdgcn_rcpf(1.0f + __expf(v0[j])); v1[j] = oml[4 + j] * __builtin_amdgcn_rcpf(1.0f + __expf(v1[j])); }
                        *(u32x4*)(K1 + (size_t)R * DM + cc) = pack8(v0, v1); }
                    else if (seg == 2) { *(u32x4*)(HI + (size_t)R * DM + cc) = pack8(v0, v1); }
                    else if (seg == 3) { if (real) {
#pragma unroll
                        for (int j = 0; j < 4; ++j) { v0[j] = v0[j] * __builtin_amdgcn_rcpf(1.0f + __expf(-v0[j])); v1[j] = v1[j] * __builtin_amdgcn_rcpf(1.0f + __expf(-v1[j])); }
                        *(u32x4*)(HG + rr * DM + cc) = pack8(v0, v1); } }
                    else if (seg == 4) { if (real) *(u32x4*)(CQ + rr * QR + cc) = pack8(v0, v1); }
                    else if (seg == 5) { *(u32x4*)(CKV + (size_t)R * KVR + cc) = pack8(v0, v1); }
                    else if (seg == 6) {
                        const f32x4* tp = (const f32x4*)(rope + ((size_t)p * 32 + (cc >> 1)) * 2);
                        const f32x4 t0 = tp[0], t1 = tp[1];
                        f32x4 o0, o1;
                        o0[0] = v0[0] * t0[0] - v0[1] * t0[1]; o0[1] = v0[1] * t0[0] + v0[0] * t0[1];
                        o0[2] = v0[2] * t0[2] - v0[3] * t0[3]; o0[3] = v0[3] * t0[2] + v0[2] * t0[3];
                        o1[0] = v1[0] * t1[0] - v1[1] * t1[1]; o1[1] = v1[1] * t1[0] + v1[0] * t1[1];
                        o1[2] = v1[2] * t1[2] - v1[3] * t1[3]; o1[3] = v1[3] * t1[2] + v1[2] * t1[3];
                        *(u32x4*)(KR + (size_t)R * ROPE + cc) = pack8(o0, o1); }
                    else { if (real) {
#pragma unroll
                        for (int j = 0; j < 4; ++j) { v0[j] = __builtin_amdgcn_rcpf(1.0f + __expf(-v0[j])); v1[j] = __builtin_amdgcn_rcpf(1.0f + __expf(-v1[j])); }
                        *(u32x4*)((seg == 7 ? GA : GB) + rr * DM + cc) = pack8(v0, v1); } }
                }
        }
    }
};

typedef EpiInProjT<false> EpiInProj;


struct EpiGates {
    static constexpr bool PERM = true, AFTER_DRAIN = false;
    bf16_t *GA, *GB;
    __device__ __forceinline__ void operator()(const f32x4 (&acc)[2][2][4][2], const Unit& u, int wr, int wc, int fr_, int fq_) const {
        int fr = fr_, fq = fq_; asm volatile("" : "+v"(fr), "+v"(fq));
#pragma unroll
        for (int bj = 0; bj < 2; ++bj) { const int c = u.pn * BM + bj * HALF + wc * 32 + 8 * fq; bf16_t* dst = (c < 1024 ? GA : GB) + (c & 1023);
#pragma unroll
            for (int ai = 0; ai < 2; ++ai)
#pragma unroll
                for (int m = 0; m < 4; ++m) { const size_t rr = (size_t)(u.pm * BM + ai * HALF + wr * 64 + m * 16 + fr);
                    f32x4 v0 = acc[ai][bj][m][0], v1 = acc[ai][bj][m][1];
#pragma unroll
                    for (int j = 0; j < 4; ++j) { v0[j] = __builtin_amdgcn_rcpf(1.0f + __expf(-v0[j])); v1[j] = __builtin_amdgcn_rcpf(1.0f + __expf(-v1[j])); }
                    *(u32x4*)(dst + rr * DM) = pack8(v0, v1); } }
    }
};

struct EpiQ {
    static constexpr bool PERM = true, AFTER_DRAIN = false;
    bf16_t* Q; const float* rq; const float* rope; int row_base;
    __device__ __forceinline__ void operator()(const f32x4 (&acc)[2][2][4][2], const Unit& u, int wr, int wc, int fr_, int fq_) const {
        int fr = fr_, fq = fq_; asm volatile("" : "+v"(fr), "+v"(fq));
        float sc[8];
#pragma unroll
        for (int i = 0; i < 8; ++i) sc[i] = rq[row_base + u.pm * BM + (i >> 2) * HALF + wr * 64 + (i & 3) * 16 + fr];
#pragma unroll
        for (int bj = 0; bj < 2; ++bj) {
            const int c = u.pn * BM + bj * HALF + wc * 32 + 8 * fq; const int hc = c % QKD; const bool isr = hc >= 128; const int pi = (hc - 128) >> 1;
#pragma unroll
            for (int ai = 0; ai < 2; ++ai) {
                f32x4 t0[4], t1[4];
                if (isr) {
#pragma unroll
                    for (int m = 0; m < 4; ++m) { const int rr = row_base + u.pm * BM + ai * HALF + wr * 64 + m * 16 + fr; const int p = LEAD + (rr & (SEQ - 1));
                        const f32x4* tp = (const f32x4*)(rope + ((size_t)p * 32 + pi) * 2); t0[m] = tp[0]; t1[m] = tp[1]; }
                }
#pragma unroll
                for (int m = 0; m < 4; ++m) {
                    const int rl = u.pm * BM + ai * HALF + wr * 64 + m * 16 + fr; const float s = sc[ai * 4 + m];
                    f32x4 v0 = acc[ai][bj][m][0] * s, v1 = acc[ai][bj][m][1] * s;
                    if (isr) {
                        f32x4 o0, o1;
                        o0[0] = v0[0] * t0[m][0] - v0[1] * t0[m][1]; o0[1] = v0[1] * t0[m][0] + v0[0] * t0[m][1];
                        o0[2] = v0[2] * t0[m][2] - v0[3] * t0[m][3]; o0[3] = v0[3] * t0[m][2] + v0[2] * t0[m][3];
                        o1[0] = v1[0] * t1[m][0] - v1[1] * t1[m][1]; o1[1] = v1[1] * t1[m][0] + v1[0] * t1[m][1];
                        o1[2] = v1[2] * t1[m][2] - v1[3] * t1[m][3]; o1[3] = v1[3] * t1[m][2] + v1[2] * t1[m][3];
                        v0 = o0; v1 = o1;
                    }
                    *(u32x4*)(Q + (size_t)rl * 3072 + c) = pack8(v0, v1);
                }
            }
        }
    }
};
struct EpiScaleBf16 {
    static constexpr bool PERM = true, AFTER_DRAIN = false;
    bf16_t* O; int ldc; const float* rs; int row_base;
    __device__ __forceinline__ void operator()(const f32x4 (&acc)[2][2][4][2], const Unit& u, int wr, int wc, int fr_, int fq_) const {
        int fr = fr_, fq = fq_; asm volatile("" : "+v"(fr), "+v"(fq));
        float sc[8];
#pragma unroll
        for (int i = 0; i < 8; ++i) sc[i] = rs ? rs[row_base + u.pm * BM + (i >> 2) * HALF + wr * 64 + (i & 3) * 16 + fr] : 1.0f;
#pragma unroll
        for (int ai = 0; ai < 2; ++ai)
#pragma unroll
            for (int m = 0; m < 4; ++m) {
                const int rl = u.pm * BM + ai * HALF + wr * 64 + m * 16 + fr; const float s = sc[ai * 4 + m];
#pragma unroll
                for (int bj = 0; bj < 2; ++bj) { const int c = u.pn * BM + bj * HALF + wc * 32 + 8 * fq;
                    *(u32x4*)(O + (size_t)rl * ldc + c) = pack8(acc[ai][bj][m][0] * s, acc[ai][bj][m][1] * s); }
            }
    }
};
template <bool ACCUM> struct EpiGate {
    static constexpr bool PERM = true, AFTER_DRAIN = false;
    bf16_t* X; const bf16_t* G;
    __device__ __forceinline__ void operator()(const f32x4 (&acc)[2][2][4][2], const Unit& u, int wr, int wc, int fr_, int fq_) const {
        int fr = fr_, fq = fq_; asm volatile("" : "+v"(fr), "+v"(fq));
#pragma unroll
        for (int ai = 0; ai < 2; ++ai)
#pragma unroll
            for (int mh = 0; mh < 2; ++mh) {
                u32x4 g[2][2], x[2][2];
#pragma unroll
                for (int mm = 0; mm < 2; ++mm) { const size_t rl = (size_t)(u.pm * BM + ai * HALF + wr * 64 + (mh * 2 + mm) * 16 + fr);
#pragma unroll
                    for (int bj = 0; bj < 2; ++bj) { const int c = u.pn * BM + bj * HALF + wc * 32 + 8 * fq; g[mm][bj] = *(const u32x4*)(G + rl * DM + c); if (ACCUM) x[mm][bj] = *(const u32x4*)(X + rl * DM + c); } }
#pragma unroll
                for (int mm = 0; mm < 2; ++mm) { const int m = mh * 2 + mm; const size_t rl = (size_t)(u.pm * BM + ai * HALF + wr * 64 + m * 16 + fr);
#pragma unroll
                    for (int bj = 0; bj < 2; ++bj) { const int c = u.pn * BM + bj * HALF + wc * 32 + 8 * fq; const u32x4 gg = g[mm][bj];
                        f32x4 v0 = acc[ai][bj][m][0], v1 = acc[ai][bj][m][1];
                        v0[0] *= bflo(gg.x); v0[1] *= bfhi(gg.x); v0[2] *= bflo(gg.y); v0[3] *= bfhi(gg.y);
                        v1[0] *= bflo(gg.z); v1[1] *= bfhi(gg.z); v1[2] *= bflo(gg.w); v1[3] *= bfhi(gg.w);
                        if (ACCUM) { const u32x4 xx = x[mm][bj];
                            v0[0] += bflo(xx.x); v0[1] += bfhi(xx.x); v0[2] += bflo(xx.y); v0[3] += bfhi(xx.y);
                            v1[0] += bflo(xx.z); v1[1] += bfhi(xx.z); v1[2] += bflo(xx.w); v1[3] += bfhi(xx.w); }
                        *(u32x4*)(X + rl * DM + c) = pack8(v0, v1); } }
            }
    }
};
struct EpiResF32 {
    static constexpr bool PERM = false, AFTER_DRAIN = false;
    float* Y; const float* base; float alpha;
    __device__ __forceinline__ void operator()(const f32x4 (&acc)[2][2][4][2], const Unit& u, int wr, int wc, int fr_, int fq_) const {
        int fr = fr_, fq = fq_; asm volatile("" : "+v"(fr), "+v"(fq));
        const int col0 = u.pn * BM + wc * 32 + 4 * fq;
#pragma unroll
        for (int ai = 0; ai < 2; ++ai)
#pragma unroll
            for (int mh = 0; mh < 2; ++mh) {
                f32x4 bs[2][2][2];
#pragma unroll
                for (int mm = 0; mm < 2; ++mm) { const size_t off = (size_t)(u.pm * BM + ai * HALF + wr * 64 + (mh * 2 + mm) * 16 + fr) * DM + col0;
#pragma unroll
                    for (int bj = 0; bj < 2; ++bj)
#pragma unroll
                        for (int n = 0; n < 2; ++n) bs[mm][bj][n] = *(const f32x4*)(base + off + bj * HALF + n * 16); }
#pragma unroll
                for (int mm = 0; mm < 2; ++mm) { const int m = mh * 2 + mm; const size_t off = (size_t)(u.pm * BM + ai * HALF + wr * 64 + m * 16 + fr) * DM + col0;
#pragma unroll
                    for (int bj = 0; bj < 2; ++bj)
#pragma unroll
                        for (int n = 0; n < 2; ++n) *(f32x4*)(Y + off + bj * HALF + n * 16) = bs[mm][bj][n] * alpha + acc[ai][bj][m][n]; }
            }
    }
};

struct EpiNoStore {
    static constexpr bool PERM = true, AFTER_DRAIN = false;
    bf16_t* O; int flag;
    __device__ __forceinline__ void operator()(const f32x4 (&acc)[2][2][4][2], const Unit& u, int wr, int wc, int fr, int fq) const {
        f32x4 s = {0.f, 0.f, 0.f, 0.f};
#pragma unroll
        for (int ai = 0; ai < 2; ++ai)
#pragma unroll
            for (int bj = 0; bj < 2; ++bj)
#pragma unroll
                for (int m = 0; m < 4; ++m) { s += acc[ai][bj][m][0]; s += acc[ai][bj][m][1]; }
        if (flag) *(f32x4*)(O + (size_t)(u.pm * 256 + fr) * 64 + fq * 8) = s;
    }
};
}

namespace attn {
using bf16x8 = __attribute__((ext_vector_type(8))) short;
using u32x4 = __attribute__((ext_vector_type(4))) unsigned;
constexpr float SCALE = 0.07216878364870322f;
constexpr float THR = 8.f;
constexpr int SHM_V = 16384, SHM_K = 16384, SHM_R = 8192;
constexpr int OFF_V = 0, OFF_K = 2 * SHM_V, OFF_R = OFF_K + 2 * SHM_K, OFF_WS = OFF_R + 2 * SHM_R, LDS_USED = OFF_WS + 8 * 64 * 4;
#define KSWZ(row, colB) ((row) * 256 + ((colB) ^ (((row) & 7) << 4)))
#define RSWZ(row, colB) ((row) * 128 + ((colB) ^ (((row) & 7) << 4)))
#define SBAR() __builtin_amdgcn_sched_barrier(0)
__device__ __forceinline__ int crow(int r, int hi) { return (r & 3) + 8 * (r >> 2) + 4 * hi; }
__device__ __forceinline__ unsigned cvtpk(float lo, float hi) { unsigned r; asm volatile("v_cvt_pk_bf16_f32 %0, %1, %2" : "=v"(r) : "v"(lo), "v"(hi)); return r; }
__device__ __forceinline__ bf16x8 ld8(const bf16* p) { return *reinterpret_cast<const bf16x8*>(p); }

__device__ __forceinline__ void partialSM(f32x16& p0, f32x16& p1, float& m_reg, float& mn, float& alpha) {
  constexpr float C = SCALE * 1.4426950408889634f;
  float pmax = p0[0];
#pragma unroll
  for (int r = 1; r < 16; ++r) pmax = fmaxf(pmax, p0[r]);
#pragma unroll
  for (int r = 0; r < 16; ++r) pmax = fmaxf(pmax, p1[r]);
  { auto rr = __builtin_amdgcn_permlane32_swap(__float_as_uint(pmax), __float_as_uint(pmax), false, false);
    pmax = fmaxf(__uint_as_float(rr[0]), __uint_as_float(rr[1])); }
  if (__builtin_expect(__all(pmax - m_reg <= THR / SCALE), 1)) { mn = m_reg; alpha = 1.f; }
  else { mn = fmaxf(m_reg, pmax); alpha = __builtin_amdgcn_exp2f((m_reg - mn) * C); m_reg = mn; }
  float mnC = -mn * C;
#pragma unroll
  for (int r = 0; r < 16; ++r) p0[r] = fmaf(p0[r], C, mnC);
#pragma unroll
  for (int r = 0; r < 16; ++r) p1[r] = fmaf(p1[r], C, mnC);
#pragma unroll
  for (int r = 0; r < 16; ++r) p0[r] = __builtin_amdgcn_exp2f(p0[r]);
}
__device__ __forceinline__ void finishSM(f32x16& p0, f32x16& p1, float alpha, float& l_reg, bf16x8& pa0, bf16x8& pa1, bf16x8& pa2, bf16x8& pa3) {
#pragma unroll
  for (int r = 0; r < 16; ++r) p1[r] = __builtin_amdgcn_exp2f(p1[r]);
  float ps = 0;
#pragma unroll
  for (int r = 0; r < 16; ++r) ps += p0[r];
#pragma unroll
  for (int r = 0; r < 16; ++r) ps += p1[r];
  { auto rr = __builtin_amdgcn_permlane32_swap(__float_as_uint(ps), __float_as_uint(ps), false, false);
    ps = __uint_as_float(rr[0]) + __uint_as_float(rr[1]); }
  l_reg = l_reg * alpha + ps;
#define PK4(P, BASE, OUT) do { unsigned a0 = cvtpk(P[BASE + 0], P[BASE + 1]), a1 = cvtpk(P[BASE + 2], P[BASE + 3]);   \
    unsigned b0 = cvtpk(P[BASE + 4], P[BASE + 5]), b1 = cvtpk(P[BASE + 6], P[BASE + 7]);                              \
    auto r0 = __builtin_amdgcn_permlane32_swap(a0, b0, false, false); auto r1 = __builtin_amdgcn_permlane32_swap(a1, b1, false, false); \
    u32x4 w = {r0[0], r1[0], r0[1], r1[1]}; OUT = *reinterpret_cast<bf16x8*>(&w); } while (0)
  PK4(p0, 0, pa0); PK4(p0, 8, pa1); PK4(p1, 0, pa2); PK4(p1, 8, pa3);
#undef PK4
}
__device__ __forceinline__ void qkt(f32x16& p0, f32x16& p1, const char* Ks, const char* Rs, const bf16x8* qr, int r32, int hi) {
  p0 = f32x16{}; p1 = f32x16{};
#pragma unroll
  for (int d0 = 0; d0 < 8; ++d0) { int cb = (d0 * 16 + hi * 8) * 2;
    bf16x8 b0 = *reinterpret_cast<const bf16x8*>(Ks + KSWZ(r32, cb));
    bf16x8 b1 = *reinterpret_cast<const bf16x8*>(Ks + KSWZ(32 + r32, cb));
    p0 = __builtin_amdgcn_mfma_f32_32x32x16_bf16(b0, qr[d0], p0, 0, 0, 0);
    p1 = __builtin_amdgcn_mfma_f32_32x32x16_bf16(b1, qr[d0], p1, 0, 0, 0); }
#pragma unroll
  for (int d0 = 0; d0 < 4; ++d0) { int cb = (d0 * 16 + hi * 8) * 2;
    bf16x8 b0 = *reinterpret_cast<const bf16x8*>(Rs + RSWZ(r32, cb));
    bf16x8 b1 = *reinterpret_cast<const bf16x8*>(Rs + RSWZ(32 + r32, cb));
    p0 = __builtin_amdgcn_mfma_f32_32x32x16_bf16(b0, qr[8 + d0], p0, 0, 0, 0);
    p1 = __builtin_amdgcn_mfma_f32_32x32x16_bf16(b1, qr[8 + d0], p1, 0, 0, 0); }
}
__device__ __forceinline__ void amask(f32x16& p0, f32x16& p1, int t, int NT, int qrel, int hi) {
  const float NEG = -INFINITY;
  if (t == 0) {
#pragma unroll
    for (int r = 0; r < 16; ++r) p0[r] = NEG;
#pragma unroll
    for (int r = 0; r < 8; ++r) p1[r] = NEG;
  } else if (t >= NT - 4) {
    const int d = qrel - 64 * (t - (NT - 4)) - 4 * hi;
#pragma unroll
    for (int r = 0; r < 16; ++r) { if ((r & 3) + 8 * (r >> 2) > d) p0[r] = NEG; if ((r & 3) + 8 * (r >> 2) + 32 > d) p1[r] = NEG; }
  }
}
__device__ __forceinline__ int v_st(int k, int c) { const int kk = (k & ~0xC) | ((k & 4) << 1) | ((k & 8) >> 1); return ((kk >> 3) * 4 + (c >> 5)) * 512 + ((kk & 7) * 32 + (c & 31)) * 2; }
__device__ __forceinline__ int v_rd_base(int lane) { return ((lane & 3) << 3) | (((lane >> 2) & 3) << 6) | (((lane >> 4) & 1) << 5) | (((lane >> 5) & 1) << 8); }
constexpr int v_rd_off(int d0, int ks, int half) { return d0 * 512 + ks * 4096 + half * 2048; }
template <int OFF> __device__ __forceinline__ s16x4 tr_read(int vb) {
  s16x4 r; asm volatile("ds_read_b64_tr_b16 %0, %1 offset:%2" : "=&v"(r) : "v"(vb), "i"(OFF) : "memory"); return r;
}
template <int D0> __device__ __forceinline__ void pv_one(f32x16& od, int vb, bf16x8 pa0, bf16x8 pa1, bf16x8 pa2, bf16x8 pa3) {
  const s16x4 l0 = tr_read<v_rd_off(D0, 0, 0)>(vb), h0 = tr_read<v_rd_off(D0, 0, 1)>(vb), l1 = tr_read<v_rd_off(D0, 1, 0)>(vb), h1 = tr_read<v_rd_off(D0, 1, 1)>(vb);
  const s16x4 l2 = tr_read<v_rd_off(D0, 2, 0)>(vb), h2 = tr_read<v_rd_off(D0, 2, 1)>(vb), l3 = tr_read<v_rd_off(D0, 3, 0)>(vb), h3 = tr_read<v_rd_off(D0, 3, 1)>(vb);
  asm volatile("s_waitcnt lgkmcnt(0)" ::: "memory"); SBAR();
#define PK(L, H) (bf16x8){L[0], L[1], L[2], L[3], H[0], H[1], H[2], H[3]}
  od = __builtin_amdgcn_mfma_f32_32x32x16_bf16(pa0, PK(l0, h0), od, 0, 0, 0);
  od = __builtin_amdgcn_mfma_f32_32x32x16_bf16(pa1, PK(l1, h1), od, 0, 0, 0);
  od = __builtin_amdgcn_mfma_f32_32x32x16_bf16(pa2, PK(l2, h2), od, 0, 0, 0);
  od = __builtin_amdgcn_mfma_f32_32x32x16_bf16(pa3, PK(l3, h3), od, 0, 0, 0);
#undef PK
}
__device__ __forceinline__ void pv_d0(f32x16* o, int vb, bf16x8 pa0, bf16x8 pa1, bf16x8 pa2, bf16x8 pa3) {
  pv_one<0>(o[0], vb, pa0, pa1, pa2, pa3); pv_one<1>(o[1], vb, pa0, pa1, pa2, pa3); pv_one<2>(o[2], vb, pa0, pa1, pa2, pa3); pv_one<3>(o[3], vb, pa0, pa1, pa2, pa3);
}

__device__ __forceinline__ void attn_unit(const bf16* __restrict__ Qb, const bf16* __restrict__ Kh, const bf16* __restrict__ Rh, bf16* __restrict__ Ob, int NT, char* lds) {
  int tid_ = threadIdx.x; asm volatile("" : "+v"(tid_));
  const int tid = tid_, wid = tid >> 6, lane = tid & 63, r32 = lane & 31, hi = lane >> 5;
  const bf16* Vh = Kh + 128;
  char* V_lds = lds + OFF_V; char* K_lds = lds + OFF_K; char* R_lds = lds + OFF_R;
  float* ws = (float*)(lds + OFF_WS) + wid * 64; float* li_l = ws; float* al_l = ws + 32;
  float m_reg = -1e30f, l_reg = 0; f32x16 o[4] = {}; bf16x8 qr[12];
  const bf16* Qw = Qb + (long)(wid * 32 + r32) * 3072 + hi * 8;
#pragma unroll
  for (int d0 = 0; d0 < 12; ++d0) qr[d0] = ld8(Qw + d0 * 16);
  const int sr = tid >> 4, sc = (tid & 15) * 8, vst0 = v_st(sr, sc), vst1 = v_st(32 + sr, sc);
  const int rrow = tid >> 3, rcol = (tid & 7) * 8;
  const int vb0 = (int)(uintptr_t)V_lds + v_rd_base(lane);
  const int qrel = wid * 32 + r32;
  bf16x8 vs0, vs1, ks0, ks1, rs0;
#define SLOAD(k0) do { vs0 = ld8(&Vh[(long)((k0) + sr) * 4096 + sc]); vs1 = ld8(&Vh[(long)((k0) + 32 + sr) * 4096 + sc]); \
    ks0 = ld8(&Kh[(long)((k0) + sr) * 4096 + sc]); ks1 = ld8(&Kh[(long)((k0) + 32 + sr) * 4096 + sc]); rs0 = ld8(&Rh[(long)((k0) + rrow) * 64 + rcol]); } while (0)
#define SWRITE(b) do { *(bf16x8*)(V_lds + (b) * SHM_V + vst0) = vs0; *(bf16x8*)(V_lds + (b) * SHM_V + vst1) = vs1; const int kc = sc * 2; \
    *(bf16x8*)(K_lds + (b) * SHM_K + KSWZ(sr, kc)) = ks0; *(bf16x8*)(K_lds + (b) * SHM_K + KSWZ(32 + sr, kc)) = ks1; \
    *(bf16x8*)(R_lds + (b) * SHM_R + RSWZ(rrow, rcol * 2)) = rs0; } while (0)
#define SWAIT() asm volatile("s_waitcnt vmcnt(0)" ::: "memory")
#define RESC(a) do { if (__any((a) < 1.f)) { if (hi == 0) al_l[r32] = (a); asm volatile("s_waitcnt lgkmcnt(0)" ::: "memory"); \
    _Pragma("unroll") for (int d = 0; d < 4; ++d) _Pragma("unroll") for (int r = 0; r < 16; ++r) o[d][r] *= al_l[crow(r, hi)]; } } while (0)
  f32x16 pA0, pA1, pB0, pB1; float mnA, mnB, alA, alB; bf16x8 pa0, pa1, pa2, pa3;
  SLOAD(0); SWAIT(); SWRITE(0); __syncthreads();
  qkt(pA0, pA1, K_lds, R_lds, qr, r32, hi); amask(pA0, pA1, 0, NT, qrel, hi); partialSM(pA0, pA1, m_reg, mnA, alA);
  SLOAD(64); SWAIT(); SWRITE(1); __syncthreads();
  for (int j = 1; j + 1 < NT; j += 2) {
    SBAR(); qkt(pB0, pB1, K_lds + SHM_K, R_lds + SHM_R, qr, r32, hi); amask(pB0, pB1, j, NT, qrel, hi);
    finishSM(pA0, pA1, alA, l_reg, pa0, pa1, pa2, pa3); SBAR();
    SLOAD((j + 1) * 64); SBAR();
    pv_d0(o, vb0, pa0, pa1, pa2, pa3); partialSM(pB0, pB1, m_reg, mnB, alB);
    __syncthreads(); SWAIT(); SWRITE(0);
    RESC(alB); __syncthreads();
    SBAR(); qkt(pA0, pA1, K_lds, R_lds, qr, r32, hi); amask(pA0, pA1, j + 1, NT, qrel, hi);
    finishSM(pB0, pB1, alB, l_reg, pa0, pa1, pa2, pa3); SBAR();
    const bool more = (j + 2 < NT);
    if (more) SLOAD((j + 2) * 64);
    SBAR();
    pv_d0(o, vb0 + SHM_V, pa0, pa1, pa2, pa3); partialSM(pA0, pA1, m_reg, mnA, alA);
    __syncthreads(); SWAIT(); if (more) SWRITE(1);
    RESC(alA); __syncthreads();
  }
  finishSM(pA0, pA1, alA, l_reg, pa0, pa1, pa2, pa3); SBAR();
  pv_d0(o, vb0, pa0, pa1, pa2, pa3);
  if (hi == 0) li_l[r32] = l_reg; asm volatile("s_waitcnt lgkmcnt(0)" ::: "memory");
  float rli[16];
#pragma unroll
  for (int r = 0; r < 16; ++r) rli[r] = __builtin_amdgcn_rcpf(li_l[crow(r, hi)]);
  __syncthreads();
  { unsigned short* stg = (unsigned short*)(lds + wid * 8192);
#pragma unroll
    for (int r = 0; r < 16; ++r) { const int orow = crow(r, hi);
#pragma unroll
      for (int d0 = 0; d0 < 4; ++d0) stg[orow * 128 + d0 * 32 + r32] = (unsigned short)f2bf(o[d0][r] * rli[r]); }
    asm volatile("s_waitcnt lgkmcnt(0)" ::: "memory");
#pragma unroll
    for (int i = 0; i < 8; ++i) { const int row = i * 4 + (lane >> 4), ch = lane & 15;
      const u32x4 v = *(const u32x4*)(stg + row * 128 + ch * 8); *(u32x4*)(Ob + (long)(wid * 32 + row) * 2048 + ch * 8) = v; } }
  __syncthreads();
#undef SLOAD
#undef SWRITE
#undef SWAIT
#undef RESC
}
#undef KSWZ
#undef RSWZ
#undef SBAR
}


struct Params {
    const float* in[20];
    float* out; unsigned char* ws;
    int ph_lo, ph_hi;
};
enum { I_X = 0, I_META, I_LBL, I_WIN, I_QG, I_KVG, I_WUQ, I_WUKV, I_HGG, I_WPH, I_WPM, I_WO, I_LN1G, I_LN1B, I_PQ, I_SK, I_PU, I_PV, I_LN2G, I_LN2B };

struct Ctx { LAS unsigned char* lds; int tid, lane, wave, G, bid, vcu; };

template <class CM> __device__ __forceinline__ void transpose_w(const float* __restrict__ W, int K, int N, int NP, bf16* __restrict__ WT, const float* __restrict__ ks, LAS float* scr, int gw, int NGW, int lane, CM cm) {
    const int nblk = NP / 32, items = (K / 64) * nblk;
    for (int it = gw; it < items; it += NGW) {
        const int kb = it / nblk, nb = it % nblk, k0 = 64 * kb, n0 = 32 * nb;
        const int scol = cm(n0 + (lane & 31));
#pragma unroll 16
        for (int i = 0; i < 32; ++i) { const int kk = 2 * i + (lane >> 5); float v = scol >= 0 ? W[(size_t)(k0 + kk) * N + scol] : 0.f; if (ks) v *= ks[k0 + kk]; scr[kk * 33 + (lane & 31)] = v; }
        asm volatile("s_waitcnt lgkmcnt(0)" ::: "memory");
        const int c = lane & 7;
#pragma unroll
        for (int j = 0; j < 4; ++j) { const int n = (lane >> 3) + 8 * j; const LAS float* s = scr + (8 * c) * 33 + n;
            v4u o; o.x = pk2(s[0 * 33], s[1 * 33]); o.y = pk2(s[2 * 33], s[3 * 33]); o.z = pk2(s[4 * 33], s[5 * 33]); o.w = pk2(s[6 * 33], s[7 * 33]);
            *(v4u*)(WT + (size_t)(n0 + n) * K + k0 + 8 * c) = o; }
        asm volatile("s_waitcnt lgkmcnt(0)" ::: "memory");
    }
}
__device__ __forceinline__ int rope_src(int j) { return (j & 1) ? 32 + (j >> 1) : (j >> 1); }

__device__ __forceinline__ void cvt_rows(const float* __restrict__ src, bf16* __restrict__ dst, size_t n8, size_t gt, size_t NGT) {
    for (size_t i = gt; i < n8; i += NGT) { const pg8::f32x4 a = *(const pg8::f32x4*)(src + i * 8), b = *(const pg8::f32x4*)(src + i * 8 + 4);
        v4u o; o.x = pk2(a[0], a[1]); o.y = pk2(a[2], a[3]); o.z = pk2(b[0], b[1]); o.w = pk2(b[2], b[3]); *(v4u*)(dst + i * 8) = o; }
}


__device__ __forceinline__ void late_weights(const Params& P, const Ctx& C, int gw, int NGW, size_t gt, size_t NGT, int part  ) {
    LAS float* scr = (LAS float*)(C.lds + C.wave * 16384);
    unsigned char* ws = P.ws;
#define ROT(k) ((gw + (k) * (NGW / 6)) % NGW)
    if (part & 1) {
    transpose_w(P.in[I_WUQ], QR, 3072, 3072, (bf16*)(ws + WS_WUQ), P.in[I_QG], scr, ROT(0), NGW, C.lane,
        [](int n) { const int h = n / QKD, c = n - h * QKD; return c < 128 ? n : h * QKD + 128 + rope_src(c - 128); });
    transpose_w(P.in[I_WUKV], KVR, 4096, 4096, (bf16*)(ws + WS_WUKV), P.in[I_KVG], scr, ROT(1), NGW, C.lane, [](int n) { return n; });
    }
    if (part & 2) {
    transpose_w(P.in[I_WPH], 1024, 1024, 1024, (bf16*)(ws + WS_WPH), nullptr, scr, ROT(2), NGW, C.lane, [](int n) { return n; });
    transpose_w(P.in[I_WPM], 2048, 1024, 1024, (bf16*)(ws + WS_WPM), nullptr, scr, ROT(3), NGW, C.lane, [](int n) { return n; });
    transpose_w(P.in[I_WO], 1024, 1024, 1024, (bf16*)(ws + WS_WO), nullptr, scr, ROT(4), NGW, C.lane, [](int n) { return n; });
    transpose_w(P.in[I_PQ], 1024, 2048, 2048, (bf16*)(ws + WS_WPQ), nullptr, scr, ROT(5), NGW, C.lane, [](int n) { return n; });
    cvt_rows(P.in[I_SK], (bf16*)(ws + WS_SK), (size_t)16 * 128 * 128 / 8, gt, NGT);
    }
#undef ROT
}

__device__ __forceinline__ void p0_prologue(const Params& P, const Ctx& C) {
    LAS float* scr = (LAS float*)(C.lds + C.wave * 16384);
    const int gw = C.vcu * 8 + C.wave, NGW = C.G * 8;
    unsigned char* ws = P.ws;
    transpose_w(P.in[I_WIN], DM, INW, INWP, (bf16*)(ws + WS_WIN), nullptr, scr, gw, NGW, C.lane,
        [](int n) { return n < 4736 ? n : n < N1V ? 4736 + rope_src(n - 4736) : n < N1 ? -1 : N1V + (n - N1); });
    const size_t gt = (size_t)C.vcu * 512 + C.tid, NGT = (size_t)C.G * 512;
    { bf16* H = (bf16*)(ws + WS_A); const float* x = P.in[I_X]; const float* meta = P.in[I_META];
      constexpr size_t NI = (size_t)MV * (DM / 8);
      for (size_t i0 = gt; i0 < NI; i0 += 4 * NGT) {
          pg8::f32x4 a[4], bb[4]; bool act[4];
#pragma unroll
          for (int u = 0; u < 4; ++u) { const size_t i = i0 + (size_t)u * NGT; act[u] = i < NI; a[u] = (pg8::f32x4){0.f, 0.f, 0.f, 0.f}; bb[u] = a[u];
              if (act[u]) { const int Rc = (int)(i >> 7), c8 = (int)(i & 127) * 8; const int b = Rc / PV, q = Rc - b * PV;
                  const float* s = q >= 16 ? x + ((size_t)b * SEQ + (q - 16)) * DM + c8 : meta + (size_t)q * DM + c8; a[u] = *(const pg8::f32x4*)s; bb[u] = *(const pg8::f32x4*)(s + 4); } }
#pragma unroll
          for (int u = 0; u < 4; ++u) if (act[u]) { const size_t i = i0 + (size_t)u * NGT; v4u o; o.x = pk2(a[u][0], a[u][1]); o.y = pk2(a[u][2], a[u][3]); o.z = pk2(bb[u][0], bb[u][1]); o.w = pk2(bb[u][2], bb[u][3]); *(v4u*)(H + i * 8) = o; }
      } }
    { bf16* HQ = (bf16*)(ws + WS_HQ); bf16* K1 = (bf16*)(ws + WS_K1); bf16* HI = (bf16*)(ws + WS_HI); bf16* CKV = (bf16*)(ws + WS_CKV);
      const v4u z = {0u, 0u, 0u, 0u};
      for (size_t i = gt; i < (size_t)NB * 48 * 128; i += NGT) { const int b = (int)(i / (48 * 128)), r = (int)(i % (48 * 128)); const size_t off = ((size_t)b * PP + 64) * DM + (size_t)r * 8;
          *(v4u*)(HQ + off) = z; *(v4u*)(K1 + off) = z; *(v4u*)(HI + off) = z; }
      for (size_t i = gt; i < (size_t)NB * 48 * 32; i += NGT) { const int b = (int)(i / (48 * 32)), r = (int)(i % (48 * 32)); *(v4u*)(CKV + ((size_t)b * PP + 64) * KVR + (size_t)r * 8) = z; } }
    { float* T = (float*)(ws + WS_ROPE);
      for (size_t i = gt; i < (size_t)PP * 32; i += NGT) { const int p = (int)(i >> 5), k = (int)(i & 31);
          const float ang = (float)(p - NPADR) * exp2f(-(float)k * 0.4152410118609203f);
          const double rev = (double)ang * 0.15915494309189535; const float fr = (float)(rev - floor(rev));
          T[i * 2] = __builtin_amdgcn_cosf(fr); T[i * 2 + 1] = __builtin_amdgcn_sinf(fr); } }
}

__device__ __forceinline__ float sq8(const v4u w) {
    return bflo(w.x) * bflo(w.x) + bfhi(w.x) * bfhi(w.x) + bflo(w.y) * bflo(w.y) + bfhi(w.y) * bfhi(w.y) + bflo(w.z) * bflo(w.z) + bfhi(w.z) * bfhi(w.z) + bflo(w.w) * bflo(w.w) + bfhi(w.w) * bfhi(w.w);
}
template <int W> __device__ __forceinline__ void rowstat_rows(const bf16* __restrict__ X, float* __restrict__ out, int nrows, int gw, int NGW, int lane) {
    const int g = lane >> 4, l16 = lane & 15;
    for (int r0 = gw * 8; r0 < nrows; r0 += NGW * 8) {
        v4u a[2][W / 128];
#pragma unroll
        for (int u = 0; u < 2; ++u) { const int r = r0 + u * 4 + g;
#pragma unroll
            for (int j = 0; j < W / 128; ++j) a[u][j] = r < nrows ? *(const v4u*)(X + (size_t)r * W + (l16 + 16 * j) * 8) : (v4u){0u, 0u, 0u, 0u}; }
#pragma unroll
        for (int u = 0; u < 2; ++u) { const int r = r0 + u * 4 + g; float s = 0.f;
#pragma unroll
            for (int j = 0; j < W / 128; ++j) s += sq8(a[u][j]);
            s += __shfl_xor(s, 1); s += __shfl_xor(s, 2); s += __shfl_xor(s, 4); s += __shfl_xor(s, 8);
            if (l16 == 0 && r < nrows) out[r] = 1.0f / sqrtf(s * (1.0f / W) + EPS); }
    }
}
__device__ __forceinline__ void rowstats(const Params& P, const Ctx& C, int gw, int NGW) {
    rowstat_rows<QR>((const bf16*)(P.ws + WS_CQ), (float*)(P.ws + WS_RQ), MR, gw, NGW, C.lane);
    rowstat_rows<KVR>((const bf16*)(P.ws + WS_CKV), (float*)(P.ws + WS_RKV), MALL, gw, NGW, C.lane);
}

__device__ __forceinline__ void hgrn_item(const Params& P, const Ctx& C, int item) {
    const int b = item >> 3, h = item & 7, tid = C.tid, v = tid & 127, kq = tid >> 7;
    LAS float* fq = (LAS float*)C.lds; LAS float* ff = fq + 2048; LAS float* fk = ff + 2048; LAS float* fi = fk + 2048; LAS float* opart = fi + 2048;
    const bf16* HQ = (const bf16*)(P.ws + WS_HQ); const bf16* K1 = (const bf16*)(P.ws + WS_K1); const bf16* HI = (const bf16*)(P.ws + WS_HI); const bf16* HG = (const bf16*)(P.ws + WS_HG);
    bf16* ON = (bf16*)(P.ws + WS_ON); const float* gain = P.in[I_HGG];
    float S[32];
#pragma unroll
    for (int j = 0; j < 32; ++j) S[j] = 0.f;
    const int lt = tid >> 5, c4 = (tid & 31) * 4;
    for (int ch = NPADR / 16; ch < PP / 16; ++ch) {
        const int p0 = ch * 16;
        { const size_t off = ((size_t)b * PP + p0 + lt) * DM + h * 128 + c4;
          const v2u q = *(const v2u*)(HQ + off), k = *(const v2u*)(K1 + off), iv = *(const v2u*)(HI + off);
          const int o = lt * 128 + c4;
          fq[o] = bflo(q.x); fq[o + 1] = bfhi(q.x); fq[o + 2] = bflo(q.y); fq[o + 3] = bfhi(q.y);
          const float k0 = bflo(k.x), k1 = bfhi(k.x), k2 = bflo(k.y), k3 = bfhi(k.y);
          fk[o] = k0; fk[o + 1] = k1; fk[o + 2] = k2; fk[o + 3] = k3;
          ff[o] = 1.f - k0; ff[o + 1] = 1.f - k1; ff[o + 2] = 1.f - k2; ff[o + 3] = 1.f - k3;
          fi[o] = bflo(iv.x); fi[o + 1] = bfhi(iv.x); fi[o + 2] = bflo(iv.y); fi[o + 3] = bfhi(iv.y); }
        __syncthreads();
#pragma unroll 2
        for (int t = 0; t < 16; ++t) {
            const float ivv = fi[t * 128 + v]; float op = 0.f;
            const LAS pg8::f32x4* f4 = (const LAS pg8::f32x4*)(ff + t * 128 + kq * 32);
            const LAS pg8::f32x4* k4 = (const LAS pg8::f32x4*)(fk + t * 128 + kq * 32);
            const LAS pg8::f32x4* q4 = (const LAS pg8::f32x4*)(fq + t * 128 + kq * 32);
#pragma unroll
            for (int j4 = 0; j4 < 8; ++j4) { const pg8::f32x4 fv = f4[j4], kv = k4[j4], qv = q4[j4];
#pragma unroll
                for (int e = 0; e < 4; ++e) { const float s = fmaf(fv[e], S[j4 * 4 + e], kv[e] * ivv); S[j4 * 4 + e] = s; op = fmaf(qv[e], s, op); } }
            opart[(t * 4 + kq) * 128 + v] = op;
        }
        __syncthreads();
        { pg8::f32x4 o = *(const LAS pg8::f32x4*)(opart + (lt * 4 + 0) * 128 + c4);
          o += *(const LAS pg8::f32x4*)(opart + (lt * 4 + 1) * 128 + c4); o += *(const LAS pg8::f32x4*)(opart + (lt * 4 + 2) * 128 + c4); o += *(const LAS pg8::f32x4*)(opart + (lt * 4 + 3) * 128 + c4);
          float ss = o[0] * o[0] + o[1] * o[1] + o[2] * o[2] + o[3] * o[3];
#pragma unroll
          for (int m = 1; m < 32; m <<= 1) ss += __shfl_xor(ss, m);
          const int p = p0 + lt;
          if (p >= LEAD) { const float rstd = 1.0f / sqrtf(ss * (1.0f / 128.f) + EPS); const size_t rr = (size_t)b * SEQ + (p - LEAD);
              const v2u g = *(const v2u*)(HG + rr * DM + h * 128 + c4); const pg8::f32x4 gn = *(const pg8::f32x4*)(gain + h * 128 + c4);
              v2u w; w.x = pk2(o[0] * rstd * gn[0] * bflo(g.x), o[1] * rstd * gn[1] * bfhi(g.x)); w.y = pk2(o[2] * rstd * gn[2] * bflo(g.y), o[3] * rstd * gn[3] * bfhi(g.y));
              *(v2u*)(ON + rr * DM + h * 128 + c4) = w; } }
    }
    __syncthreads();
}


__device__ __forceinline__ void hgrn_item2(const Params& P, const Ctx& C, int item) {
    typedef short bf16x8v __attribute__((ext_vector_type(8)));
    int tid_ = threadIdx.x; asm volatile("" : "+v"(tid_));
    const int tid = tid_, lane = tid & 63, w = C.wave, fr = lane & 15, g = lane >> 4;
    const int b = item >> 3, h = item & 7;
    constexpr int SQ = 272, SP = 144;
    constexpr int O_QD = 0, O_KI = 17408, O_KST = 34816, O_IT = 53248, O_P = 71680, O_ST = 80896, O_SEG = 115712, O_DEC = 119808;
    LAS unsigned char* L = C.lds;
    const bf16* HQ = (const bf16*)(P.ws + WS_HQ); const bf16* K1 = (const bf16*)(P.ws + WS_K1); const bf16* HI = (const bf16*)(P.ws + WS_HI); const bf16* HG = (const bf16*)(P.ws + WS_HG);
    bf16* ON = (bf16*)(P.ws + WS_ON); const float* gain = P.in[I_HGG];
    const int kp = tid & 63;
    for (int i = tid; i < 34816 / 16; i += 512) *(LAS v4u*)(L + O_ST + i * 16) = (v4u){0u, 0u, 0u, 0u};
    pg8::f32x4 S[8];
#pragma unroll
    for (int j = 0; j < 8; ++j) S[j] = (pg8::f32x4){0.f, 0.f, 0.f, 0.f};
    unsigned rq[8], rk[8], ri[8];
    const size_t colbase = (size_t)h * 128 + 2 * kp;
#define LOADRAW(c) do { const size_t r0_ = ((size_t)b * PP + 64 + 64 * (c) + 8 * w) * DM + colbase; \
        _Pragma("unroll") for (int i = 0; i < 8; ++i) { rq[i] = *(const unsigned*)(HQ + r0_ + (size_t)i * DM); rk[i] = *(const unsigned*)(K1 + r0_ + (size_t)i * DM); ri[i] = *(const unsigned*)(HI + r0_ + (size_t)i * DM); } } while (0)
    LOADRAW(0);
    __syncthreads();
#pragma unroll 1
    for (int c = 0; c < 33; ++c) {
        float cum0[8], cum1[8], ka[8], kb[8]; float cs0 = 0.f, cs1 = 0.f;
#pragma unroll
        for (int i = 0; i < 8; ++i) { const bool valid = (64 + 64 * c + 8 * w + i) >= NPADR; const float k0 = valid ? bflo(rk[i]) : 0.f, k1 = valid ? bfhi(rk[i]) : 0.f; ka[i] = k0; kb[i] = k1;
            cs0 += __builtin_amdgcn_logf(1.0f - k0); cs1 += __builtin_amdgcn_logf(1.0f - k1); cum0[i] = cs0; cum1[i] = cs1; }
        *(LAS f32x2*)(L + O_SEG + (w * 128 + 2 * kp) * 4) = (f32x2){cs0, cs1};
        { v4u w0, w1;
          w0.x = (ri[0] & 0xffffu) | (ri[1] << 16); w0.y = (ri[2] & 0xffffu) | (ri[3] << 16); w0.z = (ri[4] & 0xffffu) | (ri[5] << 16); w0.w = (ri[6] & 0xffffu) | (ri[7] << 16);
          w1.x = (ri[0] >> 16) | (ri[1] & 0xffff0000u); w1.y = (ri[2] >> 16) | (ri[3] & 0xffff0000u); w1.z = (ri[4] >> 16) | (ri[5] & 0xffff0000u); w1.w = (ri[6] >> 16) | (ri[7] & 0xffff0000u);
          *(LAS v4u*)(L + O_IT + (2 * kp) * SP + w * 16) = w0; *(LAS v4u*)(L + O_IT + (2 * kp + 1) * SP + w * 16) = w1; }
        __syncthreads();
        { float p0 = 0.f, p1 = 0.f, t0 = 0.f, t1 = 0.f;
#pragma unroll
          for (int j = 0; j < 8; ++j) { const f32x2 sj = *(const LAS f32x2*)(L + O_SEG + (j * 128 + 2 * kp) * 4); t0 += sj[0]; t1 += sj[1]; if (j < w) { p0 += sj[0]; p1 += sj[1]; } }
          const float d0 = __builtin_amdgcn_exp2f(t0), d1 = __builtin_amdgcn_exp2f(t1);
          float ks0[8], ks1[8];
#pragma unroll
          for (int i = 0; i < 8; ++i) { const float e0 = __builtin_amdgcn_exp2f(p0 + cum0[i]), e1 = __builtin_amdgcn_exp2f(p1 + cum1[i]);
              const float ki0 = ka[i] * __builtin_amdgcn_rcpf(e0), ki1 = kb[i] * __builtin_amdgcn_rcpf(e1);
              const int t = 8 * w + i;
              *(LAS unsigned*)(L + O_QD + t * SQ + kp * 4) = pg8::cvt_pk_bf16(bflo(rq[i]) * e0, bfhi(rq[i]) * e1);
              *(LAS unsigned*)(L + O_KI + t * SQ + kp * 4) = pg8::cvt_pk_bf16(ki0, ki1);
              ks0[i] = ki0 * d0; ks1[i] = ki1 * d1; }
          *(LAS v4u*)(L + O_KST + (2 * kp) * SP + w * 16) = (v4u){pg8::cvt_pk_bf16(ks0[0], ks0[1]), pg8::cvt_pk_bf16(ks0[2], ks0[3]), pg8::cvt_pk_bf16(ks0[4], ks0[5]), pg8::cvt_pk_bf16(ks0[6], ks0[7])};
          *(LAS v4u*)(L + O_KST + (2 * kp + 1) * SP + w * 16) = (v4u){pg8::cvt_pk_bf16(ks1[0], ks1[1]), pg8::cvt_pk_bf16(ks1[2], ks1[3]), pg8::cvt_pk_bf16(ks1[4], ks1[5]), pg8::cvt_pk_bf16(ks1[6], ks1[7])};
          if (w == 0) *(LAS f32x2*)(L + O_DEC + (2 * kp) * 4) = (f32x2){d0, d1}; }
        if (c + 1 < 33) LOADRAW(c + 1);
        __syncthreads();
#pragma unroll
        for (int q = 0; q < 2; ++q) { const int ti = 2 * w + q, tr = ti >> 2, sc = ti & 3;
            pg8::f32x4 acc = (pg8::f32x4){0.f, 0.f, 0.f, 0.f};
            if (sc <= tr) {
#pragma unroll
                for (int kk = 0; kk < 4; ++kk) { const bf16x8v a = *(const LAS bf16x8v*)(L + O_QD + (tr * 16 + fr) * SQ + kk * 64 + g * 16), bb = *(const LAS bf16x8v*)(L + O_KI + (sc * 16 + fr) * SQ + kk * 64 + g * 16);
                    acc = __builtin_amdgcn_mfma_f32_16x16x32_bf16(a, bb, acc, 0, 0, 0); }
            }
#pragma unroll
            for (int r = 0; r < 4; ++r) { const float v = (sc < tr || (sc == tr && fr <= 4 * g + r)) ? acc[r] : 0.f;
                *(LAS unsigned short*)(L + O_P + (tr * 16 + 4 * g + r) * SP + (sc * 16 + fr) * 2) = (unsigned short)f2bf(v); } }
        __syncthreads();
        pg8::f32x4 oacc[4];
        { const int tr = w >> 1, vb0 = (w & 1) * 4;
#pragma unroll
          for (int j = 0; j < 4; ++j) oacc[j] = (pg8::f32x4){0.f, 0.f, 0.f, 0.f};
#pragma unroll
          for (int kk = 0; kk < 2; ++kk) if (32 * kk <= 16 * tr + 15) { const bf16x8v a = *(const LAS bf16x8v*)(L + O_P + (tr * 16 + fr) * SP + kk * 64 + g * 16);
#pragma unroll
              for (int j = 0; j < 4; ++j) { const bf16x8v bb = *(const LAS bf16x8v*)(L + O_IT + ((vb0 + j) * 16 + fr) * SP + kk * 64 + g * 16); oacc[j] = __builtin_amdgcn_mfma_f32_16x16x32_bf16(a, bb, oacc[j], 0, 0, 0); } }
#pragma unroll
          for (int kk = 0; kk < 4; ++kk) { const bf16x8v a = *(const LAS bf16x8v*)(L + O_QD + (tr * 16 + fr) * SQ + kk * 64 + g * 16);
#pragma unroll
              for (int j = 0; j < 4; ++j) { const bf16x8v bb = *(const LAS bf16x8v*)(L + O_ST + ((vb0 + j) * 16 + fr) * SQ + kk * 64 + g * 16); oacc[j] = __builtin_amdgcn_mfma_f32_16x16x32_bf16(a, bb, oacc[j], 0, 0, 0); } } }
        { const pg8::f32x4 dv = *(const LAS pg8::f32x4*)(L + O_DEC + (16 * w + 4 * g) * 4);
#pragma unroll
          for (int j = 0; j < 8; ++j) S[j] = S[j] * dv;
#pragma unroll
          for (int kk = 0; kk < 2; ++kk) { const bf16x8v a = *(const LAS bf16x8v*)(L + O_KST + (16 * w + fr) * SP + kk * 64 + g * 16);
#pragma unroll
              for (int j = 0; j < 8; ++j) { const bf16x8v bb = *(const LAS bf16x8v*)(L + O_IT + (j * 16 + fr) * SP + kk * 64 + g * 16); S[j] = __builtin_amdgcn_mfma_f32_16x16x32_bf16(a, bb, S[j], 0, 0, 0); } } }
        __syncthreads();
        { const int tr = w >> 1, vb0 = (w & 1) * 4;
#pragma unroll
          for (int j = 0; j < 4; ++j)
#pragma unroll
              for (int r = 0; r < 4; ++r) ((LAS float*)L)[(tr * 16 + 4 * g + r) * 132 + (vb0 + j) * 16 + fr] = oacc[j][r];
#pragma unroll
          for (int j = 0; j < 8; ++j) { v2u pkd; pkd.x = pk2(S[j][0], S[j][1]); pkd.y = pk2(S[j][2], S[j][3]); *(LAS v2u*)(L + O_ST + (j * 16 + fr) * SQ + (16 * w + 4 * g) * 2) = pkd; } }
        __syncthreads();
        if (c >= 1) { const int t = tid >> 3, c16 = (tid & 7) * 16; const LAS pg8::f32x4* op = (const LAS pg8::f32x4*)((LAS float*)L + t * 132 + c16);
            pg8::f32x4 o[4]; float ss = 0.f;
#pragma unroll
            for (int q = 0; q < 4; ++q) { o[q] = op[q]; ss += (o[q][0] * o[q][0] + o[q][1] * o[q][1]) + (o[q][2] * o[q][2] + o[q][3] * o[q][3]); }
            ss += __shfl_xor(ss, 1); ss += __shfl_xor(ss, 2); ss += __shfl_xor(ss, 4);
            const float rstd = 1.0f / sqrtf(ss * (1.0f / 128.f) + EPS);
            const size_t rr = (size_t)b * SEQ + (64 * c - 64 + t); const size_t off = rr * DM + h * 128 + c16;
            const v4u g0 = *(const v4u*)(HG + off), g1 = *(const v4u*)(HG + off + 8);
            const pg8::f32x4* gp = (const pg8::f32x4*)(gain + h * 128 + c16); const pg8::f32x4 n0 = gp[0], n1 = gp[1], n2 = gp[2], n3 = gp[3];
            v4u w0, w1;
            w0.x = pk2(o[0][0] * rstd * n0[0] * bflo(g0.x), o[0][1] * rstd * n0[1] * bfhi(g0.x)); w0.y = pk2(o[0][2] * rstd * n0[2] * bflo(g0.y), o[0][3] * rstd * n0[3] * bfhi(g0.y));
            w0.z = pk2(o[1][0] * rstd * n1[0] * bflo(g0.z), o[1][1] * rstd * n1[1] * bfhi(g0.z)); w0.w = pk2(o[1][2] * rstd * n1[2] * bflo(g0.w), o[1][3] * rstd * n1[3] * bfhi(g0.w));
            w1.x = pk2(o[2][0] * rstd * n2[0] * bflo(g1.x), o[2][1] * rstd * n2[1] * bfhi(g1.x)); w1.y = pk2(o[2][2] * rstd * n2[2] * bflo(g1.y), o[2][3] * rstd * n2[3] * bfhi(g1.y));
            w1.z = pk2(o[3][0] * rstd * n3[0] * bflo(g1.z), o[3][1] * rstd * n3[1] * bfhi(g1.z)); w1.w = pk2(o[3][2] * rstd * n3[2] * bflo(g1.w), o[3][3] * rstd * n3[3] * bfhi(g1.w));
            *(v4u*)(ON + off) = w0; *(v4u*)(ON + off + 8) = w1; }
    }
#undef LOADRAW
    __syncthreads();
}

__device__ __forceinline__ void ln1_phase(const Params& P, const Ctx& C, bool dostore) {
    const int gw = C.vcu * 8 + C.wave, NGW = C.G * 8; bf16* H1B = (bf16*)(P.ws + WS_H1B);
    const float* g = P.in[I_LN1G]; const float* bb = P.in[I_LN1B];
    for (int r = gw; r < MR; r += NGW) {
        pg8::f32x4* row = (pg8::f32x4*)(P.out + (size_t)r * DM) + C.lane;
        pg8::f32x4 v[4]; float s = 0.f;
#pragma unroll
        for (int j = 0; j < 4; ++j) { v[j] = row[64 * j]; s += (v[j][0] + v[j][1]) + (v[j][2] + v[j][3]); }
        const float mean = wave_sum(s) * (1.f / DM); float s2 = 0.f;
#pragma unroll
        for (int j = 0; j < 4; ++j) { v[j] = v[j] - mean; s2 += (v[j][0] * v[j][0] + v[j][1] * v[j][1]) + (v[j][2] * v[j][2] + v[j][3] * v[j][3]); }
        const float rstd = 1.f / sqrtf(wave_sum(s2) * (1.f / DM) + EPS);
#pragma unroll
        for (int j = 0; j < 4; ++j) { const int c = (C.lane + 64 * j) * 4; const pg8::f32x4 gg = *(const pg8::f32x4*)(g + c), b4 = *(const pg8::f32x4*)(bb + c);
            const pg8::f32x4 o = v[j] * rstd * gg + b4; if (dostore) row[64 * j] = o;
            v2u w; w.x = pk2(o[0], o[1]); w.y = pk2(o[2], o[3]); if (dostore) *(v2u*)(H1B + (size_t)r * DM + c) = w; }
    }
}


typedef float f32x2v __attribute__((ext_vector_type(2)));
__device__ __forceinline__ void cvt_table_fp8(const float* __restrict__ src, unsigned char* __restrict__ dst, float* __restrict__ inv  , int gw, int NGW, int lane) {
    for (int r = gw; r < 16384; r += NGW) {
        const pg8::f32x4* p = (const pg8::f32x4*)(src + (size_t)r * 1024 + lane * 16);
        pg8::f32x4 v[4]; float mx = 0.f;
#pragma unroll
        for (int j = 0; j < 4; ++j) { v[j] = p[j]; mx = fmaxf(mx, fmaxf(fmaxf(fabsf(v[j][0]), fabsf(v[j][1])), fmaxf(fabsf(v[j][2]), fabsf(v[j][3])))); }
#pragma unroll
        for (int o = 1; o < 64; o <<= 1) mx = fmaxf(mx, __shfl_xor(mx, o));
        const float sc = mx > 0.f ? exp2f(floorf(log2f(256.0f / mx))) : 1.0f;
        v4u w;
        { int t = 0; t = __builtin_amdgcn_cvt_pk_fp8_f32(v[0][0] * sc, v[0][1] * sc, t, false); t = __builtin_amdgcn_cvt_pk_fp8_f32(v[0][2] * sc, v[0][3] * sc, t, true); w.x = (unsigned)t; }
        { int t = 0; t = __builtin_amdgcn_cvt_pk_fp8_f32(v[1][0] * sc, v[1][1] * sc, t, false); t = __builtin_amdgcn_cvt_pk_fp8_f32(v[1][2] * sc, v[1][3] * sc, t, true); w.y = (unsigned)t; }
        { int t = 0; t = __builtin_amdgcn_cvt_pk_fp8_f32(v[2][0] * sc, v[2][1] * sc, t, false); t = __builtin_amdgcn_cvt_pk_fp8_f32(v[2][2] * sc, v[2][3] * sc, t, true); w.z = (unsigned)t; }
        { int t = 0; t = __builtin_amdgcn_cvt_pk_fp8_f32(v[3][0] * sc, v[3][1] * sc, t, false); t = __builtin_amdgcn_cvt_pk_fp8_f32(v[3][2] * sc, v[3][3] * sc, t, true); w.w = (unsigned)t; }
        *(v4u*)(dst + (size_t)r * 1024 + lane * 16) = w;
        if (lane == 0) inv[2 * r] = 1.0f / sc;
    }
}
__device__ __forceinline__ void fp8x4_to_bf16x4(unsigned w, unsigned& lo, unsigned& hi) {
    const f32x2v a = __builtin_amdgcn_cvt_pk_f32_fp8((int)w, false), b = __builtin_amdgcn_cvt_pk_f32_fp8((int)w, true);
    lo = pg8::cvt_pk_bf16(a[0], a[1]); hi = pg8::cvt_pk_bf16(b[0], b[1]);
}

__device__ __forceinline__ float gelu_tanh(float a) { const float u = 0.7978845608028654f * (a + 0.044715f * a * a * a); return a / (1.0f + __expf(-2.0f * u)); }
typedef short bf16x8v __attribute__((ext_vector_type(8)));

__device__ __forceinline__ float vmaxf(float a, float b) { float r; asm("v_max_f32 %0, %1, %2" : "=v"(r) : "v"(a), "v"(b)); return r; }
__device__ __forceinline__ float vminf(float a, float b) { float r; asm("v_min_f32 %0, %1, %2" : "=v"(r) : "v"(a), "v"(b)); return r; }
#define CE_DESC(a, b) do { const float hi_ = vmaxf(a, b), lo_ = vminf(a, b); a = hi_; b = lo_; } while (0)
template <int N> __device__ __forceinline__ void bitonic_merge_desc(float (&v)[N]) {
#pragma unroll
    for (int j = N / 2; j > 0; j >>= 1)
#pragma unroll
        for (int i = 0; i < N; ++i) { const int l = i ^ j; if (l > i) CE_DESC(v[i], v[l]); }
}
template <int N> __device__ __forceinline__ void bitonic_sort_desc(float (&v)[N]) {
#pragma unroll
    for (int k = 2; k <= N; k <<= 1)
#pragma unroll
        for (int j = k >> 1; j > 0; j >>= 1)
#pragma unroll
            for (int i = 0; i < N; ++i) { const int l = i ^ j; if (l > i) { if ((i & k) == 0 || k == N) CE_DESC(v[i], v[l]); else CE_DESC(v[l], v[i]); } }
}
__device__ __forceinline__ void top16_merge(float (&a)[16], const float (&b)[16]) {
#pragma unroll
    for (int i = 0; i < 16; ++i) a[i] = vmaxf(a[i], b[15 - i]);
    bitonic_merge_desc<16>(a);
}
__device__ __forceinline__ void peer_route(const Params& P, const Ctx& C, int grp, LAS unsigned short* sidx, LAS float* sgate, LAS float* topv) {
    int lane_ = C.lane; asm volatile("" : "+v"(lane_));
    const int lane = lane_, w = C.wave, tokl = lane & 31, hi = lane >> 5;
    const bf16* PQ = (const bf16*)(P.ws + WS_PQ); const bf16* SK = (const bf16*)(P.ws + WS_SK);
    const int tok0 = grp * 32;
#pragma unroll 1
    for (int pp = 0; pp < 2; ++pp) {
        const int hp = 2 * w + pp;
        f32x16 acc[4] = {};
#pragma unroll
        for (int s = 0; s < 8; ++s) {
            const bf16x8v bfrag = *(const bf16x8v*)(PQ + (size_t)(tok0 + tokl) * 2048 + hp * 128 + s * 16 + hi * 8);
#pragma unroll
            for (int mb = 0; mb < 4; ++mb) { const bf16x8v afrag = *(const bf16x8v*)(SK + (size_t)(hp * 128 + mb * 32 + tokl) * 128 + s * 16 + hi * 8);
                acc[mb] = __builtin_amdgcn_mfma_f32_32x32x16_bf16(afrag, bfrag, acc[mb], 0, 0, 0); }
        }
        float g0[16], g1[16], g2[16], g3[16];
#pragma unroll
        for (int r = 0; r < 16; ++r) { const unsigned kb = (unsigned)((r & 3) + 8 * (r >> 2) + 4 * hi);
            g0[r] = __uint_as_float((__float_as_uint(acc[0][r]) & ~127u) | kb); g1[r] = __uint_as_float((__float_as_uint(acc[1][r]) & ~127u) | (kb + 32u));
            g2[r] = __uint_as_float((__float_as_uint(acc[2][r]) & ~127u) | (kb + 64u)); g3[r] = __uint_as_float((__float_as_uint(acc[3][r]) & ~127u) | (kb + 96u)); }
        bitonic_sort_desc<16>(g0); bitonic_sort_desc<16>(g1); bitonic_sort_desc<16>(g2); bitonic_sort_desc<16>(g3);
        top16_merge(g0, g1); top16_merge(g2, g3); top16_merge(g0, g2);
        { float o[16];
#pragma unroll
          for (int i = 0; i < 16; ++i) o[i] = __shfl_xor(g0[i], 32);
          top16_merge(g0, o); }
        if (hi == 0) { LAS pg8::f32x4* tp = (LAS pg8::f32x4*)(topv + tokl * 260 + hp * 16);
            tp[0] = (pg8::f32x4){g0[0], g0[1], g0[2], g0[3]}; tp[1] = (pg8::f32x4){g0[4], g0[5], g0[6], g0[7]}; tp[2] = (pg8::f32x4){g0[8], g0[9], g0[10], g0[11]}; tp[3] = (pg8::f32x4){g0[12], g0[13], g0[14], g0[15]}; }
    }
    asm volatile("s_waitcnt lgkmcnt(0)" ::: "memory");
    const LAS float* ta_l = topv + tokl * 260 + (2 * w) * 16; const LAS float* tb_l = ta_l + 16;
    float ta[16], tb[16];
#pragma unroll
    for (int q = 0; q < 4; ++q) { const pg8::f32x4 x = ((const LAS pg8::f32x4*)ta_l)[q], y = ((const LAS pg8::f32x4*)tb_l)[q];
        ta[4 * q] = x[0]; ta[4 * q + 1] = x[1]; ta[4 * q + 2] = x[2]; ta[4 * q + 3] = x[3]; tb[4 * q] = y[0]; tb[4 * q + 1] = y[1]; tb[4 * q + 2] = y[2]; tb[4 * q + 3] = y[3]; }
    float cand[25];
    { int n = 0;
#pragma unroll
      for (int i = 0; i < 16; ++i)
#pragma unroll
          for (int j = 0; j < 16; ++j) if ((i + 1) * (j + 1) <= 16) {
              const float sv = ta[i] + tb[j]; const float tagged = __uint_as_float((__float_as_uint(sv) & ~255u) | (unsigned)((i << 4) | j));
              if ((n & 1) == 0) cand[n >> 1] = tagged; else cand[n >> 1] = hi ? tagged : cand[n >> 1];
              ++n; } }
    float best[16];
    { float ca[16], cb[16];
#pragma unroll
      for (int i = 0; i < 16; ++i) { ca[i] = cand[i]; cb[i] = i < 9 ? cand[16 + i] : -INFINITY; }
      bitonic_sort_desc<16>(ca); bitonic_sort_desc<16>(cb); top16_merge(ca, cb);
#pragma unroll
      for (int i = 0; i < 16; ++i) cb[i] = __shfl_xor(ca[i], 32);
#pragma unroll
      for (int i = 0; i < 16; ++i) best[i] = vmaxf(ca[i], cb[15 - i]); }
    { float e[16], se = 0.f;
      const float bmx = __builtin_fmaxf(best[0], best[15]);
#pragma unroll
      for (int it = 0; it < 16; ++it) { e[it] = __expf(best[it] - bmx); se += e[it]; }
      const float inv = 1.0f / se;
      if (hi == 0) {
#pragma unroll
          for (int it = 0; it < 16; ++it) { const unsigned bits = __float_as_uint(best[it]); const int ci = (bits >> 4) & 15, cj = bits & 15;
              const int ia = (int)(__float_as_uint(ta_l[ci]) & 127u), ib = (int)(__float_as_uint(tb_l[cj]) & 127u);
              sidx[tokl * 128 + w * 16 + it] = (unsigned short)(ia * 128 + ib); sgate[tokl * 128 + w * 16 + it] = e[it] * inv; }
      } }
}
template <int MODE  >
__device__ __forceinline__ void peer_apply(const Params& P, const Ctx& C, int grp, const LAS unsigned short* sidx, const LAS float* sgate, bool dostore) {
    int lane_ = C.lane; asm volatile("" : "+v"(lane_));
    const int lane = lane_, w = C.wave;
    LAS float* actw = (LAS float*)(C.lds + 82432) + w * 128;
    LAS unsigned short* hrow = (LAS unsigned short*)(C.lds + 86528) + w * 1024;
    LAS float* suw = (LAS float*)(C.lds + 102912) + w * 256; LAS float* svw = suw + 128;
    const unsigned char* U8 = P.ws + WS_U8; const unsigned char* V8 = P.ws + WS_V8; const float* SU = (const float*)(P.ws + WS_SU); const float* SV = (const float*)(P.ws + WS_SV);
    const bf16* H1B = (const bf16*)(P.ws + WS_H1B);
    const float* g2 = P.in[I_LN2G]; const float* b2 = P.in[I_LN2B];
    const int tok0 = grp * 32;
        for (int tt = 0; tt < 4; ++tt) {
            const int tl = w * 4 + tt; const size_t tok = (size_t)tok0 + tl;
            f32x2v h2[8];
            { const v4u a = *(const v4u*)(H1B + tok * DM + lane * 16), b = *(const v4u*)(H1B + tok * DM + lane * 16 + 8);
              h2[0] = (f32x2v){bflo(a.x), bfhi(a.x)}; h2[1] = (f32x2v){bflo(a.y), bfhi(a.y)}; h2[2] = (f32x2v){bflo(a.z), bfhi(a.z)}; h2[3] = (f32x2v){bflo(a.w), bfhi(a.w)};
              h2[4] = (f32x2v){bflo(b.x), bfhi(b.x)}; h2[5] = (f32x2v){bflo(b.y), bfhi(b.y)}; h2[6] = (f32x2v){bflo(b.z), bfhi(b.z)}; h2[7] = (f32x2v){bflo(b.w), bfhi(b.w)}; }
            { const int e0 = sidx[tl * 128 + lane], e1 = sidx[tl * 128 + 64 + lane];
              const f32x2v s0 = *(const f32x2v*)(SU + 2 * e0), s1 = *(const f32x2v*)(SU + 2 * e1);
              suw[lane] = s0[0]; suw[64 + lane] = s1[0]; svw[lane] = s0[1]; svw[64 + lane] = s1[1]; }
            {
                v4u uA[8], uB[8]; float pd[16];
#define U_LOAD(ST, kb) do { _Pragma("unroll") for (int q = 0; q < 8; ++q) { const int e = __builtin_amdgcn_readfirstlane((int)sidx[tl * 128 + (kb) * 8 + q]); ST[q] = *(const v4u*)(U8 + (size_t)e * DM + lane * 16); } } while (0)
#define U_DOT(ST, off) do { _Pragma("unroll") for (int q = 0; q < 8; ++q) { const v4u x = ST[q]; \
                    f32x2v sacc = __builtin_amdgcn_cvt_pk_f32_fp8((int)x.x, false) * h2[0]; sacc = __builtin_elementwise_fma(__builtin_amdgcn_cvt_pk_f32_fp8((int)x.x, true), h2[1], sacc); \
                    sacc = __builtin_elementwise_fma(__builtin_amdgcn_cvt_pk_f32_fp8((int)x.y, false), h2[2], sacc); sacc = __builtin_elementwise_fma(__builtin_amdgcn_cvt_pk_f32_fp8((int)x.y, true), h2[3], sacc); \
                    sacc = __builtin_elementwise_fma(__builtin_amdgcn_cvt_pk_f32_fp8((int)x.z, false), h2[4], sacc); sacc = __builtin_elementwise_fma(__builtin_amdgcn_cvt_pk_f32_fp8((int)x.z, true), h2[5], sacc); \
                    sacc = __builtin_elementwise_fma(__builtin_amdgcn_cvt_pk_f32_fp8((int)x.w, false), h2[6], sacc); sacc = __builtin_elementwise_fma(__builtin_amdgcn_cvt_pk_f32_fp8((int)x.w, true), h2[7], sacc); \
                    pd[(off) + q] = sacc[0] + sacc[1]; } } while (0)
#define U_REDUCE(kb2) do { float r8[8], r4[4], r2[2], r1; const bool b5 = lane & 32, b4 = lane & 16, b3 = lane & 8, b2 = lane & 4; \
                    _Pragma("unroll") for (int j = 0; j < 8; ++j) { const float keep = b5 ? pd[j + 8] : pd[j], send = b5 ? pd[j] : pd[j + 8]; r8[j] = keep + __shfl_xor(send, 32); } \
                    _Pragma("unroll") for (int j = 0; j < 4; ++j) { const float keep = b4 ? r8[j + 4] : r8[j], send = b4 ? r8[j] : r8[j + 4]; r4[j] = keep + __shfl_xor(send, 16); } \
                    _Pragma("unroll") for (int j = 0; j < 2; ++j) { const float keep = b3 ? r4[j + 2] : r4[j], send = b3 ? r4[j] : r4[j + 2]; r2[j] = keep + __shfl_xor(send, 8); } \
                    { const float keep = b2 ? r2[1] : r2[0], send = b2 ? r2[0] : r2[1]; r1 = keep + __shfl_xor(send, 4); } \
                    r1 += __shfl_xor(r1, 2); r1 += __shfl_xor(r1, 1); \
                    if ((lane & 3) == 0) { const int k = (kb2) * 16 + ((lane >> 5) & 1) * 8 + ((lane >> 4) & 1) * 4 + ((lane >> 3) & 1) * 2 + ((lane >> 2) & 1); \
                        actw[k] = gelu_tanh(r1 * suw[k]) * sgate[tl * 128 + k] * svw[k]; } } while (0)
                asm volatile("s_waitcnt lgkmcnt(0)" ::: "memory");
                U_LOAD(uA, 0);
#pragma unroll 1
                for (int kb = 0; kb < 16; kb += 2) {
                    U_LOAD(uB, kb + 1);
                    U_DOT(uA, 0);
                    if (kb + 2 < 16) U_LOAD(uA, kb + 2);
                    U_DOT(uB, 8);
                    U_REDUCE(kb >> 1);
                }
#undef U_LOAD
#undef U_DOT
#undef U_REDUCE
            }
            v4u vA[8], vB[8];
#define V_LOAD(ST, kb) do { _Pragma("unroll") for (int q = 0; q < 8; ++q) { const int e = __builtin_amdgcn_readfirstlane((int)sidx[tl * 128 + (kb) * 8 + q]); ST[q] = *(const v4u*)(V8 + (size_t)e * DM + lane * 16); } } while (0)
            if (MODE == 0) V_LOAD(vA, 0);
            asm volatile("s_waitcnt lgkmcnt(0)" ::: "memory");
            if (MODE == 1) {
                if (lane < 32) *(pg8::f32x4*)((float*)(P.ws + WS_ACT) + tok * 128 + lane * 4) = *(const LAS pg8::f32x4*)(actw + lane * 4);
                else if (lane < 48) *(v4u*)((unsigned short*)(P.ws + WS_SIDX) + tok * 128 + (lane - 32) * 8) = *(const LAS v4u*)(sidx + tl * 128 + (lane - 32) * 8);
                continue;
            }
            float out[16];
#pragma unroll
            for (int i = 0; i < 16; ++i) out[i] = 0.f;
            {
#define V_COMP(ST, kb) do { _Pragma("unroll") for (int q = 0; q < 8; ++q) { const float a = actw[(kb) * 8 + q]; const f32x2v a2 = {a, a}; const v4u x = ST[q]; \
                    out2[0] = __builtin_elementwise_fma(__builtin_amdgcn_cvt_pk_f32_fp8((int)x.x, false), a2, out2[0]); out2[1] = __builtin_elementwise_fma(__builtin_amdgcn_cvt_pk_f32_fp8((int)x.x, true), a2, out2[1]); \
                    out2[2] = __builtin_elementwise_fma(__builtin_amdgcn_cvt_pk_f32_fp8((int)x.y, false), a2, out2[2]); out2[3] = __builtin_elementwise_fma(__builtin_amdgcn_cvt_pk_f32_fp8((int)x.y, true), a2, out2[3]); \
                    out2[4] = __builtin_elementwise_fma(__builtin_amdgcn_cvt_pk_f32_fp8((int)x.z, false), a2, out2[4]); out2[5] = __builtin_elementwise_fma(__builtin_amdgcn_cvt_pk_f32_fp8((int)x.z, true), a2, out2[5]); \
                    out2[6] = __builtin_elementwise_fma(__builtin_amdgcn_cvt_pk_f32_fp8((int)x.w, false), a2, out2[6]); out2[7] = __builtin_elementwise_fma(__builtin_amdgcn_cvt_pk_f32_fp8((int)x.w, true), a2, out2[7]); } } while (0)
                f32x2v out2[8];
#pragma unroll
                for (int i = 0; i < 8; ++i) out2[i] = (f32x2v){0.f, 0.f};
#pragma unroll 1
                for (int kb = 0; kb < 16; kb += 2) {
                    V_LOAD(vB, kb + 1);
                    V_COMP(vA, kb);
                    if (kb + 2 < 16) V_LOAD(vA, kb + 2);
                    V_COMP(vB, kb + 1);
                }
#undef V_LOAD
#undef V_COMP
#pragma unroll
                for (int i = 0; i < 8; ++i) { out[2 * i] = out2[i][0]; out[2 * i + 1] = out2[i][1]; }
            }
            float* orow = P.out + tok * DM + lane * 16;
            float s = 0.f;
#pragma unroll
            for (int q = 0; q < 4; ++q) { const pg8::f32x4 hv = *(const pg8::f32x4*)(orow + 4 * q);
#pragma unroll
                for (int e = 0; e < 4; ++e) { out[4 * q + e] = fmaf(ALPHA, hv[e], out[4 * q + e]); s += out[4 * q + e]; } }
            const float mean = wave_sum(s) * (1.f / DM); float s2 = 0.f;
#pragma unroll
            for (int i = 0; i < 16; ++i) { out[i] -= mean; s2 += out[i] * out[i]; }
            const float rstd = 1.f / sqrtf(wave_sum(s2) * (1.f / DM) + EPS);
#pragma unroll
            for (int q = 0; q < 4; ++q) { const pg8::f32x4 gg = *(const pg8::f32x4*)(g2 + lane * 16 + 4 * q), b4 = *(const pg8::f32x4*)(b2 + lane * 16 + 4 * q);
                pg8::f32x4 o; o[0] = out[4 * q] * rstd * gg[0] + b4[0]; o[1] = out[4 * q + 1] * rstd * gg[1] + b4[1]; o[2] = out[4 * q + 2] * rstd * gg[2] + b4[2]; o[3] = out[4 * q + 3] * rstd * gg[3] + b4[3];
                if (dostore) *(pg8::f32x4*)(orow + 4 * q) = o; }
        }
}

__device__ __forceinline__ void cvt_table_fp8_sliced(const float* __restrict__ src, unsigned char* __restrict__ dst, float* __restrict__ inv, int gw, int NGW, int lane) {
    for (int r = gw; r < 16384; r += NGW) {
        const pg8::f32x4* p = (const pg8::f32x4*)(src + (size_t)r * 1024 + lane * 16);
        pg8::f32x4 v[4]; float mx = 0.f;
#pragma unroll
        for (int j = 0; j < 4; ++j) { v[j] = p[j]; mx = fmaxf(mx, fmaxf(fmaxf(fabsf(v[j][0]), fabsf(v[j][1])), fmaxf(fabsf(v[j][2]), fabsf(v[j][3])))); }
#pragma unroll
        for (int o = 1; o < 64; o <<= 1) mx = fmaxf(mx, __shfl_xor(mx, o));
        const float sc = mx > 0.f ? exp2f(floorf(log2f(256.0f / mx))) : 1.0f;
        v4u w;
        { int t = 0; t = __builtin_amdgcn_cvt_pk_fp8_f32(v[0][0] * sc, v[0][1] * sc, t, false); t = __builtin_amdgcn_cvt_pk_fp8_f32(v[0][2] * sc, v[0][3] * sc, t, true); w.x = (unsigned)t; }
        { int t = 0; t = __builtin_amdgcn_cvt_pk_fp8_f32(v[1][0] * sc, v[1][1] * sc, t, false); t = __builtin_amdgcn_cvt_pk_fp8_f32(v[1][2] * sc, v[1][3] * sc, t, true); w.y = (unsigned)t; }
        { int t = 0; t = __builtin_amdgcn_cvt_pk_fp8_f32(v[2][0] * sc, v[2][1] * sc, t, false); t = __builtin_amdgcn_cvt_pk_fp8_f32(v[2][2] * sc, v[2][3] * sc, t, true); w.z = (unsigned)t; }
        { int t = 0; t = __builtin_amdgcn_cvt_pk_fp8_f32(v[3][0] * sc, v[3][1] * sc, t, false); t = __builtin_amdgcn_cvt_pk_fp8_f32(v[3][2] * sc, v[3][3] * sc, t, true); w.w = (unsigned)t; }
        *(v4u*)(dst + (size_t)(lane >> 3) * (16384 * 128) + (size_t)r * 128 + (lane & 7) * 16) = w;
        if (lane == 0) inv[2 * r] = 1.0f / sc;
    }
}
__device__ __forceinline__ void peer_route_publish_phase(const Params& P, const Ctx& C) {
    LAS float* topv = (LAS float*)(C.lds + 49152);
    const float* SUV = (const float*)(P.ws + WS_SU);
    const int n = (MR / 32 - C.vcu + C.G - 1) / C.G;
#pragma unroll 1
    for (int i = 0; i < n; ++i) {
        const int grp = C.vcu + i * C.G; const int cur = (i & 1) * 24576;
        LAS unsigned short* sidx = (LAS unsigned short*)(C.lds + cur); LAS float* sgate = (LAS float*)(C.lds + cur + 8192);
        peer_route(P, C, grp, sidx, sgate, topv);
        __syncthreads();
        { int lane_ = C.lane; asm volatile("" : "+v"(lane_)); const int lane = lane_, w = C.wave;
          int e0[4], e1[4]; float g0[4], g1[4]; f32x2v s0[4], s1[4];
#pragma unroll
          for (int tt = 0; tt < 4; ++tt) { const int tl = w * 4 + tt; e0[tt] = sidx[tl * 128 + lane]; e1[tt] = sidx[tl * 128 + 64 + lane]; g0[tt] = sgate[tl * 128 + lane]; g1[tt] = sgate[tl * 128 + 64 + lane]; }
#pragma unroll
          for (int tt = 0; tt < 4; ++tt) { s0[tt] = *(const f32x2v*)(SUV + 2 * e0[tt]); s1[tt] = *(const f32x2v*)(SUV + 2 * e1[tt]); }
#pragma unroll
          for (int tt = 0; tt < 4; ++tt) { const size_t tok = (size_t)grp * 32 + w * 4 + tt;
              unsigned short* so = (unsigned short*)(P.ws + WS_SIDX) + tok * 128; float* su_o = (float*)(P.ws + WS_SUS) + tok * 128; float* ap_o = (float*)(P.ws + WS_ACTPRE) + tok * 128;
              so[lane] = (unsigned short)e0[tt]; so[64 + lane] = (unsigned short)e1[tt]; su_o[lane] = s0[tt][0]; su_o[64 + lane] = s1[tt][0]; ap_o[lane] = g0[tt] * s0[tt][1]; ap_o[64 + lane] = g1[tt] * s1[tt][1]; } }
    }
}
__device__ __forceinline__ void peer_u_sliced_phase(const Params& P, const Ctx& C) {
    int lane_ = C.lane; asm volatile("" : "+v"(lane_));
    const int lane = lane_, w = C.wave, l8 = lane & 7, grp8 = lane >> 3;
    LAS float* psum = (LAS float*)C.lds + w * 2048;
    LAS unsigned short* sidc = (LAS unsigned short*)(C.lds + 65536) + w * 2048;
    const unsigned char* U8 = P.ws + WS_U8; const bf16* H1B = (const bf16*)(P.ws + WS_H1B);
    const unsigned short* SIDX = (const unsigned short*)(P.ws + WS_SIDX);
    const int n = (MR / 32 - C.vcu + C.G - 1) / C.G; const int ntok = n * 4;
#define TOKOF(t_) ((size_t)(C.vcu + ((t_) >> 2) * C.G) * 32 + w * 4 + ((t_) & 3))
    for (int t = 0; t < ntok; ++t) { const size_t tok = TOKOF(t);
        sidc[t * 128 + lane] = SIDX[tok * 128 + lane]; sidc[t * 128 + 64 + lane] = SIDX[tok * 128 + 64 + lane];
        psum[t * 128 + lane] = 0.f; psum[t * 128 + 64 + lane] = 0.f; }
    asm volatile("s_waitcnt vmcnt(0) lgkmcnt(0)" ::: "memory");
#define US_LOAD(XR, HA, HB, c_, t_) do { const size_t tok_ = TOKOF(t_); HA = *(const v4u*)(H1B + tok_ * DM + (c_) * 128 + l8 * 16); HB = *(const v4u*)(H1B + tok_ * DM + (c_) * 128 + l8 * 16 + 8); \
        _Pragma("unroll") for (int q = 0; q < 16; ++q) { const int e = sidc[(t_) * 128 + 8 * q + grp8]; XR[q] = *(const v4u*)(U8 + (size_t)(c_) * (16384 * 128) + l8 * 16 + (size_t)e * 128); } } while (0)
#define US_COMP(XR, HA, HB, t_) do { f32x2v h2[8]; \
        h2[0] = (f32x2v){bflo(HA.x), bfhi(HA.x)}; h2[1] = (f32x2v){bflo(HA.y), bfhi(HA.y)}; h2[2] = (f32x2v){bflo(HA.z), bfhi(HA.z)}; h2[3] = (f32x2v){bflo(HA.w), bfhi(HA.w)}; \
        h2[4] = (f32x2v){bflo(HB.x), bfhi(HB.x)}; h2[5] = (f32x2v){bflo(HB.y), bfhi(HB.y)}; h2[6] = (f32x2v){bflo(HB.z), bfhi(HB.z)}; h2[7] = (f32x2v){bflo(HB.w), bfhi(HB.w)}; \
        float pd[16]; \
        _Pragma("unroll") for (int q = 0; q < 16; ++q) { const v4u x = XR[q]; \
            f32x2v sacc = __builtin_amdgcn_cvt_pk_f32_fp8((int)x.x, false) * h2[0]; sacc = __builtin_elementwise_fma(__builtin_amdgcn_cvt_pk_f32_fp8((int)x.x, true), h2[1], sacc); \
            sacc = __builtin_elementwise_fma(__builtin_amdgcn_cvt_pk_f32_fp8((int)x.y, false), h2[2], sacc); sacc = __builtin_elementwise_fma(__builtin_amdgcn_cvt_pk_f32_fp8((int)x.y, true), h2[3], sacc); \
            sacc = __builtin_elementwise_fma(__builtin_amdgcn_cvt_pk_f32_fp8((int)x.z, false), h2[4], sacc); sacc = __builtin_elementwise_fma(__builtin_amdgcn_cvt_pk_f32_fp8((int)x.z, true), h2[5], sacc); \
            sacc = __builtin_elementwise_fma(__builtin_amdgcn_cvt_pk_f32_fp8((int)x.w, false), h2[6], sacc); sacc = __builtin_elementwise_fma(__builtin_amdgcn_cvt_pk_f32_fp8((int)x.w, true), h2[7], sacc); \
            pd[q] = sacc[0] + sacc[1]; } \
        float r8[8], r4[4], r2[2]; \
        _Pragma("unroll") for (int j = 0; j < 8; ++j) { const float keep = b2 ? pd[j + 8] : pd[j], send = b2 ? pd[j] : pd[j + 8]; r8[j] = keep + __shfl_xor(send, 4); } \
        _Pragma("unroll") for (int j = 0; j < 4; ++j) { const float keep = b1 ? r8[j + 4] : r8[j], send = b1 ? r8[j] : r8[j + 4]; r4[j] = keep + __shfl_xor(send, 2); } \
        _Pragma("unroll") for (int j = 0; j < 2; ++j) { const float keep = b0 ? r4[j + 2] : r4[j], send = b0 ? r4[j] : r4[j + 2]; r2[j] = keep + __shfl_xor(send, 1); } \
        psum[(t_) * 128 + 8 * q0 + grp8] += r2[0]; psum[(t_) * 128 + 8 * (q0 + 1) + grp8] += r2[1]; } while (0)
    const bool b2 = lane & 4, b1 = lane & 2, b0 = lane & 1; const int q0 = (b2 ? 8 : 0) + (b1 ? 4 : 0) + (b0 ? 2 : 0);
    const int nit = 8 * ntok;
    v4u xa[16], xb[16], ha0, ha1, hb0, hb1;
    US_LOAD(xa, ha0, ha1, 0, 0);
#pragma unroll 1
    for (int it = 0; it < nit; it += 2) {
        const int c0 = it / ntok, t0 = it - c0 * ntok;
        US_LOAD(xb, hb0, hb1, c0, t0 + 1);
        US_COMP(xa, ha0, ha1, t0);
        if (it + 2 < nit) { const int c2 = (it + 2) / ntok, t2 = (it + 2) - c2 * ntok; US_LOAD(xa, ha0, ha1, c2, t2); }
        US_COMP(xb, hb0, hb1, t0 + 1);
    }
#undef US_LOAD
#undef US_COMP
    asm volatile("s_waitcnt lgkmcnt(0)" ::: "memory");
    for (int t = 0; t < ntok; ++t) { const size_t tok = TOKOF(t);
        const float* su_i = (const float*)(P.ws + WS_SUS) + tok * 128; const float* ap_i = (const float*)(P.ws + WS_ACTPRE) + tok * 128; float* act_o = (float*)(P.ws + WS_ACT) + tok * 128;
        act_o[lane] = gelu_tanh(psum[t * 128 + lane] * su_i[lane]) * ap_i[lane]; act_o[64 + lane] = gelu_tanh(psum[t * 128 + 64 + lane] * su_i[64 + lane]) * ap_i[64 + lane]; }
#undef TOKOF
}

__device__ __forceinline__ void peer_phase(const Params& P, const Ctx& C, bool dostore) {
    LAS float* topv = (LAS float*)(C.lds + 49152);
    const int n = (MR / 32 - C.vcu + C.G - 1) / C.G;
#pragma unroll 1
    for (int i = -1; i < n; ++i) {
        const int grp = C.vcu + i * C.G; const int cur = (i & 1) * 24576, nxt = 24576 - cur;
#pragma unroll 1
        for (int slot = 0; slot < 2; ++slot) {
            const bool do_apply = (slot == 0) == (C.wave < 4 || PEER_SAMEORDER);
            if (do_apply) { if (i >= 0) {
#ifdef APPLY_REPS
                for (int ar = 1; ar < APPLY_REPS; ++ar) peer_apply<PEER_SPLIT>(P, C, grp, (const LAS unsigned short*)(C.lds + cur), (const LAS float*)(C.lds + cur + 8192), false);
#endif
                peer_apply<PEER_SPLIT>(P, C, grp, (const LAS unsigned short*)(C.lds + cur), (const LAS float*)(C.lds + cur + 8192), dostore); } }
            else if (i + 1 < n) {
#ifdef ROUTE_REPS
                for (int rr = 1; rr < ROUTE_REPS; ++rr) peer_route(P, C, grp + C.G, (LAS unsigned short*)(C.lds + nxt), (LAS float*)(C.lds + nxt + 8192), topv);
#endif
                peer_route(P, C, grp + C.G, (LAS unsigned short*)(C.lds + nxt), (LAS float*)(C.lds + nxt + 8192), topv); }
        }
        __syncthreads();
    }
}

__device__ __forceinline__ void peer_v_phase(const Params& P, const Ctx& C, bool dostore) {
    int lane_ = C.lane; asm volatile("" : "+v"(lane_));
    const int lane = lane_, w = C.wave;
    LAS float* actw = (LAS float*)C.lds + w * 128;
    LAS unsigned short* sidw = (LAS unsigned short*)(C.lds + 4096) + w * 128;
    const unsigned char* V8 = P.ws + WS_V8; const float* ACT = (const float*)(P.ws + WS_ACT); const unsigned short* SIDX = (const unsigned short*)(P.ws + WS_SIDX);
    const float* g2 = P.in[I_LN2G]; const float* b2 = P.in[I_LN2B];
    const int gw = C.vcu * 8 + w, NGW = C.G * 8;
    v4u nrow = {0u, 0u, 0u, 0u};
#define VROW_FETCH(t_) do { if (lane < 32) nrow = *(const v4u*)(ACT + (size_t)(t_) * 128 + lane * 4); else if (lane < 48) nrow = *(const v4u*)(SIDX + (size_t)(t_) * 128 + (lane - 32) * 8); } while (0)
    if (gw < MR) VROW_FETCH(gw);
#pragma unroll 1
    for (int tk = gw; tk < MR; tk += NGW) {
        const size_t tok = (size_t)tk;
        if (lane < 32) *(LAS v4u*)(actw + lane * 4) = nrow;
        else if (lane < 48) *(LAS v4u*)(sidw + (lane - 32) * 8) = nrow;
        if (tk + NGW < MR) VROW_FETCH(tk + NGW);
        asm volatile("s_waitcnt lgkmcnt(0)" ::: "memory");
        v4u vA[8], vB[8];
#define V_LOAD(ST, kb) do { _Pragma("unroll") for (int q = 0; q < 8; ++q) { const int e = __builtin_amdgcn_readfirstlane((int)sidw[(kb) * 8 + q]); ST[q] = *(const v4u*)(V8 + (size_t)e * DM + lane * 16); } } while (0)
#define V_COMP(ST, kb) do { _Pragma("unroll") for (int q = 0; q < 8; ++q) { const float a = actw[(kb) * 8 + q]; const f32x2v a2 = {a, a}; const v4u x = ST[q]; \
            out2[0] = __builtin_elementwise_fma(__builtin_amdgcn_cvt_pk_f32_fp8((int)x.x, false), a2, out2[0]); out2[1] = __builtin_elementwise_fma(__builtin_amdgcn_cvt_pk_f32_fp8((int)x.x, true), a2, out2[1]); \
            out2[2] = __builtin_elementwise_fma(__builtin_amdgcn_cvt_pk_f32_fp8((int)x.y, false), a2, out2[2]); out2[3] = __builtin_elementwise_fma(__builtin_amdgcn_cvt_pk_f32_fp8((int)x.y, true), a2, out2[3]); \
            out2[4] = __builtin_elementwise_fma(__builtin_amdgcn_cvt_pk_f32_fp8((int)x.z, false), a2, out2[4]); out2[5] = __builtin_elementwise_fma(__builtin_amdgcn_cvt_pk_f32_fp8((int)x.z, true), a2, out2[5]); \
            out2[6] = __builtin_elementwise_fma(__builtin_amdgcn_cvt_pk_f32_fp8((int)x.w, false), a2, out2[6]); out2[7] = __builtin_elementwise_fma(__builtin_amdgcn_cvt_pk_f32_fp8((int)x.w, true), a2, out2[7]); } } while (0)
        f32x2v out2[8];
#pragma unroll
        for (int i = 0; i < 8; ++i) out2[i] = (f32x2v){0.f, 0.f};
        V_LOAD(vA, 0);
#pragma unroll 1
        for (int kb = 0; kb < 16; kb += 2) {
            V_LOAD(vB, kb + 1);
            V_COMP(vA, kb);
            if (kb + 2 < 16) V_LOAD(vA, kb + 2);
            V_COMP(vB, kb + 1);
        }
#undef V_LOAD
#undef V_COMP
        float out[16];
#pragma unroll
        for (int i = 0; i < 8; ++i) { out[2 * i] = out2[i][0]; out[2 * i + 1] = out2[i][1]; }
        float* orow = P.out + tok * DM + lane * 16;
        float s = 0.f;
#pragma unroll
        for (int q = 0; q < 4; ++q) { const pg8::f32x4 hv = *(const pg8::f32x4*)(orow + 4 * q);
#pragma unroll
            for (int e = 0; e < 4; ++e) { out[4 * q + e] = fmaf(ALPHA, hv[e], out[4 * q + e]); s += out[4 * q + e]; } }
        const float mean = wave_sum(s) * (1.f / DM); float s2 = 0.f;
#pragma unroll
        for (int i = 0; i < 16; ++i) { out[i] -= mean; s2 += out[i] * out[i]; }
        const float rstd = 1.f / sqrtf(wave_sum(s2) * (1.f / DM) + EPS);
#pragma unroll
        for (int q = 0; q < 4; ++q) { const pg8::f32x4 gg = *(const pg8::f32x4*)(g2 + lane * 16 + 4 * q), b4 = *(const pg8::f32x4*)(b2 + lane * 16 + 4 * q);
            pg8::f32x4 o; o[0] = out[4 * q] * rstd * gg[0] + b4[0]; o[1] = out[4 * q + 1] * rstd * gg[1] + b4[1]; o[2] = out[4 * q + 2] * rstd * gg[2] + b4[2]; o[3] = out[4 * q + 3] * rstd * gg[3] + b4[3];
            if (dostore) *(pg8::f32x4*)(orow + 4 * q) = o; }
    }
}

#define XB_TMO      128
#define XB_XCNT(j)  (256  + 64 * (j))
#define XB_XSUB(j)  (1280 + 64 * (j))
#define XB_XGEN(j)  (2304 + 64 * (j))
#define XB_TOP      3328
#define XB_TOPGEN   3392
#define XCD_BAR_WORDS 3456
#define XB_SPIN_CAP (1u << 18)

__device__ __forceinline__ unsigned xb_ld(unsigned* p)              { return __hip_atomic_load(p, __ATOMIC_RELAXED, __HIP_MEMORY_SCOPE_AGENT); }
__device__ __forceinline__ unsigned xb_add(unsigned* p, unsigned v) { return __hip_atomic_fetch_add(p, v, __ATOMIC_RELAXED, __HIP_MEMORY_SCOPE_AGENT); }
__device__ __forceinline__ unsigned xb_xcc_id() { return (unsigned)__builtin_amdgcn_s_getreg((3 << 11) | 20) & 0xFu; }
#define XB_SPIN(cond, bar) do { unsigned _sp = 0; while (cond) { __builtin_amdgcn_s_sleep(1); \
    if ((++_sp & 255u) == 0u) { if (xb_ld(&(bar)[XB_TMO])) break; if (_sp > XB_SPIN_CAP) { atomicAdd(&(bar)[XB_TMO], 1u); break; } } } } while (0)

struct XcdBarrier {
    unsigned* bar; unsigned x;
    volatile LAS unsigned* st;
};

__device__ __forceinline__ XcdBarrier xcd_barrier_post(unsigned* bar, volatile LAS unsigned* st) {
    XcdBarrier b; b.bar = bar; b.x = xb_xcc_id(); b.st = st;
    if (threadIdx.x == 0) (void)xb_add(&bar[XB_XCNT(b.x)], 1u);
    return b;
}
__device__ __forceinline__ void xcd_barrier_complete(unsigned* bar, unsigned x, unsigned& nloc, unsigned& nx) {
    const unsigned G = gridDim.x * gridDim.y * gridDim.z;
    unsigned sum, cnt, mine, sp = 0u;
    for (;;) {
        sum = 0u; cnt = 0u; mine = 0u;
#pragma unroll
        for (unsigned j = 0; j < 16; ++j) { const unsigned c = xb_ld(&bar[XB_XCNT(j)]); sum += c; cnt += (c > 0u) ? 1u : 0u; mine = (j == x) ? c : mine; }
        if (sum == G) break;
        __builtin_amdgcn_s_sleep(1);
        if ((++sp & 255u) == 0u) { if (xb_ld(&bar[XB_TMO])) break; if (sp > XB_SPIN_CAP) { atomicAdd(&bar[XB_TMO], 1u); break; } }
    }
    nloc = mine > 0u ? mine : 1u; nx = cnt > 0u ? cnt : 1u;
}

__device__ __forceinline__ void xcd_barrier(const XcdBarrier& b) {
    asm volatile("s_waitcnt vmcnt(0)" ::: "memory");
    __syncthreads();
    if (threadIdx.x == 0) {
        unsigned* bar = b.bar;
        __builtin_amdgcn_s_waitcnt(0);
        unsigned nloc = b.st[0], nx = b.st[1];
        if (nloc == 0u) { xcd_barrier_complete(bar, b.x, nloc, nx); b.st[0] = nloc; b.st[1] = nx; }
        const unsigned old = xb_add(&bar[XB_XSUB(b.x)], 1u);
        const unsigned gen = old / nloc;
        if (old + 1u == (gen + 1u) * nloc) {
            __builtin_amdgcn_fence(__ATOMIC_RELEASE, "agent");
            asm volatile("s_waitcnt vmcnt(0)" ::: "memory");
            const unsigned og = xb_add(&bar[XB_TOP], 1u);
            const unsigned tg = og / nx;
            if (og + 1u == (tg + 1u) * nx) xb_add(&bar[XB_TOPGEN], 1u);
            else XB_SPIN(xb_ld(&bar[XB_TOPGEN]) == tg, bar);
            __builtin_amdgcn_fence(__ATOMIC_ACQUIRE, "agent");
            xb_add(&bar[XB_XGEN(b.x)], 1u);
            asm volatile("s_waitcnt vmcnt(0)" ::: "memory");
        } else {
            XB_SPIN(xb_ld(&bar[XB_XGEN(b.x)]) == gen, bar);
            __builtin_amdgcn_fence(__ATOMIC_ACQUIRE, "agent");
            asm volatile("s_waitcnt vmcnt(0)" ::: "memory");
        }
    }
    __syncthreads();
}

__device__ __forceinline__ void sub_barrier(unsigned* cnt, unsigned n) {
    asm volatile("s_waitcnt vmcnt(0)" ::: "memory");
    __syncthreads();
    if (threadIdx.x == 0) {
        __builtin_amdgcn_fence(__ATOMIC_RELEASE, "agent");
        asm volatile("s_waitcnt vmcnt(0)" ::: "memory");
        __hip_atomic_fetch_add(cnt, 1u, __ATOMIC_RELAXED, __HIP_MEMORY_SCOPE_AGENT);
        unsigned sp = 0;
        while (__hip_atomic_load(cnt, __ATOMIC_RELAXED, __HIP_MEMORY_SCOPE_AGENT) < n) { __builtin_amdgcn_s_sleep(2); if (++sp > (1u << 22)) break; }
        __builtin_amdgcn_fence(__ATOMIC_ACQUIRE, "agent");
        asm volatile("s_waitcnt vmcnt(0)" ::: "memory");
    }
    __syncthreads();
}

constexpr int N_PHASES = 12 + (PEER_SPLIT == 3 ? 2 : PEER_SPLIT);
__global__ void __launch_bounds__(512, 2) mega_fwd(Params P) {
    extern __shared__ __attribute__((aligned(16))) unsigned char lds_raw[];
    Ctx C; C.lds = (LAS unsigned char*)lds_raw; C.tid = threadIdx.x; C.lane = C.tid & 63; C.wave = __builtin_amdgcn_readfirstlane(C.tid >> 6);
    C.G = gridDim.x; C.bid = blockIdx.x; C.vcu = (C.G % 8 == 0) ? (C.bid % 8) * (C.G / 8) + C.bid / 8 : C.bid;
    unsigned char* ws = P.ws;
    const int lo = P.ph_lo, hi = P.ph_hi;
    volatile LAS unsigned* bst = (volatile LAS unsigned*)(C.lds + LDS_BYTES - 64);
    if (C.tid < 16) bst[C.tid] = 0u;
    __syncthreads();
    (void)xcd_barrier_post((unsigned*)(ws + WS_CTL) + 1024, bst);
#define RETID() do { int t_ = threadIdx.x; asm volatile("" : "+v"(t_)); C.tid = t_; C.lane = t_ & 63; } while (0)
#ifndef PH_MASK
#define PH_MASK 0x3FFF
#endif
#define IN(k) (((PH_MASK >> (k)) & 1) && lo <= (k) && (k) < hi)
#ifndef DUP_MASK
#define DUP_MASK 0
#endif
#define REPS(k) (((DUP_MASK >> (k)) & 1) ? 2 : 1)
#define SEAM(k) do { if (IN(k) && IN((k) + 1)) { if ((k) == 0) cg::this_grid().sync(); else { XcdBarrier xb_; xb_.bar = (unsigned*)(P.ws + WS_CTL) + 1024; xb_.x = xb_xcc_id(); xb_.st = (volatile LAS unsigned*)(C.lds + LDS_BYTES - 64); xcd_barrier(xb_); } } } while (0)
    typedef pg8::StaticOrder SO;
    if (IN(0)) for (int rep = 0; rep < REPS(0); ++rep) { RETID(); p0_prologue(P, C); }
    SEAM(0);
    if (IN(1)) for (int rep = 0; rep < REPS(1); ++rep) {
        pg8::Gemm g{(const bf16*)(ws + WS_A), (const bf16*)(ws + WS_WIN), MV, N1, DM}; SO S; S.init(MV, N1, C.G, C.bid);
        pg8::EpiInProj E{(bf16*)(ws + WS_HQ), (bf16*)(ws + WS_K1), (bf16*)(ws + WS_HI), (bf16*)(ws + WS_HG), (bf16*)(ws + WS_CQ), (bf16*)(ws + WS_CKV), (bf16*)(ws + WS_KR),
                         (bf16*)P.out, (bf16*)P.out + (size_t)MR * DM, P.in[I_LBL], (const float*)(ws + WS_ROPE)};
#ifdef INPROJ_NOSTORE_FIRST
        if (rep == 0) { pg8::EpiNoStore EN{E.HQ, hi > 100}; pg8::gemm_phase<pg8::EpiNoStore, SO, true, true>(C.lds, g, S, EN); } else
#endif
#ifdef INPROJ_RAW_FIRST
        if (rep == 0) { pg8::EpiInProjT<true> ER{E.HQ, E.K1, E.HI, E.HG, E.CQ, E.CKV, E.KR, E.GA, E.GB, E.lbl, E.rope}; pg8::gemm_phase<pg8::EpiInProjT<true>, SO, true, true>(C.lds, g, S, ER); } else
#endif
        pg8::gemm_phase<pg8::EpiInProj, SO, true, true>(C.lds, g, S, E);
    }
    SEAM(1);
    const bool split2 = false;
    if (IN(2)) for (int rep = 0; rep < REPS(2); ++rep) {
        RETID();
        if (!split2) {
            if (C.G == 256) {
                if (C.bid < 128) { hgrn_item2(P, C, C.bid); late_weights(P, C, C.bid * 8 + C.wave, 128 * 8, (size_t)C.bid * 512 + C.tid, (size_t)128 * 512, 2); }
                else { rowstats(P, C, (C.bid - 128) * 8 + C.wave, 128 * 8); late_weights(P, C, (C.bid - 128) * 8 + C.wave, 128 * 8, (size_t)(C.bid - 128) * 512 + C.tid, (size_t)128 * 512, 1);
                    __syncthreads();
                    pg8::Gemm g{(const bf16*)(ws + WS_A), (const bf16*)(ws + WS_WIN) + (size_t)N1 * DM, MR, 2048, DM}; pg8::GateOrder S; S.init(MR, 2048, 128, C.bid - 128);
                    pg8::EpiGates E{(bf16*)P.out, (bf16*)P.out + (size_t)MR * DM};
                    pg8::gemm_phase<pg8::EpiGates, pg8::GateOrder, true, true>(C.lds, g, S, E); }
            } else {
                rowstats(P, C, C.vcu * 8 + C.wave, C.G * 8); late_weights(P, C, C.vcu * 8 + C.wave, C.G * 8, (size_t)C.vcu * 512 + C.tid, (size_t)C.G * 512, 3);
                for (int item = C.bid; item < NB * HGH; item += C.G) hgrn_item2(P, C, item);
                { pg8::Gemm g{(const bf16*)(ws + WS_A), (const bf16*)(ws + WS_WIN) + (size_t)N1 * DM, MR, 2048, DM}; pg8::GateOrder S; S.init(MR, 2048, C.G, C.bid);
                  pg8::EpiGates E{(bf16*)P.out, (bf16*)P.out + (size_t)MR * DM};
                  pg8::gemm_phase<pg8::EpiGates, pg8::GateOrder, true, true>(C.lds, g, S, E); }
            }
        } else if (C.bid < 128) {
            hgrn_item2(P, C, C.bid);
        } else {
            rowstats(P, C, (C.bid - 128) * 8 + C.wave, 128 * 8);
            sub_barrier((unsigned*)(ws + WS_CTL) + 8192 + 64 * rep, 128u);
            { pg8::Gemm g{(const bf16*)(ws + WS_CQ), (const bf16*)(ws + WS_WUQ), MRH, 3072, QR}; SO S; S.init(MRH, 3072, 128, C.bid - 128);
              pg8::EpiQ E{(bf16*)(ws + WS_QH), (const float*)(ws + WS_RQ), (const float*)(ws + WS_ROPE), 0};
              pg8::gemm_phase<pg8::EpiQ, SO, true, true>(C.lds, g, S, E); }
            { pg8::Gemm g{(const bf16*)(ws + WS_CKV), (const bf16*)(ws + WS_WUKV), MALLH, 4096, KVR}; SO S; S.init(MALLH, 4096, 128, C.bid - 128);
              pg8::EpiScaleBf16 E{(bf16*)(ws + WS_KVH), 4096, (const float*)(ws + WS_RKV), 0};
              pg8::gemm_phase<pg8::EpiScaleBf16, SO, true, true>(C.lds, g, S, E); }
        }
    }
    SEAM(2);
#pragma unroll 1
    for (int hb = 0; hb < NHALF; ++hb) {
        if (IN(3 + 2 * hb) && !(split2 && hb == 0)) for (int rep = 0; rep < REPS(3); ++rep) {
#ifndef NO_QG
            { pg8::Gemm g{(const bf16*)(ws + WS_CQ) + (size_t)hb * MRH * QR, (const bf16*)(ws + WS_WUQ), MRH, 3072, QR}; SO S; S.init(MRH, 3072, C.G, C.bid);
              pg8::EpiQ E{(bf16*)(ws + WS_QH), (const float*)(ws + WS_RQ), (const float*)(ws + WS_ROPE), hb * MRH};
              pg8::gemm_phase<pg8::EpiQ, SO, true, true>(C.lds, g, S, E); }
#endif
#ifndef NO_KVG
            { pg8::Gemm g{(const bf16*)(ws + WS_CKV) + (size_t)hb * MALLH * KVR, (const bf16*)(ws + WS_WUKV), MALLH, 4096, KVR}; SO S; S.init(MALLH, 4096, C.G, C.bid);
              pg8::EpiScaleBf16 E{(bf16*)(ws + WS_KVH), 4096, (const float*)(ws + WS_RKV), hb * MALLH};
              pg8::gemm_phase<pg8::EpiScaleBf16, SO, true, true>(C.lds, g, S, E); }
#endif
        }
        if (!(split2 && hb == 0)) SEAM(3 + 2 * hb);
        if (IN(4 + 2 * hb)) for (int rep = 0; rep < REPS(4); ++rep) {
            const bf16* QH = (const bf16*)(ws + WS_QH); const bf16* KVH = (const bf16*)(ws + WS_KVH); const bf16* KR = (const bf16*)(ws + WS_KR); bf16* AO = (bf16*)(ws + WS_AO);
            for (int wv = C.vcu; wv < 256; wv += C.G) {
                const int bhl = wv >> 1, bl = bhl >> 4, h = bhl & 15, sub = wv & 1, b = hb * HB + bl;
#pragma unroll 1
                for (int i = 0; i < 4; ++i) {
                    const int qb = sub ? (i == 0 ? 2 : i == 1 ? 5 : i == 2 ? 3 : 4) : (i == 0 ? 0 : i == 1 ? 7 : i == 2 ? 1 : 6);
                    attn::attn_unit(QH + ((size_t)bl * SEQ + qb * 256) * 3072 + h * QKD, KVH + ((size_t)bl * PP + 64) * 4096 + h * 256, KR + ((size_t)b * PP + 64) * ROPE,
                                    AO + ((size_t)b * SEQ + qb * 256) * 2048 + h * VD, 4 * qb + 5, (char*)lds_raw);
                }
            }
        }
        SEAM(4 + 2 * hb);
    }
    if (IN(7)) for (int rep = 0; rep < REPS(7); ++rep) {
        RETID();
#pragma unroll 1
        for (int slot = 0; slot < 2; ++slot) {
            if ((slot == 0) == ((C.bid & 1) != 0)) {
#if PEER_SPLIT == 3
                cvt_table_fp8_sliced(P.in[I_PU], ws + WS_U8, (float*)(ws + WS_SU), C.vcu * 8 + C.wave, C.G * 8, C.lane);
#else
                cvt_table_fp8(P.in[I_PU], ws + WS_U8, (float*)(ws + WS_SU), C.vcu * 8 + C.wave, C.G * 8, C.lane);
#endif
                cvt_table_fp8(P.in[I_PV], ws + WS_V8, (float*)(ws + WS_SU) + 1, C.vcu * 8 + C.wave, C.G * 8, C.lane);
            } else {
                { pg8::Gemm g{(const bf16*)(ws + WS_ON), (const bf16*)(ws + WS_WPH), MR, DM, 1024}; SO S; S.init(MR, DM, C.G, C.bid);
                  pg8::EpiGate<false> E{(bf16*)(ws + WS_X), (const bf16*)P.out};
                  pg8::gemm_phase<pg8::EpiGate<false>, SO, true, true>(C.lds, g, S, E); }
                { pg8::Gemm g{(const bf16*)(ws + WS_AO), (const bf16*)(ws + WS_WPM), MR, DM, 2048}; SO S; S.init(MR, DM, C.G, C.bid);
                  pg8::EpiGate<true> E{(bf16*)(ws + WS_X), (const bf16*)P.out + (size_t)MR * DM};
                  pg8::gemm_phase<pg8::EpiGate<true>, SO, true, true>(C.lds, g, S, E); }
            }
        }
    }
    SEAM(7);
    if (IN(8)) for (int rep = 0; rep < REPS(8); ++rep) {
        pg8::Gemm g{(const bf16*)(ws + WS_X), (const bf16*)(ws + WS_WO), MR, DM, 1024}; SO S; S.init(MR, DM, C.G, C.bid);
        pg8::EpiResF32 E{P.out, P.in[I_X], ALPHA};
        pg8::gemm_phase<pg8::EpiResF32, SO, true, true>(C.lds, g, S, E);
    }
    SEAM(8);
    if (IN(9)) for (int rep = 0; rep < REPS(9); ++rep) { RETID(); ln1_phase(P, C, rep + 1 == REPS(9) || hi > 100); }
    SEAM(9);
    if (IN(10)) for (int rep = 0; rep < REPS(10); ++rep) {
        pg8::Gemm g{(const bf16*)(ws + WS_H1B), (const bf16*)(ws + WS_WPQ), MR, 2048, 1024}; SO S; S.init(MR, 2048, C.G, C.bid);
        pg8::EpiScaleBf16 E{(bf16*)(ws + WS_PQ), 2048, nullptr, 0};
        pg8::gemm_phase<pg8::EpiScaleBf16, SO, true, true>(C.lds, g, S, E);
    }
    SEAM(10);
#if PEER_SPLIT == 3
    if (IN(11)) { RETID(); peer_route_publish_phase(P, C); }
    SEAM(11);
    if (IN(12)) { RETID(); peer_u_sliced_phase(P, C); }
    SEAM(12);
    if (IN(13)) for (int rep = 0; rep < REPS(13); ++rep) { RETID(); peer_v_phase(P, C, rep + 1 == REPS(13) || hi > 100); }
#else
    if (IN(11)) for (int rep = 0; rep < REPS(11); ++rep) { RETID(); peer_phase(P, C, rep + 1 == REPS(11) || hi > 100); }
#if PEER_SPLIT
    SEAM(11);
    if (IN(12)) for (int rep = 0; rep < REPS(12); ++rep) { RETID(); peer_v_phase(P, C, rep + 1 == REPS(12) || hi > 100); }
#endif
#endif
#undef IN
#undef SEAM
}

extern "C" void kernel_launch(void* const* d_in, const int* in_sizes, int n_in, void* d_out, int out_size, void* d_ws, size_t ws_size, hipStream_t stream) {
    static int grid = 0;
    if (grid == 0) {
        if (n_in != 20 || in_sizes[0] != MR * DM || out_size != MR * DM || ws_size < WS_NEED) {
            fprintf(stderr, "kernel_launch: unexpected shapes: n_in %d in0 %d out %d ws %zu (need %zu)\n", n_in, n_in > 0 ? in_sizes[0] : -1, out_size, ws_size, (size_t)WS_NEED); grid = -1; return; }
        int dev = 0, cus = 0, per_cu = 0;
        if (hipGetDevice(&dev) != hipSuccess || hipDeviceGetAttribute(&cus, hipDeviceAttributeMultiprocessorCount, dev) != hipSuccess) { grid = -1; return; }
        if (hipFuncSetAttribute((const void*)mega_fwd, hipFuncAttributeMaxDynamicSharedMemorySize, LDS_BYTES) != hipSuccess) { fprintf(stderr, "kernel_launch: hipFuncSetAttribute failed\n"); grid = -1; return; }
        if (hipOccupancyMaxActiveBlocksPerMultiprocessor(&per_cu, (const void*)mega_fwd, 512, LDS_BYTES) != hipSuccess || per_cu < 1) { fprintf(stderr, "kernel_launch: occupancy query says %d\n", per_cu); per_cu = 1; }
        (void)hipGetLastError();
        grid = cus;
        if (grid > 256) grid = 256;
    }
    if (grid < 0) return;
    if (hipMemsetAsync((char*)d_ws + WS_CTL, 0, 65536, stream) != hipSuccess) { fprintf(stderr, "kernel_launch: memset failed\n"); return; }
    Params p{};
    for (int i = 0; i < 20; ++i) p.in[i] = (const float*)d_in[i];
    p.out = (float*)d_out; p.ws = (unsigned char*)d_ws;
#if MK_LAUNCHES == 1
    p.ph_lo = 0; p.ph_hi = N_PHASES;
    void* args[] = {&p};
    hipError_t e = hipLaunchCooperativeKernel((const void*)mega_fwd, dim3(grid), dim3(512), args, LDS_BYTES, stream);
    if (e != hipSuccess) fprintf(stderr, "cooperative launch failed: %s (grid %d)\n", hipGetErrorString(e), grid);
#else
    for (int ph = 0; ph < N_PHASES; ++ph) {
        p.ph_lo = ph; p.ph_hi = ph + 1;
        hipLaunchKernelGGL(mega_fwd, dim3(grid), dim3(512), LDS_BYTES, stream, p);
    }
#endif
}
```
